# Optimizing an MI355X kernel written in HIP

```python
import math
import jax
import jax.numpy as jnp
from jax import lax
import numpy as np

D_MODEL = 1024
BATCH = 16
SEQ = 2048
DEPTH = 4

GRID_W = 64
CTX_LEN = 256
N_EVEN = (DEPTH + 1) // 2
N_ODD = DEPTH // 2
N_MOD = 6

DN_ALPHA = (2.0 * DEPTH) ** 0.25
DN_BETA = (8.0 * DEPTH) ** -0.25
LN_EPS = 1e-5

HY_W = D_MODEL // 2
HY_ORDER = 2
HY_SHORT = 3
HY_EMB = 33
HY_BANDS = (HY_EMB - 1) // 2
HY_HID = 64
HY_N_FILT = HY_ORDER * 2 * HY_W
HY_DECAY_TARGET = 1e-2
HY_FAST_PCT = 0.3
HY_SLOW_PCT = 1.5

ATT_W = D_MODEL // 2
DA_HEADS = 4
DA_HD = ATT_W // (2 * DA_HEADS)
DA_VD = 2 * DA_HD
ROPE_BASE = 10000.0
ROPE_NF = DA_HD // 4
Q_BLOCK = 128
AB_IN = 3 * HY_W + 3 * ATT_W
AB_OUT = HY_W + ATT_W

D_RNN = D_MODEL
RG_BLOCKS = 8
RG_BW = D_RNN // RG_BLOCKS
RG_CONV = 4
RG_C = 8.0

N_EXPERTS = 64
N_GROUPS = 8
EPG = N_EXPERTS // N_GROUPS
TOPK_GROUPS = 4
TOP_K = 8
D_EXPERT = D_MODEL // 4
D_SHARED = D_MODEL // 4
ROUTED_SCALE = 2.5

F32 = jnp.float32

kernel_name = 'hybrid_hyena_diffattn_rglru_moe_dit'


def layer_norm(x, g, b):
    xf = x.astype(F32)
    mu = jnp.mean(xf, -1, keepdims=True)
    var = jnp.mean(jnp.square(xf - mu), -1, keepdims=True)
    return ((xf - mu) * lax.rsqrt(var + LN_EPS) * g + b).astype(x.dtype)


def rms_norm(x, g):
    xf = x.astype(F32)
    return (xf * lax.rsqrt(jnp.mean(xf * xf, -1, keepdims=True) + LN_EPS) * g).astype(x.dtype)


def depthwise_conv_centred(u, w, b):
    k = w.shape[0]
    left = k // 2
    y = lax.conv_general_dilated(u, w[:, None, :].astype(u.dtype), window_strides=(1,),
                                 padding=[(left, k - 1 - left)],
                                 dimension_numbers=('NWC', 'WIO', 'NWC'),
                                 feature_group_count=u.shape[-1])
    return y + b


def hyena_filters(n, w1, b1, w2, b2, w3, b3, w4, freq, decay):
    t = jnp.linspace(0.0, 1.0, n, dtype=F32)[:, None]
    f = jnp.linspace(1e-4, HY_BANDS - 1, HY_BANDS, dtype=F32)
    ang = (2.0 * math.pi / n) * jnp.arange(n, dtype=F32)[:, None] * f[None, :]
    z = jnp.concatenate([t, jnp.cos(ang), -jnp.sin(ang)], axis=-1)
    fr = freq.astype(F32)
    hdn = jnp.sin(fr * (z @ w1.astype(F32) + b1.astype(F32)))
    hdn = jnp.sin(fr * (hdn @ w2.astype(F32) + b2.astype(F32)))
    hdn = jnp.sin(fr * (hdn @ w3.astype(F32) + b3.astype(F32)))
    h = (hdn @ w4.astype(F32)) * jnp.exp(-t * jnp.abs(decay.astype(F32)))
    return h.reshape(n, HY_ORDER, 2, HY_W)


def long_conv_bidir(u, h_fwd, h_bwd, skip):
    n = u.shape[1]
    kern = jnp.concatenate([h_fwd[:1] + h_bwd[:1], h_fwd[1:], jnp.zeros_like(h_fwd[:1]), h_bwd[:0:-1]], axis=0)
    uf = u.astype(F32)
    spec = jnp.fft.rfft(uf, n=2 * n, axis=1) * jnp.fft.rfft(kern, axis=0)[None]
    y = jnp.fft.irfft(spec, n=2 * n, axis=1)[:, :n]
    return y + uf * skip.astype(F32)


def hyena_mixer(u, short_w, short_b, filt, skip):
    uc = depthwise_conv_centred(u, short_w, short_b).astype(F32)
    v, x1, x2 = jnp.split(uc, 3, axis=-1)
    z = x1 * long_conv_bidir(v, filt[:, 0, 0], filt[:, 0, 1], skip[0])
    y = x2 * long_conv_bidir(z, filt[:, 1, 0], filt[:, 1, 1], skip[1])
    return y.astype(u.dtype)


def axial_rope_tables(n):
    rows = n // GRID_W
    r = jnp.repeat(jnp.arange(rows, dtype=F32), GRID_W)
    col = jnp.tile(jnp.arange(GRID_W, dtype=F32), rows)
    inv = ROPE_BASE ** (-jnp.arange(ROPE_NF, dtype=F32) / ROPE_NF)
    ang = jnp.stack([r[:, None] * inv, col[:, None] * inv], axis=1)
    return jnp.cos(ang), jnp.sin(ang)


def apply_axial_rope(x, cos, sin):
    xs = x.reshape(x.shape[:-1] + (2, 2, ROPE_NF)).astype(F32)
    xa, xb = xs[..., 0, :], xs[..., 1, :]
    cc = cos[None, :, None, None]
    ss = sin[None, :, None, None]
    out = jnp.stack([xa * cc - xb * ss, xb * cc + xa * ss], axis=-2)
    return out.reshape(x.shape).astype(x.dtype)


def diff_attend(q, k, v, lam):
    s = jnp.einsum('bqhsd,bkhsd->bhsqk', q, k).astype(F32) * (DA_HD ** -0.5)
    p = jax.nn.softmax(s, axis=-1)
    w = p[:, :, 0] - lam * p[:, :, 1]
    return jnp.einsum('bhqk,bkhe->bqhe', w.astype(v.dtype), v)


def ab_mixer(h_ctx, h_lat, w_in, w_out, short_w, short_b, filt_p, skip,
             lq1, lk1, lq2, lk2, subln_g, lam_init, need_ctx):
    bsz, n_lat, _ = h_lat.shape
    n_ctx = h_ctx.shape[1]
    hy = 3 * HY_W
    p_ctx = h_ctx @ w_in
    p_lat = h_lat @ w_in

    y_hy_lat = hyena_mixer(p_lat[..., :hy], short_w, short_b, hyena_filters(n_lat, *filt_p), skip)

    def split_qkv(p, n):
        q, k, v = jnp.split(p[..., hy:], 3, axis=-1)
        return (q.reshape(bsz, n, DA_HEADS, 2, DA_HD), k.reshape(bsz, n, DA_HEADS, 2, DA_HD),
                v.reshape(bsz, n, DA_HEADS, DA_VD))

    q_c, k_c, v_c = split_qkv(p_ctx, n_ctx)
    q_l, k_l, v_l = split_qkv(p_lat, n_lat)
    cos, sin = axial_rope_tables(n_lat)
    q_l = apply_axial_rope(q_l, cos, sin)
    k_l = apply_axial_rope(k_l, cos, sin)
    lam = (jnp.exp(jnp.sum(lq1.astype(F32) * lk1.astype(F32)))
           - jnp.exp(jnp.sum(lq2.astype(F32) * lk2.astype(F32))) + lam_init)

    k_all = jnp.concatenate([k_c, k_l], axis=1)
    v_all = jnp.concatenate([v_c, v_l], axis=1)
    nblk = n_lat // Q_BLOCK
    qb = jnp.moveaxis(q_l.reshape(bsz, nblk, Q_BLOCK, DA_HEADS, 2, DA_HD), 1, 0)
    ob = lax.map(lambda qq: diff_attend(qq, k_all, v_all, lam), qb)
    o_lat = jnp.moveaxis(ob, 0, 1).reshape(bsz, n_lat, DA_HEADS, DA_VD)

    def head_out(o):
        return (rms_norm(o, subln_g) * (1.0 - lam_init)).reshape(bsz, o.shape[1], ATT_W)

    m_lat = jnp.concatenate([y_hy_lat, head_out(o_lat).astype(y_hy_lat.dtype)], axis=-1) @ w_out
    if not need_ctx:
        return None, m_lat
    y_hy_ctx = hyena_mixer(p_ctx[..., :hy], short_w, short_b, hyena_filters(n_ctx, *filt_p), skip)
    o_ctx = diff_attend(q_c, k_c, v_c, lam)
    m_ctx = jnp.concatenate([y_hy_ctx, head_out(o_ctx).astype(y_hy_ctx.dtype)], axis=-1) @ w_out
    return m_ctx, m_lat


def linear_scan(a, b, h0, reverse):
    def combine(l, r):
        return l[0] * r[0], r[0] * l[1] + r[1]
    a_cum, b_cum = lax.associative_scan(combine, (a, b), axis=1, reverse=reverse)
    return a_cum * h0[:, None, :] + b_cum


def rglru_coeffs(u, wa, ba, wx, bx, lam):
    bsz, n, _ = u.shape
    ub = u.reshape(bsz, n, RG_BLOCKS, RG_BW)
    r = jax.nn.sigmoid(jnp.einsum('bnkc,kcd->bnkd', ub, wa.astype(F32)).reshape(bsz, n, D_RNN) + ba.astype(F32))
    i = jax.nn.sigmoid(jnp.einsum('bnkc,kcd->bnkd', ub, wx.astype(F32)).reshape(bsz, n, D_RNN) + bx.astype(F32))
    log_a = RG_C * r * jax.nn.log_sigmoid(lam.astype(F32))
    a = jnp.exp(log_a)
    b = jnp.sqrt(-jnp.expm1(2.0 * log_a)) * (i * u)
    return a, b


def rg_mixer(h_ctx, h_lat, w_in, w_out, conv_w, conv_b, wa, ba, wx, bx, lam, need_ctx):
    def branches(h):
        gate, rec = jnp.split(h @ w_in, 2, axis=-1)
        return jax.nn.gelu(gate), depthwise_conv_centred(rec, conv_w, conv_b).astype(F32)

    g_c, u_c = branches(h_ctx)
    g_l, u_l = branches(h_lat)

    def direction(d, reverse):
        a, b = rglru_coeffs(u_c, wa[d], ba[d], wx[d], bx[d], lam[d])
        hc = linear_scan(a, b, jnp.zeros_like(u_c[:, 0]), reverse)
        h_end = hc[:, 0] if reverse else hc[:, -1]
        a, b = rglru_coeffs(u_l, wa[d], ba[d], wx[d], bx[d], lam[d])
        return hc, linear_scan(a, b, h_end, reverse)

    hc_f, hl_f = direction(0, False)
    hc_b, hl_b = direction(1, True)
    m_lat = (g_l * (hl_f + hl_b).astype(g_l.dtype)) @ w_out
    if not need_ctx:
        return None, m_lat
    m_ctx = (g_c * (hc_f + hc_b).astype(g_c.dtype)) @ w_out
    return m_ctx, m_lat


def moe(h, router_w, router_bias, w_gate, w_up, w_down, s_gate, s_up, s_down):
    bsz, n, d = h.shape
    t = h.reshape(bsz * n, d)
    scores = jax.nn.sigmoid((t @ router_w).astype(F32))
    sel = scores + router_bias.astype(F32)
    grp_score = lax.top_k(sel.reshape(-1, N_GROUPS, EPG), 2)[0].sum(-1)
    _, gidx = lax.top_k(grp_score, TOPK_GROUPS)
    gmask = jax.nn.one_hot(gidx, N_GROUPS, dtype=F32).sum(-2) > 0
    sel = jnp.where(jnp.repeat(gmask, EPG, axis=-1), sel, -jnp.inf)
    _, eidx = lax.top_k(sel, TOP_K)
    w = jnp.take_along_axis(scores, eidx, axis=-1)
    w = w / jnp.sum(w, -1, keepdims=True) * ROUTED_SCALE
    gates = jnp.einsum('tk,tke->te', w, jax.nn.one_hot(eidx, N_EXPERTS, dtype=F32)).astype(h.dtype)
    out = (jax.nn.silu(t @ s_gate) * (t @ s_up)) @ s_down
    for g in range(N_GROUPS):
        sl = slice(g * EPG, (g + 1) * EPG)
        hg = jnp.einsum('td,edf->tef', t, w_gate[sl])
        hu = jnp.einsum('td,edf->tef', t, w_up[sl])
        out = out + jnp.einsum('tef,efd->td', jax.nn.silu(hg) * hu * gates[:, sl, None], w_down[sl])
    return out.reshape(bsz, n, d)


def setup_inputs(seed: int = 0) -> dict:
    key = jax.random.key(seed)
    ks = iter(jax.random.split(key, 64))

    def nrm(shape, scale=1.0):
        return jax.random.normal(next(ks), shape, F32) * scale

    D = D_MODEL
    min_decay = math.log(1.0 / HY_DECAY_TARGET) / HY_SLOW_PCT
    max_decay = math.log(1.0 / HY_DECAY_TARGET) / HY_FAST_PCT
    decay_base = jnp.tile(jnp.linspace(min_decay, max_decay, HY_W, dtype=F32), HY_ORDER * 2)
    lam_s = jnp.sqrt(jax.random.uniform(next(ks), (N_ODD, 2, D_RNN), F32, 0.81, 0.998))
    return {
        'x': nrm((BATCH, SEQ, D)),
        'c': nrm((BATCH, D)),
        'ctx': nrm((BATCH, CTX_LEN, D)),
        'c_ctx': nrm((D,)),
        'w_mod': nrm((DEPTH, D, N_MOD * D), 0.5 * D ** -0.5),
        'b_mod': nrm((DEPTH, N_MOD * D), 0.02),
        'ln1_g': 1.0 + nrm((DEPTH, D), 0.02),
        'ln1_b': nrm((DEPTH, D), 0.02),
        'ln2_g': 1.0 + nrm((DEPTH, D), 0.02),
        'ln2_b': nrm((DEPTH, D), 0.02),
        'ab_w_in': nrm((N_EVEN, D, AB_IN), D ** -0.5),
        'ab_w_out': nrm((N_EVEN, AB_OUT, D), DN_BETA * AB_OUT ** -0.5),
        'hy_short_w': nrm((N_EVEN, HY_SHORT, 3 * HY_W), HY_SHORT ** -0.5),
        'hy_short_b': nrm((N_EVEN, 3 * HY_W), 0.02),
        'hy_fw1': nrm((N_EVEN, HY_EMB, HY_HID), HY_EMB ** -0.5),
        'hy_fb1': nrm((N_EVEN, HY_HID), 0.02),
        'hy_fw2': nrm((N_EVEN, HY_HID, HY_HID), HY_HID ** -0.5),
        'hy_fb2': nrm((N_EVEN, HY_HID), 0.02),
        'hy_fw3': nrm((N_EVEN, HY_HID, HY_HID), HY_HID ** -0.5),
        'hy_fb3': nrm((N_EVEN, HY_HID), 0.02),
        'hy_fw4': nrm((N_EVEN, HY_HID, HY_N_FILT), 0.05 * HY_HID ** -0.5),
        'hy_freq': 1.0 + nrm((N_EVEN, HY_HID), 0.1),
        'hy_decay': decay_base[None] * (1.0 + nrm((N_EVEN, HY_N_FILT), 0.05)),
        'hy_skip': nrm((N_EVEN, HY_ORDER, HY_W)),
        'da_lq1': nrm((N_EVEN, DA_HD), 0.1),
        'da_lk1': nrm((N_EVEN, DA_HD), 0.1),
        'da_lq2': nrm((N_EVEN, DA_HD), 0.1),
        'da_lk2': nrm((N_EVEN, DA_HD), 0.1),
        'da_subln_g': 1.0 + nrm((N_EVEN, DA_VD), 0.02),
        'rg_w_in': nrm((N_ODD, D, 2 * D_RNN), D ** -0.5),
        'rg_w_out': nrm((N_ODD, D_RNN, D), DN_BETA * D_RNN ** -0.5),
        'rg_conv_w': nrm((N_ODD, RG_CONV, D_RNN), RG_CONV ** -0.5),
        'rg_conv_b': nrm((N_ODD, D_RNN), 0.02),
        'rg_wa': nrm((N_ODD, 2, RG_BLOCKS, RG_BW, RG_BW), RG_BW ** -0.5),
        'rg_ba': nrm((N_ODD, 2, D_RNN), 0.02),
        'rg_wx': nrm((N_ODD, 2, RG_BLOCKS, RG_BW, RG_BW), RG_BW ** -0.5),
        'rg_bx': nrm((N_ODD, 2, D_RNN), 0.02),
        'rg_lambda': jnp.log(lam_s) - jnp.log1p(-lam_s),
        'router_w': nrm((DEPTH, D, N_EXPERTS), D ** -0.5),
        'router_bias': nrm((DEPTH, N_EXPERTS), 0.01),
        'ex_w_gate': nrm((DEPTH, N_EXPERTS, D, D_EXPERT), D ** -0.5),
        'ex_w_up': nrm((DEPTH, N_EXPERTS, D, D_EXPERT), D ** -0.5),
        'ex_w_down': nrm((DEPTH, N_EXPERTS, D_EXPERT, D), DN_BETA * D_EXPERT ** -0.5),
        'sh_w_gate': nrm((DEPTH, D, D_SHARED), D ** -0.5),
        'sh_w_up': nrm((DEPTH, D, D_SHARED), D ** -0.5),
        'sh_w_down': nrm((DEPTH, D_SHARED, D), DN_BETA * D_SHARED ** -0.5),
    }


def reference(x, c, ctx, c_ctx, w_mod, b_mod, ln1_g, ln1_b, ln2_g, ln2_b,
              ab_w_in, ab_w_out, hy_short_w, hy_short_b, hy_fw1, hy_fb1, hy_fw2, hy_fb2,
              hy_fw3, hy_fb3, hy_fw4, hy_freq, hy_decay, hy_skip,
              da_lq1, da_lk1, da_lq2, da_lk2, da_subln_g,
              rg_w_in, rg_w_out, rg_conv_w, rg_conv_b, rg_wa, rg_ba, rg_wx, rg_bx, rg_lambda,
              router_w, router_bias, ex_w_gate, ex_w_up, ex_w_down, sh_w_gate, sh_w_up, sh_w_down):
    xs, cs = x, ctx
    silu_c = jax.nn.silu(c)
    silu_cc = jax.nn.silu(c_ctx)
    for l in range(DEPTH):
        need_ctx = l < DEPTH - 1
        mod_l = (silu_c @ w_mod[l] + b_mod[l])[:, None, :]
        mod_c = (silu_cc @ w_mod[l] + b_mod[l])[None, None, :]
        sh_l, sc_l, g_l, shf_l, scf_l, gf_l = jnp.split(mod_l, N_MOD, axis=-1)
        sh_c, sc_c, g_c, shf_c, scf_c, gf_c = jnp.split(mod_c, N_MOD, axis=-1)
        hin_l = xs * (1.0 + sc_l) + sh_l
        hin_c = cs * (1.0 + sc_c) + sh_c
        if l % 2 == 0:
            e = l // 2
            filt_p = (hy_fw1[e], hy_fb1[e], hy_fw2[e], hy_fb2[e], hy_fw3[e], hy_fb3[e],
                      hy_fw4[e], hy_freq[e], hy_decay[e])
            lam_init = 0.8 - 0.6 * math.exp(-0.3 * l)
            m_c, m_l = ab_mixer(hin_c, hin_l, ab_w_in[e], ab_w_out[e], hy_short_w[e], hy_short_b[e],
                                filt_p, hy_skip[e], da_lq1[e], da_lk1[e], da_lq2[e], da_lk2[e],
                                da_subln_g[e], lam_init, need_ctx)
        else:
            o = l // 2
            m_c, m_l = rg_mixer(hin_c, hin_l, rg_w_in[o], rg_w_out[o], rg_conv_w[o], rg_conv_b[o],
                                rg_wa[o], rg_ba[o], rg_wx[o], rg_bx[o], rg_lambda[o], need_ctx)
        moe_p = (router_w[l], router_bias[l], ex_w_gate[l], ex_w_up[l], ex_w_down[l],
                 sh_w_gate[l], sh_w_up[l], sh_w_down[l])
        xs = layer_norm(DN_ALPHA * xs + g_l * m_l, ln1_g[l], ln1_b[l])
        xs = layer_norm(DN_ALPHA * xs + gf_l * moe(xs * (1.0 + scf_l) + shf_l, *moe_p), ln2_g[l], ln2_b[l])
        if need_ctx:
            cs = layer_norm(DN_ALPHA * cs + g_c * m_c, ln1_g[l], ln1_b[l])
            cs = layer_norm(DN_ALPHA * cs + gf_c * moe(cs * (1.0 + scf_c) + shf_c, *moe_p), ln2_g[l], ln2_b[l])
    return xs
```

```cpp
#include <hip/hip_runtime.h>
#include <stdint.h>
#include <math.h>

#define GAS __attribute__((address_space(1)))
#define LAS __attribute__((address_space(3)))
#define DI __device__ __forceinline__
typedef unsigned short bf16_t;
typedef short bf16x8 __attribute__((ext_vector_type(8)));
typedef float f32x4 __attribute__((ext_vector_type(4)));
typedef unsigned u32x4 __attribute__((ext_vector_type(4)));
typedef unsigned u32x2 __attribute__((ext_vector_type(2)));

constexpr int D = 1024, NB = 16, SEQ = 2048, CTXL = 256, DEPTH = 4;
constexpr int TL = NB * SEQ, TC = NB * CTXL, T = TL + TC;
constexpr float LN_EPS = 1e-5f;
constexpr float DN_ALPHA = 1.6817928305074290861f;
constexpr float C2 = 0.125f * 1.4426950408889634f;
constexpr int NTH = 512, NWV = 8;

constexpr size_t MiB = 1u << 20;
constexpr size_t WS_CTL = 0, CTL_BYTES = 1 * MiB;
constexpr size_t WS_MOD = 1 * MiB;
constexpr size_t WS_HDN = 3 * MiB;
constexpr size_t WS_ROPE = 5 * MiB;
constexpr size_t WS_KRL = 6 * MiB;
constexpr size_t WS_KRC = 22 * MiB;
constexpr size_t WS_WIN = 24 * MiB;
constexpr size_t WS_WOUT = 30 * MiB;
constexpr size_t WS_WG = 32 * MiB;
constexpr size_t WS_WGU = 36 * MiB;
constexpr size_t WS_WD = 101 * MiB;
constexpr size_t WS_XS = 134 * MiB;
constexpr size_t WS_HS = 278 * MiB;
constexpr size_t WS_BIG = 448 * MiB;
constexpr size_t B_PH = 0, B_QB = 108 * MiB, B_KB = 144 * MiB, B_VB = 180 * MiB, B_UC = 216 * MiB, B_YH = 324 * MiB, B_MIXA_E = 360 * MiB;
constexpr size_t B_GATE = 0, B_REC = 72 * MiB, B_U = 144 * MiB, B_LA = 216 * MiB, B_BB = 360 * MiB, B_MIXA_O = 504 * MiB;
constexpr size_t O_ABUF = 0, O_PW = 72 * MiB, O_LIST = 74 * MiB, O_CT = 84 * MiB, O_CARRY = 94 * MiB;
constexpr int CW_BAR = 4096, CW_CNT = 8192;

constexpr int LDS_SCR = 143360;
constexpr int LDS_MISC = LDS_SCR;
constexpr int LDS_TOFF = LDS_SCR + 256;
constexpr int LDS_BYTES = 147456;

DI float bf2f(bf16_t b) { return __uint_as_float(((unsigned)b) << 16); }
DI unsigned f2bf(float f) { unsigned u = __float_as_uint(f); return (u + 0x7fffu + ((u >> 16) & 1u)) >> 16; }
DI unsigned pk2(float lo, float hi) { return f2bf(lo) | (f2bf(hi) << 16); }
DI void store_bf4(bf16_t* p, f32x4 v) { u32x2 w; w.x = pk2(v[0], v[1]); w.y = pk2(v[2], v[3]); *(u32x2*)p = w; }
DI float wave_sum(float v) {
#pragma unroll
    for (int o = 1; o < 64; o <<= 1) v += __shfl_xor(v, o);
    return v;
}
DI float sigmoidf_(float x) { return 1.f / (1.f + __expf(-x)); }
#define LDS_WAIT() asm volatile("s_waitcnt lgkmcnt(0)" ::: "memory")
DI int otid() { int t = threadIdx.x; asm volatile("" : "+v"(t)); return t; }
DI int obid() { int b = blockIdx.x; asm volatile("" : "+s"(b)); return b; }

#define XB_TMO      128
#define XB_XCNT(j)  (256  + 64 * (j))
#define XB_XSUB(j)  (1280 + 64 * (j))
#define XB_XGEN(j)  (2304 + 64 * (j))
#define XB_TOP      3328
#define XB_TOPGEN   3392
#define XCD_BAR_WORDS 3456
#define XB_SPIN_CAP (1u << 22)
DI unsigned xb_ld(unsigned* p)              { return __hip_atomic_load(p, __ATOMIC_RELAXED, __HIP_MEMORY_SCOPE_AGENT); }
DI unsigned xb_add(unsigned* p, unsigned v) { return __hip_atomic_fetch_add(p, v, __ATOMIC_RELAXED, __HIP_MEMORY_SCOPE_AGENT); }
DI unsigned xb_xcc_id() { return (unsigned)__builtin_amdgcn_s_getreg((3 << 11) | 20) & 0xFu; }
#define XB_SPIN(cond, bar) do { unsigned _sp = 0; while (cond) { __builtin_amdgcn_s_sleep(1); \
    if ((++_sp & 255u) == 0u) { if (xb_ld(&(bar)[XB_TMO])) break; if (_sp > XB_SPIN_CAP) { atomicAdd(&(bar)[XB_TMO], 1u); break; } } } } while (0)
struct XcdBarrier { unsigned* bar; unsigned x; volatile LAS unsigned* st; };
DI XcdBarrier xcd_barrier_post(unsigned* bar, volatile LAS unsigned* st) {
    XcdBarrier b; b.bar = bar; b.x = xb_xcc_id(); b.st = st;
    if (threadIdx.x == 0) (void)xb_add(&bar[XB_XCNT(b.x)], 1u);
    return b;
}
DI void xcd_barrier_complete(unsigned* bar, unsigned x, unsigned& nloc, unsigned& nx) {
    const unsigned G = gridDim.x * gridDim.y * gridDim.z;
    unsigned sum, cnt, mine, sp = 0u;
    for (;;) {
        sum = 0u; cnt = 0u; mine = 0u;
#pragma unroll
        for (unsigned j = 0; j < 16; ++j) { const unsigned c = xb_ld(&bar[XB_XCNT(j)]); sum += c; cnt += (c > 0u) ? 1u : 0u; mine = (j == x) ? c : mine; }
        if (sum == G) break;
        __builtin_amdgcn_s_sleep(1);
        if ((++sp & 255u) == 0u) { if (xb_ld(&bar[XB_TMO])) break; if (sp > XB_SPIN_CAP) { atomicAdd(&bar[XB_TMO], 1u); break; } }
    }
    nloc = mine > 0u ? mine : 1u; nx = cnt > 0u ? cnt : 1u;
}
DI void xcd_barrier(const XcdBarrier& b) {
    asm volatile("s_waitcnt vmcnt(0)" ::: "memory");
    __syncthreads();
    if (threadIdx.x == 0) {
        unsigned* bar = b.bar;
        __builtin_amdgcn_s_waitcnt(0);
        unsigned nloc = b.st[0], nx = b.st[1];
        if (nloc == 0u) { xcd_barrier_complete(bar, xb_xcc_id(), nloc, nx); b.st[0] = nloc; b.st[1] = nx; }
        const unsigned bx_ = xb_xcc_id();
        const unsigned old = xb_add(&bar[XB_XSUB(bx_)], 1u);
        const unsigned gen = old / nloc;
        if (old + 1u == (gen + 1u) * nloc) {
            __builtin_amdgcn_fence(__ATOMIC_RELEASE, "agent");
            asm volatile("s_waitcnt vmcnt(0)" ::: "memory");
            const unsigned og = xb_add(&bar[XB_TOP], 1u);
            const unsigned tg = og / nx;
            if (og + 1u == (tg + 1u) * nx) xb_add(&bar[XB_TOPGEN], 1u);
            else XB_SPIN(xb_ld(&bar[XB_TOPGEN]) == tg, bar);
            __builtin_amdgcn_fence(__ATOMIC_ACQUIRE, "agent");
            xb_add(&bar[XB_XGEN(bx_)], 1u);
            asm volatile("s_waitcnt vmcnt(0)" ::: "memory");
        } else {
            XB_SPIN(xb_ld(&bar[XB_XGEN(bx_)]) == gen, bar);
            __builtin_amdgcn_fence(__ATOMIC_ACQUIRE, "agent");
            asm volatile("s_waitcnt vmcnt(0)" ::: "memory");
        }
    }
    __syncthreads();
}

struct Args { const float* in[46]; float* out; unsigned char* ws; };
enum { I_X = 0, I_C, I_CTX, I_CCTX, I_WMOD, I_BMOD, I_LN1G, I_LN1B, I_LN2G, I_LN2B, I_ABWIN, I_ABWOUT, I_HYSW, I_HYSB, I_FW1, I_FB1, I_FW2, I_FB2,
       I_FW3, I_FB3, I_FW4, I_FREQ, I_DECAY, I_SKIP, I_LQ1, I_LK1, I_LQ2, I_LK2, I_SUBG, I_RGWIN, I_RGWOUT, I_RGCW, I_RGCB, I_RGWA, I_RGBA, I_RGWX, I_RGBX,
       I_RGLAM, I_ROUTW, I_ROUTB, I_EXG, I_EXU, I_EXD, I_SHG, I_SHU, I_SHD };

struct GU { const bf16_t* A; const bf16_t* B; int pm, pn, e, ti, nvalid; };

DI f32x4 mfma16(bf16x8 a, bf16x8 b, f32x4 c) { return __builtin_amdgcn_mfma_f32_16x16x32_bf16(a, b, c, 0, 0, 0); }

template <class Sched, class Epi>
DI void gemm_naive(const Sched& S, const Epi& E, int K, int ldb) {
    const int tid = otid(), wave = tid >> 6, lane = tid & 63, fr = lane & 15, fq = lane >> 4;
    GU u;
    for (int i = 0; S.next(i, u); ++i) {
        for (int task = wave; task < 64; task += NWV) {
            const int rg = task >> 2, c0 = (task & 3) * 32, r = rg * 16 + fr;
            const bf16_t* arow = u.A + S.arow_off(u, r) + 8 * fq;
            const bf16_t* b00 = u.B + (size_t)(c0 + fr) * ldb + 8 * fq;
            const bf16_t* b01 = b00 + (size_t)16 * ldb; const bf16_t* b10 = b00 + (size_t)128 * ldb; const bf16_t* b11 = b00 + (size_t)144 * ldb;
            f32x4 a0 = {0.f, 0.f, 0.f, 0.f}, a1 = a0, b0 = a0, b1 = a0;
            for (int k0 = 0; k0 < K; k0 += 32) {
                const bf16x8 af = *(const bf16x8*)(arow + k0);
                const bf16x8 w00 = *(const bf16x8*)(b00 + k0), w01 = *(const bf16x8*)(b01 + k0), w10 = *(const bf16x8*)(b10 + k0), w11 = *(const bf16x8*)(b11 + k0);
                a0 = mfma16(w00, af, a0); a1 = mfma16(w01, af, a1); b0 = mfma16(w10, af, b0); b1 = mfma16(w11, af, b1);
            }
            E(u, r, c0 + 4 * fq, a0, a1, b0, b1);
        }
    }
}

namespace pg8 {
constexpr int BK = 64, HALF = 128, HTB = HALF * BK * 2, STAGE_BYTES = 8 * HTB;
DI int lds_byte(int r, int c) { const int st = (r >> 4) * 2 + (c >> 5), rr = r & 15, cc = c & 31, ob = rr * 64 + cc * 2; return st * 1024 + (ob ^ (((ob >> 9) & 1) << 5)); }
DI void stage_rc(int b, int& R, int& C) { const int st = b / 1024, sb = b % 1024, swz = sb ^ (((sb >> 9) & 1) << 5); R = (st >> 1) * 16 + swz / 64; C = (st & 1) * 32 + (swz % 64) / 2; }
}
DI const char* uni_ptr(const void* p) { const unsigned long long v = (unsigned long long)p; const unsigned lo = __builtin_amdgcn_readfirstlane((unsigned)v), hi = __builtin_amdgcn_readfirstlane((unsigned)(v >> 32)); return (const char*)(((unsigned long long)hi << 32) | lo); }
template <class Sched, class Epi>
DI void gemm_fast(LAS unsigned char* lds, const Sched& S, const Epi& E, const int K, const int ldb) {
    using namespace pg8;
    const int tid = otid(), wid = __builtin_amdgcn_readfirstlane(tid >> 6), lane = tid & 63, wr = wid >> 2, wc = wid & 3, fr = lane & 15, fq = lane >> 4;
    const int nt = K / BK;
    int R0, C0, R1, C1; stage_rc(tid * 16, R0, C0); stage_rc(tid * 16 + 8192, R1, C1);
    unsigned voffB[2]; voffB[0] = (unsigned)(R0 * ldb + C0) * 2u; voffB[1] = (unsigned)(R1 * ldb + C1) * 2u;
    GU cur, nxt; int ui = 0;
    if (!S.next(0, cur)) return;
    const size_t lda_ = S.arow_off(cur, 1);
    unsigned voffA[2]; voffA[0] = (unsigned)(R0 * lda_ + C0) * 2u; voffA[1] = (unsigned)(R1 * lda_ + C1) * 2u;
    const size_t kstep = (size_t)(BK * 2), hstepB = (size_t)HALF * ldb * 2, hstepA = (size_t)HALF * lda_ * 2;
    const unsigned ldsw = (unsigned)wid * 1024u;
    const int aoff = lds_byte(wr * 64 + fr, fq * 8), boff = lds_byte(wc * 32 + fr, fq * 8);
#define PG8_SA(b, h) (((b) * 2 + (h)) * HTB)
#define PG8_SB(b, h) ((4 + (b) * 2 + (h)) * HTB)
#define PG8_GLDS(gp, ldsoff) __builtin_amdgcn_global_load_lds((const unsigned*)(gp), (LAS unsigned*)(lds + (ldsoff)), 16, 0, 0)
#define PG8_STAGE_B(bufoff, gbase) do { PG8_GLDS((const char*)(gbase) + voffB[0], (bufoff) + ldsw); PG8_GLDS((const char*)(gbase) + voffB[1], (bufoff) + ldsw + 8192); } while (0)
#define PG8_STAGE_A(bufoff, gbase, h, o0, o1) do { if constexpr (Sched::GATHER) { PG8_GLDS((const char*)(gbase) + (o0), (bufoff) + ldsw); PG8_GLDS((const char*)(gbase) + (o1), (bufoff) + ldsw + 8192); } \
        else { PG8_GLDS((const char*)(gbase) + (h) * hstepA + voffA[0], (bufoff) + ldsw); PG8_GLDS((const char*)(gbase) + (h) * hstepA + voffA[1], (bufoff) + ldsw + 8192); } } while (0)
#define PG8_LDA(dst, b, h) do { _Pragma("unroll") for (int m = 0; m < 4; ++m) _Pragma("unroll") for (int k = 0; k < 2; ++k) dst[m][k] = *(const LAS bf16x8*)(lds + PG8_SA(b, h) + aoff + m * 2048 + k * 1024); } while (0)
#define PG8_LDB(dst, b, h) do { _Pragma("unroll") for (int n = 0; n < 2; ++n) _Pragma("unroll") for (int k = 0; k < 2; ++k) dst[n][k] = *(const LAS bf16x8*)(lds + PG8_SB(b, h) + boff + n * 2048 + k * 1024); } while (0)
#define PG8_MMA(ai, bj, At, Bt) do { __builtin_amdgcn_s_setprio(1); _Pragma("unroll") for (int m = 0; m < 4; ++m) _Pragma("unroll") for (int n = 0; n < 2; ++n) _Pragma("unroll") for (int k = 0; k < 2; ++k) \
        acc[ai][bj][m][n] = __builtin_amdgcn_mfma_f32_16x16x32_bf16(Bt[n][k], At[m][k], acc[ai][bj][m][n], 0, 0, 0); __builtin_amdgcn_s_setprio(0); } while (0)
#define PG8_WAIT_V(n) asm volatile("s_waitcnt vmcnt(" #n ")" ::: "memory")
#define PG8_WAIT_L(n) asm volatile("s_waitcnt lgkmcnt(" #n ")" ::: "memory")
#define PG8_BAR __builtin_amdgcn_s_barrier()
#define PG8_SCHED __builtin_amdgcn_sched_barrier(0)
#define PG8_AOFFS(d00, d01, d10, d11, u) do { if constexpr (Sched::GATHER) { d00 = (unsigned)(S.arow_off(u, R0) + C0) * 2u; d01 = (unsigned)(S.arow_off(u, R1) + C1) * 2u; \
        d10 = (unsigned)(S.arow_off(u, R0 + 128) + C0) * 2u; d11 = (unsigned)(S.arow_off(u, R1 + 128) + C1) * 2u; } } while (0)
    f32x4 acc[2][2][4][2];
#pragma unroll
    for (int a_ = 0; a_ < 2; ++a_)
#pragma unroll
        for (int b_ = 0; b_ < 2; ++b_)
#pragma unroll
            for (int m = 0; m < 4; ++m)
#pragma unroll
                for (int n = 0; n < 2; ++n) acc[a_][b_][m][n] = (f32x4){0.f, 0.f, 0.f, 0.f};
    bf16x8 At[4][2], B0[2][2], B1[2][2];
    const char* cA = uni_ptr(cur.A); const char* cB = uni_ptr(cur.B);
    unsigned c00 = 0, c01 = 0, c10 = 0, c11 = 0, n00 = 0, n01 = 0, n10 = 0, n11 = 0;
    PG8_AOFFS(c00, c01, c10, c11, cur);
    PG8_STAGE_B(PG8_SB(0, 0), cB); PG8_STAGE_B(PG8_SB(0, 1), cB + hstepB); PG8_STAGE_A(PG8_SA(0, 0), cA, 0, c00, c01); PG8_STAGE_A(PG8_SA(0, 1), cA, 1, c10, c11);
    if (wr == 1) PG8_BAR;
    PG8_WAIT_V(2); PG8_BAR;
    PG8_STAGE_B(PG8_SB(1, 0), cB + kstep); PG8_STAGE_A(PG8_SA(1, 0), cA + kstep, 0, c00, c01); PG8_STAGE_B(PG8_SB(1, 1), cB + hstepB + kstep);
    PG8_WAIT_V(6); PG8_BAR;
    for (;;) {
        const bool has_next = S.next(ui + 1, nxt);
        const char* nA = has_next ? uni_ptr(nxt.A) : cA; const char* nB = has_next ? uni_ptr(nxt.B) : cB;
        if (has_next) { PG8_AOFFS(n00, n01, n10, n11, nxt); } else { n00 = c00; n01 = c01; n10 = c10; n11 = c11; }
        for (int t = 0; t < nt; t += 2) {
            const bool last = (t == nt - 2);
            const char* a1 = cA + (size_t)(t + 1) * kstep;
            const char* a2 = last ? nA : cA + (size_t)(t + 2) * kstep; const char* b2 = last ? nB : cB + (size_t)(t + 2) * kstep;
            const char* a3 = a2 + kstep; const char* b3 = b2 + kstep;
            asm volatile("" : "+s"(a1), "+s"(a2), "+s"(b2), "+s"(a3), "+s"(b3));
            const unsigned o00 = last ? n00 : c00, o01 = last ? n01 : c01, o10 = last ? n10 : c10, o11 = last ? n11 : c11;
            PG8_LDB(B0, 0, 0); PG8_LDB(B1, 0, 1); PG8_SCHED; PG8_LDA(At, 0, 0); PG8_STAGE_A(PG8_SA(1, 1), a1, 1, c10, c11);
            PG8_WAIT_V(8); PG8_WAIT_L(0); PG8_BAR; PG8_MMA(0, 0, At, B0); PG8_MMA(0, 1, At, B1); PG8_BAR; PG8_SCHED;
            PG8_LDA(At, 0, 1); PG8_STAGE_B(PG8_SB(0, 0), b2); PG8_STAGE_B(PG8_SB(0, 1), b2 + hstepB); PG8_STAGE_A(PG8_SA(0, 0), a2, 0, o00, o01);
            PG8_WAIT_V(8); PG8_WAIT_L(0); PG8_BAR; PG8_MMA(1, 0, At, B0); PG8_MMA(1, 1, At, B1); PG8_BAR; PG8_SCHED;
            PG8_LDB(B0, 1, 0); PG8_LDB(B1, 1, 1); PG8_SCHED; PG8_LDA(At, 1, 0); PG8_STAGE_A(PG8_SA(0, 1), a2, 1, o10, o11);
            PG8_WAIT_V(8); PG8_WAIT_L(0); PG8_BAR; PG8_MMA(0, 0, At, B0); PG8_MMA(0, 1, At, B1); PG8_BAR; PG8_SCHED;
            PG8_LDA(At, 1, 1); PG8_STAGE_B(PG8_SB(1, 0), b3); PG8_STAGE_B(PG8_SB(1, 1), b3 + hstepB); PG8_STAGE_A(PG8_SA(1, 0), a3, 0, o00, o01);
            PG8_WAIT_V(8); PG8_WAIT_L(0); PG8_BAR; PG8_MMA(1, 0, At, B0); PG8_MMA(1, 1, At, B1); PG8_BAR; PG8_SCHED;
        }
        if (wr == 0) PG8_BAR;
        { int tz = threadIdx.x; asm volatile("" : "+v"(tz));
          const int wz = tz >> 6, lz = tz & 63, wrz = wz >> 2, wcz = wz & 3, frz = lz & 15, fqz = lz >> 4;
#pragma unroll
        for (int ai = 0; ai < 2; ++ai)
#pragma unroll
            for (int m = 0; m < 4; ++m) { E(cur, ai * HALF + wrz * 64 + m * 16 + frz, wcz * 32 + 4 * fqz, acc[ai][0][m][0], acc[ai][0][m][1], acc[ai][1][m][0], acc[ai][1][m][1]); asm volatile("" ::: "memory"); }
        }
        if (!has_next) break;
#pragma unroll
        for (int a_ = 0; a_ < 2; ++a_)
#pragma unroll
            for (int b_ = 0; b_ < 2; ++b_)
#pragma unroll
                for (int m = 0; m < 4; ++m)
#pragma unroll
                    for (int n = 0; n < 2; ++n) acc[a_][b_][m][n] = (f32x4){0.f, 0.f, 0.f, 0.f};
        cur = nxt; cA = nA; cB = nB; c00 = n00; c01 = n01; c10 = n10; c11 = n11; ++ui;
        if (wr == 1) PG8_BAR;
    }
    PG8_WAIT_V(0);
    PG8_BAR;
#undef PG8_SA
#undef PG8_SB
#undef PG8_GLDS
#undef PG8_STAGE_A
#undef PG8_STAGE_B
#undef PG8_LDA
#undef PG8_LDB
#undef PG8_MMA
#undef PG8_WAIT_V
#undef PG8_WAIT_L
#undef PG8_BAR
#undef PG8_SCHED
#undef PG8_AOFFS
}
template <bool FAST, class Sched, class Epi>
DI void gemm_units(LAS unsigned char* lds, const Sched& S, const Epi& E, int K, int ldb) { if constexpr (FAST) gemm_fast(lds, S, E, K, ldb); else gemm_naive(S, E, K, ldb); }

struct SchedDense {
    static constexpr bool GATHER = false;
    const bf16_t* A; const bf16_t* B; int lda, ldb, nM, nN, G, c;
    DI bool next(int i, GU& u) const { const int L = i * G + c; if (L >= nM * nN) return false; u.pm = L / nN; u.pn = L % nN;
        u.A = A + (size_t)u.pm * 256 * lda; u.B = B + (size_t)u.pn * 256 * ldb; u.e = 0; u.ti = 0; u.nvalid = 256; return true; }
    DI size_t arow_off(const GU&, int r) const { return (size_t)r * lda; }
};
struct SchedGates {
    static constexpr bool GATHER = false;
    const bf16_t* A; const bf16_t* B; int nM, G, c;
    DI bool next(int i, GU& u) const { const int L = i * G + c; if (L >= nM * 16) return false; u.pm = L >> 4; u.pn = L & 15;
        u.A = A + (size_t)u.pm * 256 * 1024 + (u.pn >> 2) * 256; u.B = B + (size_t)u.pn * 256 * 256; u.e = 0; u.ti = 0; u.nvalid = 256; return true; }
    DI size_t arow_off(const GU&, int r) const { return (size_t)r * 1024; }
};
struct SchedMoe {
    static constexpr bool GATHER = true;
    const bf16_t* A; const bf16_t* B; const int* cnt; const int* list; volatile LAS int* toff; int NT, NJ, G, c; bool gather; size_t bstride;
    DI bool next(int i, GU& u) const { const int L = i * G + c; if (L >= NT * NJ) return false; const int rt = L / NJ; u.pn = L % NJ; u.pm = rt;
        int e = 0; while (e < 64 && toff[e + 1] <= rt) ++e;
        u.e = e; u.ti = rt - toff[e]; const int cn = (e < 64) ? cnt[e] : 0x7fffffff; const int rem = cn - u.ti * 256; u.nvalid = rem < 256 ? rem : 256;
        u.A = gather ? A : A + (size_t)rt * 256 * 256; u.B = B + (size_t)e * bstride + (size_t)u.pn * 256 * (gather ? 1024 : 256); return true; }
    DI size_t arow_off(const GU& u, int r) const {
        if (!gather) return (size_t)r * 256;
        int tok; if (u.e < 64) tok = (r < u.nvalid) ? (list[(size_t)u.e * T + u.ti * 256 + r] >> 3) : 0; else tok = u.ti * 256 + r;
        return (size_t)tok * 1024; }
};

struct EpiAbIn { bf16_t *PH, *QB, *KB, *VB; const float* rope;
    DI void put(int row, int col, f32x4 v0, f32x4 v1) const {
        if (col < 1536) { store_bf4(PH + (size_t)row * 1536 + col, v0); store_bf4(PH + (size_t)row * 1536 + col + 16, v1); }
        else if (col < 2560) { int cc = col - 1536; bf16_t* dst = cc < 512 ? QB : KB; const float sc = cc < 512 ? C2 : 1.f; cc &= 511;
            if (row < TL) { const int d = cc & 63, axis = d >> 5, f0 = d & 15, pos = row & (SEQ - 1), p = axis ? (pos & 63) : (pos >> 6);
#pragma unroll
                for (int j = 0; j < 4; ++j) { const float cs = rope[(p * 16 + f0 + j) * 2], sn = rope[(p * 16 + f0 + j) * 2 + 1]; const float xa = v0[j], xb = v1[j];
                    v0[j] = xa * cs - xb * sn; v1[j] = xb * cs + xa * sn; } }
            v0 = v0 * sc; v1 = v1 * sc; store_bf4(dst + (size_t)row * 512 + cc, v0); store_bf4(dst + (size_t)row * 512 + cc + 16, v1); }
        else { const int cc = col - 2560; store_bf4(VB + (size_t)row * 512 + cc, v0); store_bf4(VB + (size_t)row * 512 + cc + 16, v1); }
    }
    DI void operator()(const GU& u, int rl, int cl, f32x4 a0, f32x4 a1, f32x4 b0, f32x4 b1) const {
        const int row = u.pm * 256 + rl, col = u.pn * 256 + cl; put(row, col, a0, a1); put(row, col + 128, b0, b1); }
};
DI float gelu_tanh(float x) { const float y = 0.7978845608028654f * (x + 0.044715f * x * x * x); const float t = 1.f - 2.f / (1.f + __expf(2.f * y)); return 0.5f * x * (1.f + t); }
struct EpiRgIn { bf16_t *GATE, *REC;
    DI void put(int row, int col, f32x4 v) const {
        if (col < 1024) { f32x4 g;
#pragma unroll
            for (int j = 0; j < 4; ++j) g[j] = gelu_tanh(v[j]);
            store_bf4(GATE + (size_t)row * 1024 + col, g); }
        else store_bf4(REC + (size_t)row * 1024 + col - 1024, v); }
    DI void operator()(const GU& u, int rl, int cl, f32x4 a0, f32x4 a1, f32x4 b0, f32x4 b1) const {
        const int row = u.pm * 256 + rl, col = u.pn * 256 + cl; put(row, col, a0); put(row, col + 16, a1); put(row, col + 128, b0); put(row, col + 144, b1); }
};
struct EpiOut { float* XS; const float* modl;
    DI void put(int row, int col, f32x4 v) const { const int mrow = row < TL ? (row >> 11) : 16; const f32x4 g = *(const f32x4*)(modl + mrow * 6144 + 2048 + col);
        float* p = XS + (size_t)row * 1024 + col; const f32x4 x = *(const f32x4*)p; *(f32x4*)p = x * DN_ALPHA + g * v; }
    DI void operator()(const GU& u, int rl, int cl, f32x4 a0, f32x4 a1, f32x4 b0, f32x4 b1) const {
        const int row = u.pm * 256 + rl, col = u.pn * 256 + cl; put(row, col, a0); put(row, col + 16, a1); put(row, col + 128, b0); put(row, col + 144, b1); }
};
struct EpiGates { const bf16_t* U; bf16_t *LA, *BB; const float *ba, *bx, *lam;
    DI void put(int row, int dir, int ch, f32x4 ra, f32x4 ia) const {
        const u32x2 uu = *(const u32x2*)(U + (size_t)row * 1024 + ch); float uv[4] = {__uint_as_float(uu.x << 16), __uint_as_float(uu.x & 0xffff0000u), __uint_as_float(uu.y << 16), __uint_as_float(uu.y & 0xffff0000u)};
        f32x4 la, bb;
#pragma unroll
        for (int j = 0; j < 4; ++j) { const int cidx = dir * 1024 + ch + j; const float r = sigmoidf_(ra[j] + ba[cidx]), ig = sigmoidf_(ia[j] + bx[cidx]);
            const float lm = lam[cidx]; const float lsg = -log1pf(__expf(-lm)); const float l = 8.f * r * lsg; la[j] = l; bb[j] = sqrtf(-expm1f(2.f * l)) * ig * uv[j]; }
        store_bf4(LA + ((size_t)dir * T + row) * 1024 + ch, la); store_bf4(BB + ((size_t)dir * T + row) * 1024 + ch, bb); }
    DI void operator()(const GU& u, int rl, int cl, f32x4 a0, f32x4 a1, f32x4 b0, f32x4 b1) const {
        const int row = u.pm * 256 + rl, k = u.pn >> 1, dir = u.pn & 1, ch = k * 128 + cl; put(row, dir, ch, a0, b0); put(row, dir, ch + 16, a1, b1); }
};
struct EpiGU { bf16_t* HS;
    DI void put(size_t hrow, int hc, f32x4 g, f32x4 up) const { f32x4 h;
#pragma unroll
        for (int j = 0; j < 4; ++j) h[j] = g[j] * sigmoidf_(g[j]) * up[j];
        store_bf4(HS + hrow * 256 + hc, h); }
    DI void operator()(const GU& u, int rl, int cl, f32x4 a0, f32x4 a1, f32x4 b0, f32x4 b1) const {
        const size_t hrow = (size_t)u.pm * 256 + rl; const int hc = u.pn * 128 + cl; put(hrow, hc, a0, b0); put(hrow, hc + 16, a1, b1); }
};
struct EpiDn { bf16_t* Y; float* XS; const int* list; const float* pw; const float* modl;
    DI void operator()(const GU& u, int rl, int cl, f32x4 a0, f32x4 a1, f32x4 b0, f32x4 b1) const {
        const int col = u.pn * 256 + cl;
        if (u.e < 64) { if (rl < u.nvalid) { const int pair = list[(size_t)u.e * T + u.ti * 256 + rl]; const float w = pw[pair]; bf16_t* y = Y + (size_t)pair * 1024 + col;
                store_bf4(y, a0 * w); store_bf4(y + 16, a1 * w); store_bf4(y + 128, b0 * w); store_bf4(y + 144, b1 * w); } }
        else { const int row = u.ti * 256 + rl; const int mrow = row < TL ? (row >> 11) : 16; const float* gp = modl + mrow * 6144 + 5120 + col; float* p = XS + (size_t)row * 1024 + col;
            *(f32x4*)p = *(const f32x4*)p * DN_ALPHA + *(const f32x4*)gp * a0; *(f32x4*)(p + 16) = *(const f32x4*)(p + 16) * DN_ALPHA + *(const f32x4*)(gp + 16) * a1;
            *(f32x4*)(p + 128) = *(const f32x4*)(p + 128) * DN_ALPHA + *(const f32x4*)(gp + 128) * b0; *(f32x4*)(p + 144) = *(const f32x4*)(p + 144) * DN_ALPHA + *(const f32x4*)(gp + 144) * b1; }
    }
};

DI void phase_mod(const Args& a, LAS unsigned char* lds) {
    LAS float* sc = (LAS float*)lds;
    LAS float* red = sc + 17 * 1024;
    float* MOD = (float*)(a.ws + WS_MOD);
    const int tid = otid(), wave = tid >> 6, lane = tid & 63;
    for (int i = tid; i < 17 * 1024; i += NTH) { const float v = (i < 16384) ? a.in[I_C][i] : a.in[I_CCTX][i - 16384]; sc[i] = v / (1.f + expf(-v)); }
    __syncthreads();
    for (int unit = obid(); unit < 4 * 96; unit += gridDim.x) {
        const int l = unit / 96, n0 = (unit % 96) * 64;
        const float* W = a.in[I_WMOD] + (size_t)l * 1024 * 6144 + n0 + lane;
        float acc[17];
#pragma unroll
        for (int r = 0; r < 17; ++r) acc[r] = 0.f;
        for (int k = wave * 128; k < wave * 128 + 128; ++k) { const float w = W[(size_t)k * 6144];
#pragma unroll
            for (int r = 0; r < 17; ++r) acc[r] += sc[r * 1024 + k] * w; }
#pragma unroll
        for (int r = 0; r < 17; ++r) red[(wave * 17 + r) * 64 + lane] = acc[r];
        __syncthreads();
        for (int i = tid; i < 17 * 64; i += NTH) { const int r = i >> 6, ln = i & 63; float s = 0.f;
#pragma unroll
            for (int w = 0; w < 8; ++w) s += red[(w * 17 + r) * 64 + ln];
            MOD[((size_t)l * 17 + r) * 6144 + n0 + ln] = s + a.in[I_BMOD][l * 6144 + n0 + ln]; }
        __syncthreads();
    }
}
DI void phase_hdn(const Args& a) {
    float* HDN = (float*)(a.ws + WS_HDN);
    const int tid = otid(); const int lane = tid & 63, gw = obid() * NWV + (tid >> 6), NGW = gridDim.x * NWV;
    for (int task = gw; task < 2 * 2304; task += NGW) {
        const int e = task / 2304, p = task % 2304, nsel = p >= 2048, t = nsel ? p - 2048 : p, n = nsel ? 256 : 2048;
        const float tt = (float)t / (float)(n - 1);
        const float fm = 1e-4f + (float)(lane & 15) * ((15.f - 1e-4f) / 15.f);
        const float ang = (6.283185307179586f / (float)n) * (float)t * fm;
        const float cs = cosf(ang), sn = sinf(ang);
        const float* w1 = a.in[I_FW1] + e * 33 * 64; const float* w2 = a.in[I_FW2] + e * 64 * 64; const float* w3 = a.in[I_FW3] + e * 64 * 64;
        const float fr = a.in[I_FREQ][e * 64 + lane];
        float s = tt * w1[lane];
#pragma unroll
        for (int m = 0; m < 16; ++m) { s += __shfl(cs, m) * w1[(1 + m) * 64 + lane]; s -= __shfl(sn, m) * w1[(17 + m) * 64 + lane]; }
        float h = sinf(fr * (s + a.in[I_FB1][e * 64 + lane]));
        s = 0.f;
#pragma unroll 8
        for (int i = 0; i < 64; ++i) s += __shfl(h, i) * w2[i * 64 + lane];
        h = sinf(fr * (s + a.in[I_FB2][e * 64 + lane]));
        s = 0.f;
#pragma unroll 8
        for (int i = 0; i < 64; ++i) s += __shfl(h, i) * w3[i * 64 + lane];
        h = sinf(fr * (s + a.in[I_FB3][e * 64 + lane]));
        HDN[(size_t)task * 64 + lane] = h;
    }
}
DI void phase_rope(const Args& a) {
    float* R = (float*)(a.ws + WS_ROPE);
    const int gt = obid() * NTH + otid();
    if (gt < 64 * 16) { const int p = gt >> 4, f = gt & 15; const float inv = powf(10000.f, -(float)f / 16.f); const float ang = (float)p * inv; R[gt * 2] = cosf(ang); R[gt * 2 + 1] = sinf(ang); }
}
DI void transpose_item(const float* W, int ldw, bf16_t* WT, int ldt, int k0, int n0, int drow0, int dcol0, LAS float* scr, int lane) {
#pragma unroll 8
    for (int i = 0; i < 32; ++i) { const int kk = 2 * i + (lane >> 5); scr[kk * 33 + (lane & 31)] = W[(size_t)(k0 + kk) * ldw + n0 + (lane & 31)]; }
    LDS_WAIT();
    const int c = lane & 7;
#pragma unroll
    for (int j = 0; j < 4; ++j) { const int n = (lane >> 3) + 8 * j; const LAS float* s = scr + (8 * c) * 33 + n;
        u32x4 o; o.x = pk2(s[0 * 33], s[1 * 33]); o.y = pk2(s[2 * 33], s[3 * 33]); o.z = pk2(s[4 * 33], s[5 * 33]); o.w = pk2(s[6 * 33], s[7 * 33]);
        *(u32x4*)(WT + (size_t)(drow0 + n) * ldt + dcol0 + 8 * c) = o; }
    LDS_WAIT();
}
DI void phase_weights(const Args& a, int l, LAS unsigned char* lds) {
    const int tid = otid(), wave = tid >> 6, lane = tid & 63, gw = obid() * NWV + wave, NGW = gridDim.x * NWV;
    LAS float* scr = (LAS float*)(lds + wave * 16384);
    bf16_t* WIN = (bf16_t*)(a.ws + WS_WIN); bf16_t* WOUT = (bf16_t*)(a.ws + WS_WOUT); bf16_t* WG = (bf16_t*)(a.ws + WS_WG);
    bf16_t* WGU = (bf16_t*)(a.ws + WS_WGU); bf16_t* WD = (bf16_t*)(a.ws + WS_WD);
    const int half = l >> 1;
    if ((l & 1) == 0) {
        const float* win = a.in[I_ABWIN] + (size_t)half * 1024 * 3072; const float* wout = a.in[I_ABWOUT] + (size_t)half * 1024 * 1024;
        for (int it = gw; it < 1536 + 512; it += NGW) {
            if (it < 1536) { const int kb = it / 96, nb = it % 96; transpose_item(win, 3072, WIN, 1024, kb * 64, nb * 32, nb * 32, kb * 64, scr, lane); }
            else { const int r = it - 1536, kb = r / 32, nb = r % 32; transpose_item(wout, 1024, WOUT, 1024, kb * 64, nb * 32, nb * 32, kb * 64, scr, lane); }
        }
    } else {
        const float* win = a.in[I_RGWIN] + (size_t)half * 1024 * 2048; const float* wout = a.in[I_RGWOUT] + (size_t)half * 1024 * 1024;
        for (int it = gw; it < 1024 + 512; it += NGW) {
            if (it < 1024) { const int kb = it / 64, nb = it % 64; transpose_item(win, 2048, WIN, 1024, kb * 64, nb * 32, nb * 32, kb * 64, scr, lane); }
            else { const int r = it - 1024, kb = r / 32, nb = r % 32; transpose_item(wout, 1024, WOUT, 1024, kb * 64, nb * 32, nb * 32, kb * 64, scr, lane); }
        }
        const float* wa = a.in[I_RGWA] + (size_t)half * 2 * 8 * 128 * 128; const float* wx = a.in[I_RGWX] + (size_t)half * 2 * 8 * 128 * 128;
        for (int idx = obid() * NTH + tid; idx < 4096 * 256; idx += gridDim.x * NTH) {
            const int n = idx >> 8, kk = idx & 255, pn = n >> 8, hf = (n >> 7) & 1, c = n & 127, k = pn >> 1, dir = pn & 1;
            float v = 0.f; if ((kk >> 7) == (k & 1)) v = (hf ? wx : wa)[(((size_t)dir * 8 + k) * 128 + (kk & 127)) * 128 + c];
            WG[idx] = (bf16_t)f2bf(v);
        }
    }
    for (int it = gw; it < 65 * 384; it += NGW) {
        const int e = it / 384, m = (it % 384) >> 7, r = it & 127;
        if (m < 2) { const float* src = (e < 64) ? a.in[m ? I_EXU : I_EXG] + ((size_t)l * 64 + e) * 1024 * 256 : a.in[m ? I_SHU : I_SHG] + (size_t)l * 1024 * 256;
            const int kb = r >> 3, nb = r & 7, n0 = nb * 32; const int drow0 = (n0 >> 7) * 256 + (n0 & 127) + (m ? 128 : 0);
            transpose_item(src, 256, WGU + (size_t)e * 512 * 1024, 1024, kb * 64, n0, drow0, kb * 64, scr, lane); }
        else { const float* src = (e < 64) ? a.in[I_EXD] + ((size_t)l * 64 + e) * 256 * 1024 : a.in[I_SHD] + (size_t)l * 256 * 1024;
            const int kb = r >> 5, nb = r & 31; transpose_item(src, 1024, WD + (size_t)e * 1024 * 256, 256, kb * 64, nb * 32, nb * 32, kb * 64, scr, lane); }
    }
}
DI void phase_kr(const Args& a) {
    const float* HDN = (const float*)(a.ws + WS_HDN);
    bf16_t* KRL = (bf16_t*)(a.ws + WS_KRL); bf16_t* KRC = (bf16_t*)(a.ws + WS_KRC);
    const int tid = otid(); const int lane = tid & 63, gw = obid() * NWV + (tid >> 6), NGW = gridDim.x * NWV;
    for (int item = gw; item < 2 * 2048; item += NGW) {
        const int nsel = item >> 11, r = item & 2047, e = r >> 10, ord = (r >> 9) & 1, c = r & 511, n = nsel ? 256 : 2048;
        const float* w4 = a.in[I_FW4] + (size_t)e * 64 * 2048; const int f0 = ord * 1024 + c, f1 = f0 + 512;
        const float w4f = w4[lane * 2048 + f0], w4b = w4[lane * 2048 + f1];
        const float dec0 = fabsf(a.in[I_DECAY][e * 2048 + f0]), dec1 = fabsf(a.in[I_DECAY][e * 2048 + f1]);
        const float skip = a.in[I_SKIP][(e * 2 + ord) * 512 + c];
        const float* hd = HDN + ((size_t)e * 2304 + (nsel ? 2048 : 0)) * 64;
        bf16_t* dst = nsel ? KRC + ((size_t)(e * 2 + ord) * 512 + c) * 512 : KRL + ((size_t)(e * 2 + ord) * 512 + c) * 4096;
        for (int x0 = 0; x0 < 2 * n; x0 += 64) {
            const int x = x0 + lane, d = n - x, t = d < 0 ? -d : d;
            float val = 0.f;
            if (t < n) {
                const float* hr = hd + (size_t)t * 64; float sf = 0.f, sb = 0.f;
#pragma unroll 8
                for (int j = 0; j < 64; ++j) { const float hv = hr[j]; sf += hv * __shfl(w4f, j); sb += hv * __shfl(w4b, j); }
                const float tt = (float)t / (float)(n - 1);
                const float hf = sf * expf(-tt * dec0), hb = sb * expf(-tt * dec1);
                val = d > 0 ? hf : (d < 0 ? hb : hf + hb + skip);
            }
            dst[x] = (bf16_t)f2bf(val);
        }
    }
}
DI void phase_init(const Args& a) {
    float* XS = (float*)(a.ws + WS_XS); bf16_t* AB = (bf16_t*)((unsigned char*)a.out + O_ABUF); const float* MOD = (const float*)(a.ws + WS_MOD);
    const int tid = otid(); const int lane = tid & 63, gw = obid() * NWV + (tid >> 6), NGW = gridDim.x * NWV;
    for (int row = gw; row < T; row += NGW) {
        const float* src = row < TL ? a.in[I_X] + (size_t)row * 1024 : a.in[I_CTX] + (size_t)(row - TL) * 1024;
        const int mrow = row < TL ? (row >> 11) : 16; const float* md = MOD + (size_t)mrow * 6144;
#pragma unroll
        for (int j = 0; j < 4; ++j) { const int col = 4 * lane + 256 * j; const f32x4 v = *(const f32x4*)(src + col);
            *(f32x4*)(XS + (size_t)row * 1024 + col) = v;
            const f32x4 sh = *(const f32x4*)(md + col), sc = *(const f32x4*)(md + 1024 + col);
            store_bf4(AB + (size_t)row * 1024 + col, v * (sc + 1.f) + sh); }
    }
}

DI void phase_uc(const Args& a, int e, LAS unsigned char* lds) {
    const bf16_t* PH = (const bf16_t*)(a.ws + WS_BIG + B_PH); bf16_t* UC = (bf16_t*)(a.ws + WS_BIG + B_UC);
    LAS float* buf = (LAS float*)lds;
    const float* sw = a.in[I_HYSW] + (size_t)e * 3 * 1536; const float* sb = a.in[I_HYSB] + (size_t)e * 1536;
    const int tid = otid();
    for (int tile = obid(); tile < 288 * 24; tile += gridDim.x) {
        const int tt = tile / 24, cb = tile % 24, tok0 = tt * 128;
        int s0, s1; if (tok0 < TL) { s0 = tok0 & ~(SEQ - 1); s1 = s0 + SEQ; } else { s0 = TL + ((tok0 - TL) & ~(CTXL - 1)); s1 = s0 + CTXL; }
        for (int i = tid; i < 130 * 8; i += NTH) { const int rr = i >> 3, c8 = i & 7, tok = tok0 - 1 + rr;
            u32x4 v = {0u, 0u, 0u, 0u}; if (tok >= s0 && tok < s1) v = *(const u32x4*)(PH + (size_t)tok * 1536 + cb * 64 + c8 * 8);
            LAS float* d = buf + rr * 65 + c8 * 8;
            d[0] = __uint_as_float(v.x << 16); d[1] = __uint_as_float(v.x & 0xffff0000u); d[2] = __uint_as_float(v.y << 16); d[3] = __uint_as_float(v.y & 0xffff0000u);
            d[4] = __uint_as_float(v.z << 16); d[5] = __uint_as_float(v.z & 0xffff0000u); d[6] = __uint_as_float(v.w << 16); d[7] = __uint_as_float(v.w & 0xffff0000u); }
        __syncthreads();
        for (int i = tid; i < 64 * 16; i += NTH) { const int c = i >> 4, ch = i & 15, cg = cb * 64 + c;
            const float w0 = sw[cg], w1 = sw[1536 + cg], w2 = sw[3072 + cg], bb = sb[cg]; float o[8];
#pragma unroll
            for (int j = 0; j < 8; ++j) { const int t = ch * 8 + j; o[j] = w0 * buf[t * 65 + c] + w1 * buf[(t + 1) * 65 + c] + w2 * buf[(t + 2) * 65 + c] + bb; }
            u32x4 w; w.x = pk2(o[0], o[1]); w.y = pk2(o[2], o[3]); w.z = pk2(o[4], o[5]); w.w = pk2(o[6], o[7]);
            *(u32x4*)(UC + (size_t)cg * T + tok0 + ch * 8) = w; }
        __syncthreads();
    }
}
template <class F> DI void hy_conv_naive(const LAS bf16_t* U, const LAS bf16_t* KR, int n, const F& out) {
    const int tid = otid(); const int nt4 = n >> 2;
    for (int task = tid; task < 16 * nt4; task += NTH) {
        const int b = task / nt4, t0 = (task % nt4) * 4;
        const LAS bf16_t* ub = U + b * n; float y0 = 0.f, y1 = 0.f, y2 = 0.f, y3 = 0.f;
        int base = n - t0;
        float w1 = base - 1 >= 0 ? bf2f(KR[base - 1]) : 0.f, w2 = base - 2 >= 0 ? bf2f(KR[base - 2]) : 0.f, w3 = base - 3 >= 0 ? bf2f(KR[base - 3]) : 0.f;
        for (int s = 0; s < n; ++s) { const float w0 = bf2f(KR[base + s]); const float uv = bf2f(ub[s]);
            y0 += w0 * uv; y1 += w1 * uv; y2 += w2 * uv; y3 += w3 * uv; w3 = w2; w2 = w1; w1 = w0; }
        out(b, t0, y0, y1, y2, y3);
    }
}
struct HyOutZ { LAS bf16_t* Z; const bf16_t* x1; int n; int tokbase; int tstride;
    DI void operator()(int b, int t0, float y0, float y1, float y2, float y3) const { const u32x2 xv = *(const u32x2*)(x1 + tokbase + b * tstride + t0);
        const float a0 = __uint_as_float(xv.x << 16), a1 = __uint_as_float(xv.x & 0xffff0000u), a2 = __uint_as_float(xv.y << 16), a3 = __uint_as_float(xv.y & 0xffff0000u);
        u32x2 w; w.x = pk2(a0 * y0, a1 * y1); w.y = pk2(a2 * y2, a3 * y3); *(LAS u32x2*)(Z + b * n + t0) = w; } };
struct HyOutY { bf16_t* yh; const bf16_t* x2; int tokbase; int tstride;
    DI void operator()(int b, int t0, float y0, float y1, float y2, float y3) const { const u32x2 xv = *(const u32x2*)(x2 + tokbase + b * tstride + t0);
        const float a0 = __uint_as_float(xv.x << 16), a1 = __uint_as_float(xv.x & 0xffff0000u), a2 = __uint_as_float(xv.y << 16), a3 = __uint_as_float(xv.y & 0xffff0000u);
        u32x2 w; w.x = pk2(a0 * y0, a1 * y1); w.y = pk2(a2 * y2, a3 * y3); *(u32x2*)(yh + tokbase + b * tstride + t0) = w; } };
DI void hyena_unit_naive(const Args& a, int e, int c, int nsel, LAS unsigned char* lds) {
    const int n = nsel ? CTXL : SEQ, tokbase = nsel ? TL : 0, tid = otid();
    const bf16_t* UC = (const bf16_t*)(a.ws + WS_BIG + B_UC); bf16_t* YH = (bf16_t*)(a.ws + WS_BIG + B_YH);
    const bf16_t* kr0 = nsel ? (const bf16_t*)(a.ws + WS_KRC) + ((size_t)(e * 2 + 0) * 512 + c) * 512 : (const bf16_t*)(a.ws + WS_KRL) + ((size_t)(e * 2 + 0) * 512 + c) * 4096;
    const bf16_t* kr1 = nsel ? (const bf16_t*)(a.ws + WS_KRC) + ((size_t)(e * 2 + 1) * 512 + c) * 512 : (const bf16_t*)(a.ws + WS_KRL) + ((size_t)(e * 2 + 1) * 512 + c) * 4096;
    LAS bf16_t* U = (LAS bf16_t*)lds; LAS bf16_t* Z = U + 16 * SEQ; LAS bf16_t* KR = Z + 16 * SEQ;
    const bf16_t* vrow = UC + (size_t)c * T + tokbase;
    for (int i = tid; i < 16 * n / 8; i += NTH) { const int el = i * 8; *(LAS u32x4*)(U + el) = *(const u32x4*)(vrow + el); }
    for (int i = tid; i < 2 * n / 8; i += NTH) *(LAS u32x4*)(KR + i * 8) = *(const u32x4*)(kr0 + i * 8);
    __syncthreads();
    { HyOutZ o{Z, UC + (size_t)(512 + c) * T, n, tokbase, n}; hy_conv_naive(U, KR, n, o); }
    __syncthreads();
    for (int i = tid; i < 2 * n / 8; i += NTH) *(LAS u32x4*)(KR + i * 8) = *(const u32x4*)(kr1 + i * 8);
    __syncthreads();
    { HyOutY o{YH + (size_t)c * T, UC + (size_t)(1024 + c) * T, tokbase, n}; hy_conv_naive(Z, KR, n, o); }
    __syncthreads();
}
constexpr int HY_RS = 4112, HY_CS = 8208;
DI void hy_build_kc(const bf16_t* kr, int n, LAS unsigned char* KC, int tid) {
    for (int x8 = tid; x8 < 2 * n / 8; x8 += NTH) {
        const u32x4 lo = *(const u32x4*)(kr + x8 * 8); u32x4 hi = {0u, 0u, 0u, 0u}; if (x8 + 1 < 2 * n / 8) hi = *(const u32x4*)(kr + x8 * 8 + 8);
        const unsigned w[9] = {lo.x, lo.y, lo.z, lo.w, hi.x, hi.y, hi.z, hi.w, 0u};
#pragma unroll
        for (int r = 0; r < 8; ++r) { u32x4 o; const int k = r >> 1;
            if ((r & 1) == 0) { o.x = w[k]; o.y = w[k + 1]; o.z = w[k + 2]; o.w = w[k + 3]; }
            else { o.x = __builtin_amdgcn_alignbit(w[k + 1], w[k], 16); o.y = __builtin_amdgcn_alignbit(w[k + 2], w[k + 1], 16); o.z = __builtin_amdgcn_alignbit(w[k + 3], w[k + 2], 16); o.w = __builtin_amdgcn_alignbit(w[k + 4], w[k + 3], 16); }
            *(LAS u32x4*)(KC + r * HY_CS + x8 * 16) = o; }
    }
}
template <int NTW> DI void hy_conv_mfma(const LAS unsigned char* Ub, const LAS unsigned char* KC, int wave, int lane, f32x4 (&acc)[NTW]) {
    constexpr int n = NTW * 128;
    const int i = lane & 15, q = lane >> 4, r = (8 - (i & 7)) & 7, t0w = wave * NTW * 16;
    const LAS unsigned char* ap = KC + r * HY_CS + 2 * (8 * q - t0w - 16 * (NTW - 1) - i + n - r);
    const LAS unsigned char* bp = Ub + i * HY_RS + 16 * q;
#pragma unroll
    for (int k = 0; k < NTW; ++k) acc[k] = (f32x4){0.f, 0.f, 0.f, 0.f};
#pragma unroll 2
    for (int s0c = 0; s0c < n / 32; ++s0c) {
        const bf16x8 bf = *(const LAS bf16x8*)(bp + 64 * s0c);
#pragma unroll
        for (int k = 0; k < NTW; ++k) { const bf16x8 af = *(const LAS bf16x8*)(ap + 64 * s0c + 32 * (NTW - 1 - k)); acc[k] = mfma16(af, bf, acc[k]); }
    }
}
template <int NTW> DI void hyena_unit_fast(const Args& a, int e, int c, LAS unsigned char* lds) {
    constexpr int n = NTW * 128; constexpr int nsel = (n == CTXL) ? 1 : 0; constexpr int tokbase = nsel ? TL : 0;
    const int tid = otid(), wave = tid >> 6, lane = tid & 63, b = lane & 15, q = lane >> 4;
    const bf16_t* UC = (const bf16_t*)(a.ws + WS_BIG + B_UC); bf16_t* YH = (bf16_t*)(a.ws + WS_BIG + B_YH);
    const bf16_t* kr0 = nsel ? (const bf16_t*)(a.ws + WS_KRC) + ((size_t)(e * 2 + 0) * 512 + c) * 512 : (const bf16_t*)(a.ws + WS_KRL) + ((size_t)(e * 2 + 0) * 512 + c) * 4096;
    const bf16_t* kr1 = nsel ? (const bf16_t*)(a.ws + WS_KRC) + ((size_t)(e * 2 + 1) * 512 + c) * 512 : (const bf16_t*)(a.ws + WS_KRL) + ((size_t)(e * 2 + 1) * 512 + c) * 4096;
    LAS unsigned char* Ub = lds; LAS unsigned char* KC = lds + 16 * HY_RS;
    const bf16_t* vrow = UC + (size_t)c * T + tokbase; const bf16_t* x1row = UC + (size_t)(512 + c) * T + tokbase; const bf16_t* x2row = UC + (size_t)(1024 + c) * T + tokbase;
    bf16_t* yrow = YH + (size_t)c * T + tokbase;
    for (int idx = tid; idx < 16 * n / 8; idx += NTH) { const int bb = idx / (n / 8), ch = idx % (n / 8); *(LAS u32x4*)(Ub + bb * HY_RS + ch * 16) = *(const u32x4*)(vrow + bb * n + ch * 8); }
    hy_build_kc(kr0, n, KC, tid);
    __syncthreads();
    f32x4 acc[NTW]; u32x2 zp[NTW];
    hy_conv_mfma<NTW>(Ub, KC, wave, lane, acc);
#pragma unroll
    for (int k = 0; k < NTW; ++k) { const int t = wave * NTW * 16 + 16 * k + 4 * q; const u32x2 xv = *(const u32x2*)(x1row + b * n + t);
        zp[k].x = pk2(__uint_as_float(xv.x << 16) * acc[k][0], __uint_as_float(xv.x & 0xffff0000u) * acc[k][1]); zp[k].y = pk2(__uint_as_float(xv.y << 16) * acc[k][2], __uint_as_float(xv.y & 0xffff0000u) * acc[k][3]); }
    __syncthreads();
#pragma unroll
    for (int k = 0; k < NTW; ++k) { const int t = wave * NTW * 16 + 16 * k + 4 * q; *(LAS u32x2*)(Ub + b * HY_RS + t * 2) = zp[k]; }
    hy_build_kc(kr1, n, KC, tid);
    __syncthreads();
    hy_conv_mfma<NTW>(Ub, KC, wave, lane, acc);
#pragma unroll
    for (int k = 0; k < NTW; ++k) { const int t = wave * NTW * 16 + 16 * k + 4 * q; const u32x2 xv = *(const u32x2*)(x2row + b * n + t);
        zp[k].x = pk2(__uint_as_float(xv.x << 16) * acc[k][0], __uint_as_float(xv.x & 0xffff0000u) * acc[k][1]); zp[k].y = pk2(__uint_as_float(xv.y << 16) * acc[k][2], __uint_as_float(xv.y & 0xffff0000u) * acc[k][3]); }
    __syncthreads();
#pragma unroll
    for (int k = 0; k < NTW; ++k) { const int t = wave * NTW * 16 + 16 * k + 4 * q; *(LAS u32x2*)(Ub + b * HY_RS + t * 2) = zp[k]; }
    __syncthreads();
    for (int idx = tid; idx < 16 * n / 8; idx += NTH) { const int bb = idx / (n / 8), ch = idx % (n / 8); *(u32x4*)(yrow + bb * n + ch * 8) = *(const LAS u32x4*)(Ub + bb * HY_RS + ch * 16); }
    __syncthreads();
}
DI void attn_unit_naive(const Args& a, int l, int isctx, int b, int h, int qb, LAS unsigned char* lds) {
    const bf16_t* QB = (const bf16_t*)(a.ws + WS_BIG + B_QB); const bf16_t* KB = (const bf16_t*)(a.ws + WS_BIG + B_KB); const bf16_t* VB = (const bf16_t*)(a.ws + WS_BIG + B_VB);
    bf16_t* MIXA = (bf16_t*)(a.ws + WS_BIG + B_MIXA_E);
    LAS bf16_t* Ks = (LAS bf16_t*)lds; LAS bf16_t* Vs = Ks + 64 * 128; LAS float* ex = (LAS float*)(lds + 32768); LAS float* ssq = ex + 64 * 128;
    const int tid = otid(), r = tid & 63, s = (tid >> 6) & 1, qt = tid >> 7, e = l >> 1;
    const int qrow = isctx ? TL + b * CTXL + qb * 64 + r : b * SEQ + qb * 64 + r;
    float q[64], o[32];
    { const bf16_t* qp = QB + (size_t)qrow * 512 + h * 128 + s * 64;
#pragma unroll
      for (int d8 = 0; d8 < 8; ++d8) { const u32x4 v = *(const u32x4*)(qp + d8 * 8);
          q[d8 * 8 + 0] = __uint_as_float(v.x << 16); q[d8 * 8 + 1] = __uint_as_float(v.x & 0xffff0000u); q[d8 * 8 + 2] = __uint_as_float(v.y << 16); q[d8 * 8 + 3] = __uint_as_float(v.y & 0xffff0000u);
          q[d8 * 8 + 4] = __uint_as_float(v.z << 16); q[d8 * 8 + 5] = __uint_as_float(v.z & 0xffff0000u); q[d8 * 8 + 6] = __uint_as_float(v.w << 16); q[d8 * 8 + 7] = __uint_as_float(v.w & 0xffff0000u); } }
#pragma unroll
    for (int i = 0; i < 32; ++i) o[i] = 0.f;
    float m = -INFINITY, lsum = 0.f;
    const int ntiles = isctx ? 4 : 36;
    for (int kt = 0; kt < ntiles; ++kt) {
        const int krow0 = (kt < 4) ? TL + b * CTXL + kt * 64 : b * SEQ + (kt - 4) * 64;
        __syncthreads();
        for (int i = tid; i < 1024; i += NTH) { const int key = i >> 4, ch = i & 15;
            *(LAS u32x4*)(Ks + key * 128 + ch * 8) = *(const u32x4*)(KB + (size_t)(krow0 + key) * 512 + h * 128 + ch * 8);
            *(LAS u32x4*)(Vs + key * 128 + ch * 8) = *(const u32x4*)(VB + (size_t)(krow0 + key) * 512 + h * 128 + ch * 8); }
        __syncthreads();
        for (int kg = 0; kg < 64; kg += 4) {
            float sc[4];
#pragma unroll
            for (int kk = 0; kk < 4; ++kk) { const LAS bf16_t* kp = Ks + (kg + kk) * 128 + s * 64; float acc = 0.f;
#pragma unroll
                for (int d8 = 0; d8 < 8; ++d8) { const u32x4 v = *(const LAS u32x4*)(kp + d8 * 8);
                    acc += q[d8 * 8 + 0] * __uint_as_float(v.x << 16) + q[d8 * 8 + 1] * __uint_as_float(v.x & 0xffff0000u) + q[d8 * 8 + 2] * __uint_as_float(v.y << 16) + q[d8 * 8 + 3] * __uint_as_float(v.y & 0xffff0000u)
                         + q[d8 * 8 + 4] * __uint_as_float(v.z << 16) + q[d8 * 8 + 5] * __uint_as_float(v.z & 0xffff0000u) + q[d8 * 8 + 6] * __uint_as_float(v.w << 16) + q[d8 * 8 + 7] * __uint_as_float(v.w & 0xffff0000u); }
                sc[kk] = acc; }
            const float mx = fmaxf(fmaxf(sc[0], sc[1]), fmaxf(sc[2], sc[3]));
            const float mn = fmaxf(m, mx); const float corr = exp2f(m - mn); m = mn; lsum *= corr;
#pragma unroll
            for (int i = 0; i < 32; ++i) o[i] *= corr;
#pragma unroll
            for (int kk = 0; kk < 4; ++kk) { const float p = exp2f(sc[kk] - mn); lsum += p; const LAS bf16_t* vp = Vs + (kg + kk) * 128 + qt * 32;
#pragma unroll
                for (int d8 = 0; d8 < 4; ++d8) { const u32x4 v = *(const LAS u32x4*)(vp + d8 * 8);
                    o[d8 * 8 + 0] += p * __uint_as_float(v.x << 16); o[d8 * 8 + 1] += p * __uint_as_float(v.x & 0xffff0000u); o[d8 * 8 + 2] += p * __uint_as_float(v.y << 16); o[d8 * 8 + 3] += p * __uint_as_float(v.y & 0xffff0000u);
                    o[d8 * 8 + 4] += p * __uint_as_float(v.z << 16); o[d8 * 8 + 5] += p * __uint_as_float(v.z & 0xffff0000u); o[d8 * 8 + 6] += p * __uint_as_float(v.w << 16); o[d8 * 8 + 7] += p * __uint_as_float(v.w & 0xffff0000u); } }
        }
    }
    const float inv = 1.f / lsum;
    float d1 = 0.f, d2 = 0.f;
    for (int i = 0; i < 64; ++i) { d1 += a.in[I_LQ1][e * 64 + i] * a.in[I_LK1][e * 64 + i]; d2 += a.in[I_LQ2][e * 64 + i] * a.in[I_LK2][e * 64 + i]; }
    const float lam_init = 0.8f - 0.6f * expf(-0.3f * (float)l);
    const float lam = expf(d1) - expf(d2) + lam_init;
    __syncthreads();
    if (s == 1) {
#pragma unroll
        for (int i = 0; i < 32; ++i) ex[r * 128 + qt * 32 + i] = o[i] * inv; }
    __syncthreads();
    if (s == 0) { float ss = 0.f;
#pragma unroll
        for (int i = 0; i < 32; ++i) { o[i] = o[i] * inv - lam * ex[r * 128 + qt * 32 + i]; ss += o[i] * o[i]; }
        ssq[r * 4 + qt] = ss; }
    __syncthreads();
    if (s == 0) { const float tot = (ssq[r * 4] + ssq[r * 4 + 1]) + (ssq[r * 4 + 2] + ssq[r * 4 + 3]); const float rs = rsqrtf(tot * (1.f / 128.f) + LN_EPS) * (1.f - lam_init);
        const float* g = a.in[I_SUBG] + e * 128 + qt * 32; bf16_t* dst = MIXA + (size_t)qrow * 1024 + 512 + h * 128 + qt * 32;
#pragma unroll
        for (int i = 0; i < 32; i += 4) { f32x4 v = {o[i] * rs * g[i], o[i + 1] * rs * g[i + 1], o[i + 2] * rs * g[i + 2], o[i + 3] * rs * g[i + 3]}; store_bf4(dst + i, v); } }
    __syncthreads();
}
typedef float f32x16 __attribute__((ext_vector_type(16)));
typedef short s16x4 __attribute__((ext_vector_type(4)));
constexpr int AT_KS = 272, AT_VS = 288, AT_KB = 64 * AT_KS, AT_VB = 64 * AT_VS;
constexpr int AT_EX = 2 * AT_KB + 2 * AT_VB;
DI f32x16 mfma32(bf16x8 a, bf16x8 b, f32x16 c) { return __builtin_amdgcn_mfma_f32_32x32x16_bf16(a, b, c, 0, 0, 0); }
DI s16x4 tr_read(const LAS unsigned char* p) { return __builtin_bit_cast(s16x4, __builtin_amdgcn_ds_read_tr16_b64_v4i16((LAS s16x4*)p)); }
DI void attn_unit_fast(const Args& a, int l, int isctx, int b, int hd, int qb, LAS unsigned char* lds) {
    const bf16_t* QB = (const bf16_t*)(a.ws + WS_BIG + B_QB); const bf16_t* KB = (const bf16_t*)(a.ws + WS_BIG + B_KB); const bf16_t* VB = (const bf16_t*)(a.ws + WS_BIG + B_VB);
    bf16_t* MIXA = (bf16_t*)(a.ws + WS_BIG + B_MIXA_E);
    const int tid = otid(), wave = tid >> 6, lane = tid & 63, s = wave >> 2, r32 = lane & 31, hi = lane >> 5, e = l >> 1;
    const int qrow0 = isctx ? TL + b * CTXL + qb * 128 : b * SEQ + qb * 128;
    const int qrow = qrow0 + 32 * (wave & 3) + r32;
    bf16x8 qf[4];
#pragma unroll
    for (int d0 = 0; d0 < 4; ++d0) qf[d0] = *(const bf16x8*)(QB + (size_t)qrow * 512 + hd * 128 + s * 64 + 16 * d0 + 8 * hi);
    f32x16 O[4];
#pragma unroll
    for (int eb = 0; eb < 4; ++eb)
#pragma unroll
        for (int r = 0; r < 16; ++r) O[eb][r] = 0.f;
    float m = -INFINITY, lsum = 0.f;
    const int ntiles = isctx ? 4 : 36;
    u32x4 pre[4];
    const int ck = tid >> 4, cc = tid & 15;
#define AT_LOAD(kt_) do { const int kr0_ = ((kt_) < 4) ? TL + b * CTXL + (kt_) * 64 : b * SEQ + ((kt_) - 4) * 64; \
        pre[0] = *(const u32x4*)(KB + (size_t)(kr0_ + ck) * 512 + hd * 128 + cc * 8); pre[1] = *(const u32x4*)(KB + (size_t)(kr0_ + ck + 32) * 512 + hd * 128 + cc * 8); \
        pre[2] = *(const u32x4*)(VB + (size_t)(kr0_ + ck) * 512 + hd * 128 + cc * 8); pre[3] = *(const u32x4*)(VB + (size_t)(kr0_ + ck + 32) * 512 + hd * 128 + cc * 8); } while (0)
#define AT_STORE(buf_) do { *(LAS u32x4*)(lds + (buf_) * AT_KB + ck * AT_KS + cc * 16) = pre[0]; *(LAS u32x4*)(lds + (buf_) * AT_KB + (ck + 32) * AT_KS + cc * 16) = pre[1]; \
        *(LAS u32x4*)(lds + 2 * AT_KB + (buf_) * AT_VB + ck * AT_VS + cc * 16) = pre[2]; *(LAS u32x4*)(lds + 2 * AT_KB + (buf_) * AT_VB + (ck + 32) * AT_VS + cc * 16) = pre[3]; } while (0)
    AT_LOAD(0); AT_STORE(0);
    __syncthreads();
    const int i16 = lane & 15, qq = i16 >> 2, p4 = i16 & 3, blk16 = (lane >> 4) & 1;
    const int koff = r32 * AT_KS + s * 128 + hi * 16;
    const int voff = (4 * hi + qq) * AT_VS + (16 * blk16 + 4 * p4) * 2;
    for (int kt = 0; kt < ntiles; ++kt) {
        const int buf = kt & 1;
        if (kt + 1 < ntiles) AT_LOAD(kt + 1);
        const LAS unsigned char* Kt = lds + buf * AT_KB + koff; const LAS unsigned char* Vt = lds + 2 * AT_KB + buf * AT_VB + voff;
        f32x16 P0, P1;
#pragma unroll
        for (int r = 0; r < 16; ++r) { P0[r] = 0.f; P1[r] = 0.f; }
#pragma unroll
        for (int d0 = 0; d0 < 4; ++d0) { const bf16x8 k0 = *(const LAS bf16x8*)(Kt + d0 * 32), k1 = *(const LAS bf16x8*)(Kt + 32 * AT_KS + d0 * 32);
            P0 = mfma32(k0, qf[d0], P0); P1 = mfma32(k1, qf[d0], P1); }
        float mx = fmaxf(P0[0], P1[0]);
#pragma unroll
        for (int r = 1; r < 16; ++r) mx = fmaxf(mx, fmaxf(P0[r], P1[r]));
        mx = fmaxf(mx, __shfl_xor(mx, 32));
        if (__any(mx > m)) { const float mn = fmaxf(m, mx); const float corr = __builtin_amdgcn_exp2f(m - mn); m = mn; lsum *= corr;
#pragma unroll
            for (int eb = 0; eb < 4; ++eb) O[eb] = O[eb] * corr; }
        float ps = 0.f;
#pragma unroll
        for (int r = 0; r < 16; ++r) { P0[r] = __builtin_amdgcn_exp2f(P0[r] - m); P1[r] = __builtin_amdgcn_exp2f(P1[r] - m); ps += P0[r] + P1[r]; }
        lsum += ps;
        bf16x8 pa[4];
#pragma unroll
        for (int s2 = 0; s2 < 2; ++s2) { u32x4 w0, w1;
            w0.x = pk2(P0[8 * s2 + 0], P0[8 * s2 + 1]); w0.y = pk2(P0[8 * s2 + 2], P0[8 * s2 + 3]); w0.z = pk2(P0[8 * s2 + 4], P0[8 * s2 + 5]); w0.w = pk2(P0[8 * s2 + 6], P0[8 * s2 + 7]);
            w1.x = pk2(P1[8 * s2 + 0], P1[8 * s2 + 1]); w1.y = pk2(P1[8 * s2 + 2], P1[8 * s2 + 3]); w1.z = pk2(P1[8 * s2 + 4], P1[8 * s2 + 5]); w1.w = pk2(P1[8 * s2 + 6], P1[8 * s2 + 7]);
            pa[s2] = __builtin_bit_cast(bf16x8, w0); pa[2 + s2] = __builtin_bit_cast(bf16x8, w1); }
#pragma unroll
        for (int eb = 0; eb < 4; ++eb)
#pragma unroll
            for (int ks = 0; ks < 4; ++ks) { const LAS unsigned char* vp = Vt + ks * 16 * AT_VS + eb * 64;
                const s16x4 lo = tr_read(vp), hh = tr_read(vp + 8 * AT_VS);
                const bf16x8 vf = __builtin_shufflevector(lo, hh, 0, 1, 2, 3, 4, 5, 6, 7);
                O[eb] = mfma32(vf, pa[ks], O[eb]); }
        if (kt + 1 < ntiles) AT_STORE(buf ^ 1);
        __syncthreads();
    }
#undef AT_LOAD
#undef AT_STORE
    const float ltot = lsum + __shfl_xor(lsum, 32); const float inv = 1.f / ltot;
    float d1 = 0.f, d2 = 0.f;
    for (int i = 0; i < 64; ++i) { d1 += a.in[I_LQ1][e * 64 + i] * a.in[I_LK1][e * 64 + i]; d2 += a.in[I_LQ2][e * 64 + i] * a.in[I_LK2][e * 64 + i]; }
    const float lam_init = 0.8f - 0.6f * expf(-0.3f * (float)l);
    const float lam = expf(d1) - expf(d2) + lam_init;
    LAS float* ex = (LAS float*)(lds + AT_EX); const int lrow = 32 * (wave & 3) + r32;
    if (s == 1) {
#pragma unroll
        for (int eb = 0; eb < 4; ++eb)
#pragma unroll
            for (int r = 0; r < 16; ++r) ex[lrow * 129 + eb * 32 + (r & 3) + 8 * (r >> 2) + 4 * hi] = O[eb][r] * inv; }
    __syncthreads();
    if (s == 0) { float ss = 0.f;
#pragma unroll
        for (int eb = 0; eb < 4; ++eb)
#pragma unroll
            for (int r = 0; r < 16; ++r) { const float dv = O[eb][r] * inv - lam * ex[lrow * 129 + eb * 32 + (r & 3) + 8 * (r >> 2) + 4 * hi]; O[eb][r] = dv; ss += dv * dv; }
        ss += __shfl_xor(ss, 32);
        const float rs = rsqrtf(ss * (1.f / 128.f) + LN_EPS) * (1.f - lam_init); const float* g = a.in[I_SUBG] + e * 128;
        LAS bf16_t* st = (LAS bf16_t*)lds;
#pragma unroll
        for (int eb = 0; eb < 4; ++eb)
#pragma unroll
            for (int r4 = 0; r4 < 4; ++r4) { const int e0 = eb * 32 + 8 * r4 + 4 * hi; u32x2 w;
                w.x = pk2(O[eb][4 * r4] * rs * g[e0], O[eb][4 * r4 + 1] * rs * g[e0 + 1]); w.y = pk2(O[eb][4 * r4 + 2] * rs * g[e0 + 2], O[eb][4 * r4 + 3] * rs * g[e0 + 3]);
                *(LAS u32x2*)(st + lrow * 136 + e0) = w; } }
    __syncthreads();
    { const LAS bf16_t* st = (const LAS bf16_t*)lds;
      for (int i = tid; i < 128 * 16; i += NTH) { const int row = i >> 4, ch = i & 15; *(u32x4*)(MIXA + (size_t)(qrow0 + row) * 1024 + 512 + hd * 128 + ch * 8) = *(const LAS u32x4*)(st + row * 136 + ch * 8); } }
    __syncthreads();
}
DI void phase_yh_t(const Args& a, LAS unsigned char* lds) {
    const bf16_t* YH = (const bf16_t*)(a.ws + WS_BIG + B_YH); bf16_t* MIXA = (bf16_t*)(a.ws + WS_BIG + B_MIXA_E);
    LAS bf16_t* buf = (LAS bf16_t*)lds;
    const int tid = otid();
    for (int tile = obid(); tile < 288 * 8; tile += gridDim.x) {
        const int tt = tile >> 3, cb = tile & 7, tok0 = tt * 128;
        for (int i = tid; i < 64 * 16; i += NTH) { const int c = i >> 4, ch = i & 15; *(LAS u32x4*)(buf + c * 136 + ch * 8) = *(const u32x4*)(YH + (size_t)(cb * 64 + c) * T + tok0 + ch * 8); }
        __syncthreads();
        for (int i = tid; i < 128 * 8; i += NTH) { const int tk = i >> 3, c8 = i & 7; unsigned short v[8];
#pragma unroll
            for (int j = 0; j < 8; ++j) v[j] = buf[(c8 * 8 + j) * 136 + tk];
            u32x4 w; w.x = v[0] | ((unsigned)v[1] << 16); w.y = v[2] | ((unsigned)v[3] << 16); w.z = v[4] | ((unsigned)v[5] << 16); w.w = v[6] | ((unsigned)v[7] << 16);
            *(u32x4*)(MIXA + (size_t)(tok0 + tk) * 1024 + cb * 64 + c8 * 8) = w; }
        __syncthreads();
    }
}

DI void phase_rgconv(const Args& a, int o) {
    const bf16_t* REC = (const bf16_t*)(a.ws + WS_BIG + B_REC); bf16_t* U = (bf16_t*)(a.ws + WS_BIG + B_U);
    const float* cw = a.in[I_RGCW] + (size_t)o * 4 * 1024; const float* cb = a.in[I_RGCB] + (size_t)o * 1024;
    for (int idx = obid() * NTH + otid(); idx < T * 128; idx += gridDim.x * NTH) {
        const int row = idx >> 7, c8 = (idx & 127) * 8;
        int s0, s1; if (row < TL) { s0 = row & ~(SEQ - 1); s1 = s0 + SEQ; } else { s0 = TL + ((row - TL) & ~(CTXL - 1)); s1 = s0 + CTXL; }
        float acc[8];
#pragma unroll
        for (int j = 0; j < 8; ++j) acc[j] = cb[c8 + j];
#pragma unroll
        for (int k = 0; k < 4; ++k) { const int rr = row + k - 2; if (rr >= s0 && rr < s1) { const u32x4 v = *(const u32x4*)(REC + (size_t)rr * 1024 + c8); const float* w = cw + k * 1024 + c8;
                acc[0] += w[0] * __uint_as_float(v.x << 16); acc[1] += w[1] * __uint_as_float(v.x & 0xffff0000u); acc[2] += w[2] * __uint_as_float(v.y << 16); acc[3] += w[3] * __uint_as_float(v.y & 0xffff0000u);
                acc[4] += w[4] * __uint_as_float(v.z << 16); acc[5] += w[5] * __uint_as_float(v.z & 0xffff0000u); acc[6] += w[6] * __uint_as_float(v.w << 16); acc[7] += w[7] * __uint_as_float(v.w & 0xffff0000u); } }
        u32x4 w; w.x = pk2(acc[0], acc[1]); w.y = pk2(acc[2], acc[3]); w.z = pk2(acc[4], acc[5]); w.w = pk2(acc[6], acc[7]);
        *(u32x4*)(U + (size_t)row * 1024 + c8) = w;
    }
}
DI int scan_chunk_of(int dir, int jj) { return dir == 0 ? jj : (jj < 4 ? 3 - jj : 39 - jj); }
DI int chunk_row0(int b, int chunk) { return chunk < 4 ? TL + b * CTXL + chunk * 64 : b * SEQ + (chunk - 4) * 64; }
DI void phase_scan1(const Args& a) {
    const bf16_t* LA = (const bf16_t*)(a.ws + WS_BIG + B_LA); const bf16_t* BB = (const bf16_t*)(a.ws + WS_BIG + B_BB);
    float* CT = (float*)((unsigned char*)a.out + O_CT);
    for (int idx = obid() * NTH + otid(); idx < 2 * 16 * 36 * 1024; idx += gridDim.x * NTH) {
        const int ch = idx & 1023, chunk = (idx >> 10) % 36, b = ((idx >> 10) / 36) & 15, dir = (idx >> 10) / (36 * 16);
        const int row0 = chunk_row0(b, chunk); const bf16_t* la = LA + ((size_t)dir * T + row0) * 1024 + ch; const bf16_t* bb = BB + ((size_t)dir * T + row0) * 1024 + ch;
        float P = 1.f, Q = 0.f;
        for (int i = 0; i < 64; ++i) { const int ii = dir ? 63 - i : i; const float av = __expf(bf2f(la[(size_t)ii * 1024])), bv = bf2f(bb[(size_t)ii * 1024]); P *= av; Q = av * Q + bv; }
        CT[(size_t)idx * 2] = P; CT[(size_t)idx * 2 + 1] = Q;
    }
}
DI void phase_scan2(const Args& a) {
    const float* CT = (const float*)((unsigned char*)a.out + O_CT); float* CARRY = (float*)((unsigned char*)a.out + O_CARRY);
    for (int idx = obid() * NTH + otid(); idx < 2 * 16 * 1024; idx += gridDim.x * NTH) {
        const int ch = idx & 1023, b = (idx >> 10) & 15, dir = idx >> 14; float h = 0.f;
        for (int jj = 0; jj < 36; ++jj) { const int chunk = scan_chunk_of(dir, jj); const size_t o = (((size_t)dir * 16 + b) * 36 + chunk) * 1024 + ch;
            CARRY[o] = h; h = CT[o * 2] * h + CT[o * 2 + 1]; }
    }
}
DI void phase_scan3(const Args& a) {
    const bf16_t* LA = (const bf16_t*)(a.ws + WS_BIG + B_LA); const bf16_t* BB = (const bf16_t*)(a.ws + WS_BIG + B_BB); const bf16_t* GATE = (const bf16_t*)(a.ws + WS_BIG + B_GATE);
    bf16_t* MIXA = (bf16_t*)(a.ws + WS_BIG + B_MIXA_O); const float* CARRY = (const float*)((unsigned char*)a.out + O_CARRY);
    for (int idx = obid() * NTH + otid(); idx < 16 * 36 * 1024; idx += gridDim.x * NTH) {
        const int ch = idx & 1023, chunk = (idx >> 10) % 36, b = (idx >> 10) / 36; const int row0 = chunk_row0(b, chunk);
        float hfv[64];
        { const bf16_t* la = LA + ((size_t)row0) * 1024 + ch; const bf16_t* bb = BB + ((size_t)row0) * 1024 + ch; float h = CARRY[(((size_t)0 * 16 + b) * 36 + chunk) * 1024 + ch];
#pragma unroll
          for (int i = 0; i < 64; ++i) { h = __expf(bf2f(la[(size_t)i * 1024])) * h + bf2f(bb[(size_t)i * 1024]); hfv[i] = h; } }
        { const bf16_t* la = LA + ((size_t)T + row0) * 1024 + ch; const bf16_t* bb = BB + ((size_t)T + row0) * 1024 + ch; float h = CARRY[(((size_t)1 * 16 + b) * 36 + chunk) * 1024 + ch];
          const bf16_t* g = GATE + (size_t)row0 * 1024 + ch; bf16_t* mo = MIXA + (size_t)row0 * 1024 + ch;
#pragma unroll
          for (int i = 63; i >= 0; --i) { h = __expf(bf2f(la[(size_t)i * 1024])) * h + bf2f(bb[(size_t)i * 1024]); mo[(size_t)i * 1024] = (bf16_t)f2bf(bf2f(g[(size_t)i * 1024]) * (hfv[i] + h)); } }
    }
}

DI void phase_ln1(const Args& a, int l, int Mrows) {
    float* XS = (float*)(a.ws + WS_XS); bf16_t* TM = (bf16_t*)((unsigned char*)a.out + O_ABUF); const float* MOD = (const float*)(a.ws + WS_MOD) + (size_t)l * 17 * 6144;
    const float* g = a.in[I_LN1G] + l * 1024; const float* bta = a.in[I_LN1B] + l * 1024;
    const int tid = otid(); const int lane = tid & 63, gw = obid() * NWV + (tid >> 6), NGW = gridDim.x * NWV;
    for (int row = gw; row < Mrows; row += NGW) {
        float* xr = XS + (size_t)row * 1024; f32x4 v[4]; float s = 0.f;
#pragma unroll
        for (int j = 0; j < 4; ++j) { v[j] = *(const f32x4*)(xr + 4 * lane + 256 * j); s += (v[j][0] + v[j][1]) + (v[j][2] + v[j][3]); }
        const float mean = wave_sum(s) * (1.f / 1024.f); float s2 = 0.f;
#pragma unroll
        for (int j = 0; j < 4; ++j) { v[j] = v[j] - mean; s2 += (v[j][0] * v[j][0] + v[j][1] * v[j][1]) + (v[j][2] * v[j][2] + v[j][3] * v[j][3]); }
        const float rstd = rsqrtf(wave_sum(s2) * (1.f / 1024.f) + LN_EPS);
        const int mrow = row < TL ? (row >> 11) : 16; const float* md = MOD + (size_t)mrow * 6144;
#pragma unroll
        for (int j = 0; j < 4; ++j) { const int col = 4 * lane + 256 * j; const f32x4 y = v[j] * rstd * *(const f32x4*)(g + col) + *(const f32x4*)(bta + col);
            *(f32x4*)(xr + col) = y; const f32x4 shf = *(const f32x4*)(md + 3072 + col), scf = *(const f32x4*)(md + 4096 + col);
            store_bf4(TM + (size_t)row * 1024 + col, y * (scf + 1.f) + shf); }
    }
}
DI void route_row(float logit, int lane, float bias, int row, int* cnt, int* LIST, float* PW) {
    const float score = 1.f / (1.f + expf(-logit)); const float sel = score + bias;
    float m1 = sel; m1 = fmaxf(m1, __shfl_xor(m1, 1)); m1 = fmaxf(m1, __shfl_xor(m1, 2)); m1 = fmaxf(m1, __shfl_xor(m1, 4));
    const unsigned long long eq = __ballot(sel == m1); const int g = lane >> 3; const unsigned gm = (unsigned)(eq >> (g * 8)) & 0xffu; const int first = __ffs(gm) - 1;
    float m2 = ((lane & 7) == first) ? -INFINITY : sel; m2 = fmaxf(m2, __shfl_xor(m2, 1)); m2 = fmaxf(m2, __shfl_xor(m2, 2)); m2 = fmaxf(m2, __shfl_xor(m2, 4));
    const float gs = m1 + m2; int grank = 0;
#pragma unroll
    for (int gg = 0; gg < 8; ++gg) { const float o = __shfl(gs, gg * 8); grank += ((o > gs) || (o == gs && gg < g)) ? 1 : 0; }
    const float msel = grank < 4 ? sel : -INFINITY; int rank = 0;
#pragma unroll
    for (int e2 = 0; e2 < 64; ++e2) { const float o = __shfl(msel, e2); rank += ((o > msel) || (o == msel && e2 < lane)) ? 1 : 0; }
    const bool chosen = rank < 8; const float wsum = wave_sum(chosen ? score : 0.f);
    if (chosen) { const float w = score / wsum * 2.5f; const int slot = atomicAdd(&cnt[lane], 1); const int pair = row * 8 + rank; LIST[(size_t)lane * T + slot] = pair; PW[pair] = w; }
}
DI void phase_router(const Args& a, int l, int Mrows, LAS unsigned char* lds) {
    const float* XS = (const float*)(a.ws + WS_XS); const float* MOD = (const float*)(a.ws + WS_MOD) + (size_t)l * 17 * 6144;
    const float* RW = a.in[I_ROUTW] + (size_t)l * 1024 * 64; const float rb = a.in[I_ROUTB][l * 64 + (otid() & 63)];
    int* cnt = (int*)(a.ws + WS_CTL) + CW_CNT + l * 64; int* LIST = (int*)((unsigned char*)a.out + O_LIST); float* PW = (float*)((unsigned char*)a.out + O_PW);
    const int tid = otid(); const int wave = tid >> 6, lane = tid & 63, gw = obid() * NWV + wave, NGW = gridDim.x * NWV;
    LAS float* tb = (LAS float*)(lds + wave * 16384);
    for (int r0 = gw * 4; r0 < Mrows; r0 += NGW * 4) {
#pragma unroll
        for (int rr = 0; rr < 4; ++rr) { const int row = r0 + rr; const int mrow = row < TL ? (row >> 11) : 16; const float* md = MOD + (size_t)mrow * 6144;
#pragma unroll
            for (int j = 0; j < 4; ++j) { const int col = 4 * lane + 256 * j; const f32x4 y = *(const f32x4*)(XS + (size_t)row * 1024 + col);
                const f32x4 shf = *(const f32x4*)(md + 3072 + col), scf = *(const f32x4*)(md + 4096 + col); *(LAS f32x4*)(tb + rr * 1024 + col) = y * (scf + 1.f) + shf; } }
        LDS_WAIT();
        float acc0 = 0.f, acc1 = 0.f, acc2 = 0.f, acc3 = 0.f;
#pragma unroll 4
        for (int d = 0; d < 1024; ++d) { const float w = RW[d * 64 + lane]; acc0 += tb[d] * w; acc1 += tb[1024 + d] * w; acc2 += tb[2048 + d] * w; acc3 += tb[3072 + d] * w; }
        route_row(acc0, lane, rb, r0, cnt, LIST, PW); route_row(acc1, lane, rb, r0 + 1, cnt, LIST, PW);
        route_row(acc2, lane, rb, r0 + 2, cnt, LIST, PW); route_row(acc3, lane, rb, r0 + 3, cnt, LIST, PW);
        LDS_WAIT();
    }
}
DI void build_toff(const Args& a, int l, int Mrows, volatile LAS int* toff) {
    const int* cnt = (const int*)(a.ws + WS_CTL) + CW_CNT + l * 64;
    __syncthreads();
    if (otid() == 0) { int acc = 0; for (int e = 0; e < 64; ++e) { toff[e] = acc; acc += (cnt[e] + 255) >> 8; } toff[64] = acc; acc += Mrows >> 8; toff[65] = acc; }
    __syncthreads();
}
DI void phase_ln2(const Args& a, int l, int Mrows) {
    float* XS = (float*)(a.ws + WS_XS); const bf16_t* Y = (const bf16_t*)(a.ws + WS_BIG); bf16_t* AB = (bf16_t*)((unsigned char*)a.out + O_ABUF);
    const float* MOD = (const float*)(a.ws + WS_MOD) + (size_t)l * 17 * 6144; const float* MODN = MOD + 17 * 6144;
    const float* g = a.in[I_LN2G] + l * 1024; const float* bta = a.in[I_LN2B] + l * 1024;
    const int tid = otid(); const int lane = tid & 63, gw = obid() * NWV + (tid >> 6), NGW = gridDim.x * NWV;
    for (int row = gw; row < Mrows; row += NGW) {
        float* xr = XS + (size_t)row * 1024; const int mrow = row < TL ? (row >> 11) : 16; const float* md = MOD + (size_t)mrow * 6144;
        f32x4 v[4]; float s = 0.f;
#pragma unroll
        for (int j = 0; j < 4; ++j) { const int col = 4 * lane + 256 * j; f32x4 ys = {0.f, 0.f, 0.f, 0.f};
#pragma unroll
            for (int k = 0; k < 8; ++k) { const u32x2 yv = *(const u32x2*)(Y + ((size_t)row * 8 + k) * 1024 + col);
                ys[0] += __uint_as_float(yv.x << 16); ys[1] += __uint_as_float(yv.x & 0xffff0000u); ys[2] += __uint_as_float(yv.y << 16); ys[3] += __uint_as_float(yv.y & 0xffff0000u); }
            v[j] = *(const f32x4*)(xr + col) + *(const f32x4*)(md + 5120 + col) * ys; s += (v[j][0] + v[j][1]) + (v[j][2] + v[j][3]); }
        const float mean = wave_sum(s) * (1.f / 1024.f); float s2 = 0.f;
#pragma unroll
        for (int j = 0; j < 4; ++j) { v[j] = v[j] - mean; s2 += (v[j][0] * v[j][0] + v[j][1] * v[j][1]) + (v[j][2] * v[j][2] + v[j][3] * v[j][3]); }
        const float rstd = rsqrtf(wave_sum(s2) * (1.f / 1024.f) + LN_EPS);
        if (l == DEPTH - 1) {
#pragma unroll
            for (int j = 0; j < 4; ++j) { const int col = 4 * lane + 256 * j; *(f32x4*)(a.out + (size_t)row * 1024 + col) = v[j] * rstd * *(const f32x4*)(g + col) + *(const f32x4*)(bta + col); }
        } else { const float* mdn = MODN + (size_t)mrow * 6144;
#pragma unroll
            for (int j = 0; j < 4; ++j) { const int col = 4 * lane + 256 * j; const f32x4 y = v[j] * rstd * *(const f32x4*)(g + col) + *(const f32x4*)(bta + col);
                *(f32x4*)(xr + col) = y; const f32x4 sh = *(const f32x4*)(mdn + col), sc = *(const f32x4*)(mdn + 1024 + col);
                store_bf4(AB + (size_t)row * 1024 + col, y * (sc + 1.f) + sh); } }
    }
}

#ifndef FASTMASK
#define FASTMASK 0xff
#endif
constexpr bool F_ABIN = FASTMASK & 1, F_RGIN = FASTMASK & 2, F_OUT = FASTMASK & 4, F_GATES = FASTMASK & 8, F_GU = FASTMASK & 16, F_DN = FASTMASK & 32, F_HY = FASTMASK & 64, F_AT = FASTMASK & 128;
__global__ void __launch_bounds__(NTH, 2) mega(Args a) {
    extern __shared__ __attribute__((aligned(16))) unsigned char lds_raw[];
    LAS unsigned char* lds = (LAS unsigned char*)lds_raw;
    const int tid = threadIdx.x;
    volatile LAS unsigned* MISC = (volatile LAS unsigned*)(lds + LDS_MISC);
    volatile LAS int* toff = (volatile LAS int*)(lds + LDS_TOFF);
    if (tid < 64) MISC[tid] = 0u;
    __syncthreads();
    XcdBarrier bar = xcd_barrier_post((unsigned*)(a.ws + WS_CTL) + CW_BAR, MISC);
    const int G = gridDim.x, bx = blockIdx.x;
#define GRID_BAR() xcd_barrier(bar)
    unsigned char* ws = a.ws; unsigned char* ob = (unsigned char*)a.out;
    const float* MOD = (const float*)(ws + WS_MOD);
    bf16_t* ABUF = (bf16_t*)(ob + O_ABUF);
    float* XS = (float*)(ws + WS_XS);
    const int* LIST = (const int*)(ob + O_LIST); const float* PW = (const float*)(ob + O_PW);

    phase_mod(a, lds); phase_hdn(a); phase_rope(a); phase_weights(a, 0, lds);
    GRID_BAR();
    phase_kr(a); phase_init(a);
    GRID_BAR();

    for (int l = 0; l < DEPTH; ++l) {
        const int Mrows = (l == DEPTH - 1) ? TL : T;
        if (l > 0) { phase_weights(a, l, lds); GRID_BAR(); }
        if ((l & 1) == 0) {
            const int e = l >> 1;
            { SchedDense S{ABUF, (const bf16_t*)(ws + WS_WIN), 1024, 1024, T / 256, 12, G, bx};
              EpiAbIn E{(bf16_t*)(ws + WS_BIG + B_PH), (bf16_t*)(ws + WS_BIG + B_QB), (bf16_t*)(ws + WS_BIG + B_KB), (bf16_t*)(ws + WS_BIG + B_VB), (const float*)(ws + WS_ROPE)};
              gemm_units<F_ABIN>(lds, S, E, 1024, 1024); }
            GRID_BAR();
            phase_uc(a, e, lds);
            GRID_BAR();
            if constexpr (F_HY) { for (int c = bx; c < 1024; c += G) { if (c < 512) hyena_unit_fast<16>(a, e, c, lds); else hyena_unit_fast<2>(a, e, c - 512, lds); } }
            else { for (int c = bx; c < 1024; c += G) hyena_unit_naive(a, e, c & 511, c >> 9, lds); }
            if constexpr (F_AT) { for (int u = bx; u < 1024 + 128; u += G) { if (u < 1024) attn_unit_fast(a, l, 0, u >> 6, (u >> 4) & 3, u & 15, lds); else { const int v = u - 1024; attn_unit_fast(a, l, 1, v >> 3, (v >> 1) & 3, v & 1, lds); } } }
            else { for (int u = bx; u < 2048 + 256; u += G) { if (u < 2048) attn_unit_naive(a, l, 0, u >> 7, (u >> 5) & 3, u & 31, lds); else { const int v = u - 2048; attn_unit_naive(a, l, 1, v >> 4, (v >> 2) & 3, v & 3, lds); } } }
            GRID_BAR();
            phase_yh_t(a, lds);
            GRID_BAR();
            { SchedDense S{(const bf16_t*)(ws + WS_BIG + B_MIXA_E), (const bf16_t*)(ws + WS_WOUT), 1024, 1024, Mrows / 256, 4, G, bx}; EpiOut E{XS, MOD + (size_t)l * 17 * 6144}; gemm_units<F_OUT>(lds, S, E, 1024, 1024); }
            GRID_BAR();
        } else {
            const int o = l >> 1;
            { SchedDense S{ABUF, (const bf16_t*)(ws + WS_WIN), 1024, 1024, T / 256, 8, G, bx}; EpiRgIn E{(bf16_t*)(ws + WS_BIG + B_GATE), (bf16_t*)(ws + WS_BIG + B_REC)}; gemm_units<F_RGIN>(lds, S, E, 1024, 1024); }
            GRID_BAR();
            phase_rgconv(a, o);
            GRID_BAR();
            { SchedGates S{(const bf16_t*)(ws + WS_BIG + B_U), (const bf16_t*)(ws + WS_WG), T / 256, G, bx};
              EpiGates E{(const bf16_t*)(ws + WS_BIG + B_U), (bf16_t*)(ws + WS_BIG + B_LA), (bf16_t*)(ws + WS_BIG + B_BB), a.in[I_RGBA] + o * 2048, a.in[I_RGBX] + o * 2048, a.in[I_RGLAM] + o * 2048};
              gemm_units<F_GATES>(lds, S, E, 256, 256); }
            GRID_BAR();
            phase_scan1(a);
            GRID_BAR();
            phase_scan2(a);
            GRID_BAR();
            phase_scan3(a);
            GRID_BAR();
            { SchedDense S{(const bf16_t*)(ws + WS_BIG + B_MIXA_O), (const bf16_t*)(ws + WS_WOUT), 1024, 1024, Mrows / 256, 4, G, bx}; EpiOut E{XS, MOD + (size_t)l * 17 * 6144}; gemm_units<F_OUT>(lds, S, E, 1024, 1024); }
            GRID_BAR();
        }
        phase_ln1(a, l, Mrows);
        GRID_BAR();
        phase_router(a, l, Mrows, lds);
        GRID_BAR();
        build_toff(a, l, Mrows, toff);
        const int* cnt = (const int*)(ws + WS_CTL) + CW_CNT + l * 64;
        { SchedMoe S{ABUF, (const bf16_t*)(ws + WS_WGU), cnt, LIST, toff, toff[65], 2, G, bx, true, (size_t)512 * 1024}; EpiGU E{(bf16_t*)(ws + WS_HS)}; gemm_units<F_GU>(lds, S, E, 1024, 1024); }
        GRID_BAR();
        { SchedMoe S{(const bf16_t*)(ws + WS_HS), (const bf16_t*)(ws + WS_WD), cnt, LIST, toff, toff[65], 4, G, bx, false, (size_t)1024 * 256};
          EpiDn E{(bf16_t*)(ws + WS_BIG), XS, LIST, PW, MOD + (size_t)l * 17 * 6144}; gemm_units<F_DN>(lds, S, E, 256, 256); }
        GRID_BAR();
        phase_ln2(a, l, Mrows);
        GRID_BAR();
    }
}

extern "C" void kernel_launch(void* const* d_in, const int* in_sizes, int n_in, void* d_out, int out_size, void* d_ws, size_t ws_size, hipStream_t stream) {
    static int grid = 0;
    if (grid == 0) {
        int dev = 0, cus = 0;
        if (hipGetDevice(&dev) != hipSuccess || hipDeviceGetAttribute(&cus, hipDeviceAttributeMultiprocessorCount, dev) != hipSuccess) { grid = -1; return; }
        if (hipFuncSetAttribute((const void*)mega, hipFuncAttributeMaxDynamicSharedMemorySize, LDS_BYTES) != hipSuccess) { grid = -1; return; }
        int per_cu = 0; (void)hipOccupancyMaxActiveBlocksPerMultiprocessor(&per_cu, (const void*)mega, NTH, LDS_BYTES); (void)hipGetLastError();
        grid = cus;
        if (per_cu < 1) grid = cus;
    }
    if (grid < 0) return;
    (void)hipMemsetAsync((char*)d_ws + WS_CTL, 0, CTL_BYTES, stream);
    Args a{};
    for (int i = 0; i < 46; ++i) a.in[i] = (const float*)d_in[i];
    a.out = (float*)d_out; a.ws = (unsigned char*)d_ws;
    hipLaunchKernelGGL(mega, dim3(grid), dim3(NTH), LDS_BYTES, stream, a);
}
```

```cpp
#include <hip/hip_runtime.h>
#include <stdint.h>
#include <math.h>

#define GAS __attribute__((address_space(1)))
#define LAS __attribute__((address_space(3)))
#define DI __device__ __forceinline__
typedef unsigned short bf16_t;
typedef short bf16x8 __attribute__((ext_vector_type(8)));
typedef float f32x4 __attribute__((ext_vector_type(4)));
typedef unsigned u32x4 __attribute__((ext_vector_type(4)));
typedef unsigned u32x2 __attribute__((ext_vector_type(2)));

constexpr int D = 1024, NB = 16, SEQ = 2048, CTXL = 256, DEPTH = 4;
constexpr int TL = NB * SEQ, TC = NB * CTXL, T = TL + TC;
constexpr float LN_EPS = 1e-5f;
constexpr float DN_ALPHA = 1.6817928305074290861f;
constexpr float C2 = 0.125f * 1.4426950408889634f;
constexpr int NTH = 512, NWV = 8;

constexpr size_t MiB = 1u << 20;
constexpr size_t WS_CTL = 0, CTL_BYTES = 1 * MiB;
constexpr size_t WS_MOD = 1 * MiB;
constexpr size_t WS_HDN = 3 * MiB;
constexpr size_t WS_ROPE = 5 * MiB;
constexpr size_t WS_KRL = 6 * MiB;
constexpr size_t WS_KRC = 22 * MiB;
constexpr size_t WS_WIN = 24 * MiB;
constexpr size_t WS_WOUT = 30 * MiB;
constexpr size_t WS_WG = 32 * MiB;
constexpr size_t WS_WGU = 36 * MiB;
constexpr size_t WS_WD = 101 * MiB;
constexpr size_t WS_XS = 134 * MiB;
constexpr size_t WS_HS = 278 * MiB;
constexpr size_t WS_BIG = 448 * MiB;
constexpr size_t B_PH = 0, B_QB = 108 * MiB, B_KB = 144 * MiB, B_VB = 180 * MiB, B_UC = 216 * MiB, B_YH = 324 * MiB, B_MIXA_E = 360 * MiB, B_M_E = 432 * MiB;
constexpr size_t B_GATE = 0, B_REC = 72 * MiB, B_U = 144 * MiB, B_LA = 216 * MiB, B_BB = 360 * MiB, B_MIXA_O = 504 * MiB, B_M_O = 0;
constexpr size_t O_ABUF = 0, O_LIST = 72 * MiB, O_CT = 92 * MiB, O_CARRY = 112 * MiB;
constexpr int CW_BAR = 4096, CW_CNT = 8192, CW_HYC = 16384;

constexpr int LDS_SCR = 143360;
constexpr int LDS_MISC = LDS_SCR;
constexpr int LDS_TOFF = LDS_SCR + 256;
constexpr int LDS_PTRS = LDS_SCR + 5120;
constexpr int LDS_BYTES = 151552;

DI float bf2f(bf16_t b) { return __uint_as_float(((unsigned)b) << 16); }
DI unsigned f2bf(float f) { unsigned u = __float_as_uint(f); return (u + 0x7fffu + ((u >> 16) & 1u)) >> 16; }
typedef float f32x2_t __attribute__((ext_vector_type(2))); typedef __bf16 bf16x2_t __attribute__((ext_vector_type(2)));
DI unsigned pk2(float lo, float hi) { const f32x2_t v = {lo, hi}; const bf16x2_t b = __builtin_convertvector(v, bf16x2_t); return __builtin_bit_cast(unsigned, b); }
DI void store_bf8(bf16_t* p, f32x4 v0, f32x4 v1) { u32x4 w; w.x = pk2(v0[0], v0[1]); w.y = pk2(v0[2], v0[3]); w.z = pk2(v1[0], v1[1]); w.w = pk2(v1[2], v1[3]); *(u32x4*)p = w; }
DI void store_bf4(bf16_t* p, f32x4 v) { u32x2 w; w.x = pk2(v[0], v[1]); w.y = pk2(v[2], v[3]); *(u32x2*)p = w; }
template <int X> DI float xor_lane(float v) {
    if constexpr (X == 32) { const auto rr = __builtin_amdgcn_permlane32_swap(__float_as_uint(v), __float_as_uint(v), false, false); return __uint_as_float(rr[0] == __float_as_uint(v) ? rr[1] : rr[0]); }
    else return __uint_as_float((unsigned)__builtin_amdgcn_ds_swizzle((int)__float_as_uint(v), 0x1f | (X << 10)));
}
DI float xor32_sum(float v) { const auto rr = __builtin_amdgcn_permlane32_swap(__float_as_uint(v), __float_as_uint(v), false, false); return __uint_as_float(rr[0]) + __uint_as_float(rr[1]); }
DI float xor32_max(float v) { const auto rr = __builtin_amdgcn_permlane32_swap(__float_as_uint(v), __float_as_uint(v), false, false); return fmaxf(__uint_as_float(rr[0]), __uint_as_float(rr[1])); }
DI float lane_bcast(float v, int l) { return __uint_as_float((unsigned)__builtin_amdgcn_readlane((int)__float_as_uint(v), l)); }
DI float wave_sum(float v) { v += xor_lane<1>(v); v += xor_lane<2>(v); v += xor_lane<4>(v); v += xor_lane<8>(v); v += xor_lane<16>(v); return xor32_sum(v); }
DI float sigmoidf_(float x) { return __builtin_amdgcn_rcpf(1.f + __expf(-x)); }
#define LDS_WAIT() asm volatile("s_waitcnt lgkmcnt(0)" ::: "memory")
DI int otid() { int t = threadIdx.x; asm volatile("" : "+v"(t)); return t; }
DI const char* uni_ptr(const void* p) { const unsigned long long v = (unsigned long long)p; const unsigned lo = __builtin_amdgcn_readfirstlane((unsigned)v), hi = __builtin_amdgcn_readfirstlane((unsigned)(v >> 32)); return (const char*)(GAS const char*)(((unsigned long long)hi << 32) | lo); }
DI int obid() { int b = blockIdx.x; asm volatile("" : "+s"(b)); return b; }

#define XB_TMO      128
#define XB_XCNT(j)  (256  + 64 * (j))
#define XB_XSUB(j)  (1280 + 64 * (j))
#define XB_XGEN(j)  (2304 + 64 * (j))
#define XB_TOP      3328
#define XB_TOPGEN   3392
#define XCD_BAR_WORDS 3456
#define XB_SPIN_CAP (1u << 22)
DI unsigned xb_ld(unsigned* p)              { return __hip_atomic_load(p, __ATOMIC_RELAXED, __HIP_MEMORY_SCOPE_AGENT); }
DI unsigned xb_add(unsigned* p, unsigned v) { return __hip_atomic_fetch_add(p, v, __ATOMIC_RELAXED, __HIP_MEMORY_SCOPE_AGENT); }
DI unsigned xb_xcc_id() { return (unsigned)__builtin_amdgcn_s_getreg((3 << 11) | 20) & 0xFu; }
#define XB_SPIN(cond, bar) do { unsigned _sp = 0; while (cond) { __builtin_amdgcn_s_sleep(1); \
    if ((++_sp & 255u) == 0u) { if (xb_ld(&(bar)[XB_TMO])) break; if (_sp > XB_SPIN_CAP) { atomicAdd(&(bar)[XB_TMO], 1u); break; } } } } while (0)
struct XcdBarrier { unsigned* bar; unsigned x; volatile LAS unsigned* st; };
DI XcdBarrier xcd_barrier_post(unsigned* bar, volatile LAS unsigned* st) {
    XcdBarrier b; b.bar = bar; b.x = xb_xcc_id(); b.st = st;
    if (threadIdx.x == 0) (void)xb_add(&bar[XB_XCNT(b.x)], 1u);
    return b;
}
DI void xcd_barrier_complete(unsigned* bar, unsigned x, unsigned& nloc, unsigned& nx) {
    const unsigned G = gridDim.x * gridDim.y * gridDim.z;
    unsigned sum, cnt, mine, sp = 0u;
    for (;;) {
        sum = 0u; cnt = 0u; mine = 0u;
#pragma unroll
        for (unsigned j = 0; j < 16; ++j) { const unsigned c = xb_ld(&bar[XB_XCNT(j)]); sum += c; cnt += (c > 0u) ? 1u : 0u; mine = (j == x) ? c : mine; }
        if (sum == G) break;
        __builtin_amdgcn_s_sleep(1);
        if ((++sp & 255u) == 0u) { if (xb_ld(&bar[XB_TMO])) break; if (sp > XB_SPIN_CAP) { atomicAdd(&bar[XB_TMO], 1u); break; } }
    }
    nloc = mine > 0u ? mine : 1u; nx = cnt > 0u ? cnt : 1u;
}
DI void xcd_barrier(const XcdBarrier& b) {
    asm volatile("s_waitcnt vmcnt(0)" ::: "memory");
    __syncthreads();
    unsigned long long bi_ = (unsigned long long)uni_ptr(b.bar); asm volatile("" : "+s"(bi_));
    if (threadIdx.x == 0) {
        unsigned* bar = (unsigned*)(GAS unsigned*)bi_;
        __builtin_amdgcn_s_waitcnt(0);
        unsigned nloc = b.st[0], nx = b.st[1];
        if (nloc == 0u) { xcd_barrier_complete(bar, xb_xcc_id(), nloc, nx); b.st[0] = nloc; b.st[1] = nx; }
        const unsigned bx_ = xb_xcc_id();
        const unsigned old = xb_add(&bar[XB_XSUB(bx_)], 1u);
        const unsigned gen = old / nloc;
        if (old + 1u == (gen + 1u) * nloc) {
            __builtin_amdgcn_fence(__ATOMIC_RELEASE, "agent");
            asm volatile("s_waitcnt vmcnt(0)" ::: "memory");
            const unsigned og = xb_add(&bar[XB_TOP], 1u);
            const unsigned tg = og / nx;
            if (og + 1u == (tg + 1u) * nx) xb_add(&bar[XB_TOPGEN], 1u);
            else XB_SPIN(xb_ld(&bar[XB_TOPGEN]) == tg, bar);
            __builtin_amdgcn_fence(__ATOMIC_ACQUIRE, "agent");
            xb_add(&bar[XB_XGEN(bx_)], 1u);
            asm volatile("s_waitcnt vmcnt(0)" ::: "memory");
        } else {
            XB_SPIN(xb_ld(&bar[XB_XGEN(bx_)]) == gen, bar);
            __builtin_amdgcn_fence(__ATOMIC_ACQUIRE, "agent");
            asm volatile("s_waitcnt vmcnt(0)" ::: "memory");
        }
    }
    __syncthreads();
}

DI void hy_signal(unsigned* cw) { asm volatile("s_waitcnt vmcnt(0)" ::: "memory"); __syncthreads();
    if (threadIdx.x == 0) { __builtin_amdgcn_fence(__ATOMIC_RELEASE, "agent"); asm volatile("s_waitcnt vmcnt(0)" ::: "memory"); (void)xb_add(cw, 1u); } }
DI void hy_wait(unsigned* cw, unsigned target, unsigned* bar) {
    if (threadIdx.x == 0) { XB_SPIN(xb_ld(cw) < target, bar); __builtin_amdgcn_fence(__ATOMIC_ACQUIRE, "agent"); asm volatile("s_waitcnt vmcnt(0)" ::: "memory"); }
    __syncthreads(); }

struct Args { const float* in[46]; float* out; unsigned char* ws; };
enum { I_X = 0, I_C, I_CTX, I_CCTX, I_WMOD, I_BMOD, I_LN1G, I_LN1B, I_LN2G, I_LN2B, I_ABWIN, I_ABWOUT, I_HYSW, I_HYSB, I_FW1, I_FB1, I_FW2, I_FB2,
       I_FW3, I_FB3, I_FW4, I_FREQ, I_DECAY, I_SKIP, I_LQ1, I_LK1, I_LQ2, I_LK2, I_SUBG, I_RGWIN, I_RGWOUT, I_RGCW, I_RGCB, I_RGWA, I_RGBA, I_RGWX, I_RGBX,
       I_RGLAM, I_ROUTW, I_ROUTB, I_EXG, I_EXU, I_EXD, I_SHG, I_SHU, I_SHD };
DI const float* kin(int i) { const volatile LAS unsigned* tb = (const volatile LAS unsigned*)(size_t)LDS_PTRS; const unsigned lo = tb[2 * i], hi = tb[2 * i + 1];
    return (const float*)(GAS const float*)(((unsigned long long)(unsigned)__builtin_amdgcn_readfirstlane((int)hi) << 32) | (unsigned)__builtin_amdgcn_readfirstlane((int)lo)); }

struct GU { const bf16_t* A; const bf16_t* B; int pm, pn, e, ti, nvalid; };

DI f32x4 mfma16(bf16x8 a, bf16x8 b, f32x4 c) { return __builtin_amdgcn_mfma_f32_16x16x32_bf16(a, b, c, 0, 0, 0); }

namespace pg8 {
constexpr int BK = 64, HALF = 128, HTB = HALF * BK * 2, STAGE_BYTES = 8 * HTB;
DI int lds_byte(int r, int c) { const int st = (r >> 4) * 2 + (c >> 5), rr = r & 15, cc = c & 31, ob = rr * 64 + cc * 2; return st * 1024 + (ob ^ (((ob >> 9) & 1) << 5)); }
DI int perm32(int rho) { const int n = rho >> 4, i = rho & 15; return 8 * (i >> 2) + 4 * n + (i & 3); }
DI void stage_rc(int b, int& R, int& C) { const int st = b / 1024, sb = b % 1024, swz = sb ^ (((sb >> 9) & 1) << 5); R = (st >> 1) * 16 + swz / 64; C = (st & 1) * 32 + (swz % 64) / 2; }
template <class Sched, class Epi>
DI void gemm_naive(const Sched& S, const Epi& E, int K, int ldb) {
    const int tid = otid(), wave = tid >> 6, lane = tid & 63, fr = lane & 15, fq = lane >> 4;
    GU u;
    for (int i = 0; S.next(i, u); ++i) {
        for (int task = wave; task < 64; task += NWV) {
            const int rg = task >> 2, c0 = (task & 3) * 32, r = rg * 16 + fr;
            const bf16_t* arow = u.A + S.arow_off(u, r) + 8 * fq;
            const int br0 = Epi::PERM ? pg8::perm32(fr) : fr, br1 = Epi::PERM ? pg8::perm32(16 + fr) : 16 + fr;
            const bf16_t* b00 = u.B + (size_t)(c0 + br0) * ldb + 8 * fq; const bf16_t* b01 = u.B + (size_t)(c0 + br1) * ldb + 8 * fq;
            const bf16_t* b10 = b00 + (size_t)128 * ldb; const bf16_t* b11 = b01 + (size_t)128 * ldb;
            f32x4 a0 = {0.f, 0.f, 0.f, 0.f}, a1 = a0, b0 = a0, b1 = a0;
            for (int k0 = 0; k0 < K; k0 += 32) {
                const bf16x8 af = *(const bf16x8*)(arow + k0);
                const bf16x8 w00 = *(const bf16x8*)(b00 + k0), w01 = *(const bf16x8*)(b01 + k0), w10 = *(const bf16x8*)(b10 + k0), w11 = *(const bf16x8*)(b11 + k0);
                a0 = mfma16(w00, af, a0); a1 = mfma16(w01, af, a1); b0 = mfma16(w10, af, b0); b1 = mfma16(w11, af, b1);
            }
            const int cle = c0 + (Epi::PERM ? 8 : 4) * fq; typename Epi::UPre UP; typename Epi::Pre P; E.upre(u, cle, UP); E.pre(u, r, cle, P); E(u, r, cle, a0, a1, b0, b1, UP, P);
        }
    }
}

}
#ifndef PG8_ALIGN
#define PG8_ALIGN false
#endif
template <class Sched, class Epi>
DI void gemm_fast(LAS unsigned char* lds, const Sched& S, const Epi& E, const int K, const int ldb) {
    using namespace pg8;
    const int tid = otid(), wid = __builtin_amdgcn_readfirstlane(tid >> 6), lane = tid & 63, wr = wid >> 2, wc = wid & 3, fr = lane & 15, fq = lane >> 4;
    const int nt = K / BK;
    int R0, C0, R1, C1; stage_rc(tid * 16, R0, C0); stage_rc(tid * 16 + 8192, R1, C1);
    const int Rb0 = Epi::PERM ? ((R0 & ~31) + perm32(R0 & 31)) : R0, Rb1 = Epi::PERM ? ((R1 & ~31) + perm32(R1 & 31)) : R1;
    unsigned voffB[2]; voffB[0] = (unsigned)(Rb0 * ldb + C0) * 2u; voffB[1] = (unsigned)(Rb1 * ldb + C1) * 2u;
    GU cur, nxt; int ui = 0;
    if (!S.next(0, cur)) return;
    const size_t lda_ = S.arow_off(cur, 1);
    unsigned voffA[2]; voffA[0] = (unsigned)(R0 * lda_ + C0) * 2u; voffA[1] = (unsigned)(R1 * lda_ + C1) * 2u;
    const size_t kstep = (size_t)(BK * 2), hstepB = (size_t)HALF * ldb * 2, hstepA = (size_t)HALF * lda_ * 2;
    const unsigned ldsw = (unsigned)wid * 1024u;
    const int aoff = lds_byte(wr * 64 + fr, fq * 8), boff = lds_byte(wc * 32 + fr, fq * 8);
#define PG8_SA(b, h) (((b) * 2 + (h)) * HTB)
#define PG8_SB(b, h) ((4 + (b) * 2 + (h)) * HTB)
#define PG8_GLDS(gp, ldsoff) __builtin_amdgcn_global_load_lds((const unsigned*)(gp), (LAS unsigned*)(lds + (ldsoff)), 16, 0, 0)
#define PG8_STAGE_B(bufoff, gbase) do { PG8_GLDS((const char*)(gbase) + voffB[0], (bufoff) + ldsw); PG8_GLDS((const char*)(gbase) + voffB[1], (bufoff) + ldsw + 8192); } while (0)
#define PG8_STAGE_A(bufoff, gbase, h, o0, o1) do { if constexpr (Sched::GATHER) { PG8_GLDS((const char*)(gbase) + (o0), (bufoff) + ldsw); PG8_GLDS((const char*)(gbase) + (o1), (bufoff) + ldsw + 8192); } \
        else { PG8_GLDS((const char*)(gbase) + (h) * hstepA + voffA[0], (bufoff) + ldsw); PG8_GLDS((const char*)(gbase) + (h) * hstepA + voffA[1], (bufoff) + ldsw + 8192); } } while (0)
#define PG8_LDA(dst, b, h) do { _Pragma("unroll") for (int m = 0; m < 4; ++m) _Pragma("unroll") for (int k = 0; k < 2; ++k) dst[m][k] = *(const LAS bf16x8*)(lds + PG8_SA(b, h) + aoff + m * 2048 + k * 1024); } while (0)
#define PG8_LDB(dst, b, h) do { _Pragma("unroll") for (int n = 0; n < 2; ++n) _Pragma("unroll") for (int k = 0; k < 2; ++k) dst[n][k] = *(const LAS bf16x8*)(lds + PG8_SB(b, h) + boff + n * 2048 + k * 1024); } while (0)
#define PG8_MMA(ai, bj, At, Bt) do { __builtin_amdgcn_s_setprio(1); _Pragma("unroll") for (int m = 0; m < 4; ++m) _Pragma("unroll") for (int n = 0; n < 2; ++n) _Pragma("unroll") for (int k = 0; k < 2; ++k) \
        acc[ai][bj][m][n] = __builtin_amdgcn_mfma_f32_16x16x32_bf16(Bt[n][k], At[m][k], acc[ai][bj][m][n], 0, 0, 0); __builtin_amdgcn_s_setprio(0); } while (0)
#define PG8_WAIT_V(n) asm volatile("s_waitcnt vmcnt(" #n ")" ::: "memory")
#define PG8_WAIT_L(n) asm volatile("s_waitcnt lgkmcnt(" #n ")" ::: "memory")
#define PG8_BAR __builtin_amdgcn_s_barrier()
#define PG8_SCHED __builtin_amdgcn_sched_barrier(0)
#define PG8_AOFFS(d00, d01, d10, d11, u) do { if constexpr (Sched::GATHER) { d00 = (unsigned)(S.arow_off(u, R0) + C0) * 2u; d01 = (unsigned)(S.arow_off(u, R1) + C1) * 2u; \
        d10 = (unsigned)(S.arow_off(u, R0 + 128) + C0) * 2u; d11 = (unsigned)(S.arow_off(u, R1 + 128) + C1) * 2u; } } while (0)
    f32x4 acc[2][2][4][2];
#pragma unroll
    for (int a_ = 0; a_ < 2; ++a_)
#pragma unroll
        for (int b_ = 0; b_ < 2; ++b_)
#pragma unroll
            for (int m = 0; m < 4; ++m)
#pragma unroll
                for (int n = 0; n < 2; ++n) acc[a_][b_][m][n] = (f32x4){0.f, 0.f, 0.f, 0.f};
    bf16x8 At[4][2], B0[2][2], B1[2][2];
    const char* cA = uni_ptr(cur.A); const char* cB = uni_ptr(cur.B);
    unsigned c00 = 0, c01 = 0, c10 = 0, c11 = 0, n00 = 0, n01 = 0, n10 = 0, n11 = 0;
    PG8_AOFFS(c00, c01, c10, c11, cur);
    PG8_STAGE_B(PG8_SB(0, 0), cB); PG8_STAGE_B(PG8_SB(0, 1), cB + hstepB); PG8_STAGE_A(PG8_SA(0, 0), cA, 0, c00, c01); PG8_STAGE_A(PG8_SA(0, 1), cA, 1, c10, c11);
    if (wr == 1) PG8_BAR;
    PG8_WAIT_V(2); PG8_BAR;
    PG8_STAGE_B(PG8_SB(1, 0), cB + kstep); PG8_STAGE_A(PG8_SA(1, 0), cA + kstep, 0, c00, c01); PG8_STAGE_B(PG8_SB(1, 1), cB + hstepB + kstep);
    PG8_WAIT_V(6); PG8_BAR;
    for (;;) {
        const bool has_next = S.next(ui + 1, nxt);
        const char* nA = has_next ? uni_ptr(nxt.A) : cA; const char* nB = has_next ? uni_ptr(nxt.B) : cB;
        if (has_next) { PG8_AOFFS(n00, n01, n10, n11, nxt); } else { n00 = c00; n01 = c01; n10 = c10; n11 = c11; }
        if constexpr (Epi::LDSMETA) { int tq = threadIdx.x; asm volatile("" : "+v"(tq));
            if (tq < 256) { const unsigned* gp = E.mptr(cur, tq); LAS unsigned* lp = (LAS unsigned*)(lds + 131072 + (ui & 1) * 2048 + __builtin_amdgcn_readfirstlane(tq >> 6) * 256);
                __builtin_amdgcn_global_load_lds(gp, lp, 4, 0, 0); __builtin_amdgcn_global_load_lds(gp + 1, lp + 256, 4, 0, 0); } }
        typename Epi::Pre PE[Epi::EARLY ? 4 : 1];
        if constexpr (Epi::EARLY) { int tq = threadIdx.x; asm volatile("" : "+v"(tq)); const int wq = tq >> 6, lq = tq & 63, rbq = (wq >> 2) * 64 + (lq & 15), clq = (wq & 3) * 32 + (Epi::PERM ? 8 : 4) * (lq >> 4);
#pragma unroll
            for (int g = 0; g < 4; ++g) E.pre(cur, rbq + g * 16, clq, PE[g]); }
        for (int t = 0; t < nt; t += 2) {
            const bool last = (t == nt - 2);
            const char* a1 = cA + (size_t)(t + 1) * kstep;
            const char* a2 = last ? nA : cA + (size_t)(t + 2) * kstep; const char* b2 = last ? nB : cB + (size_t)(t + 2) * kstep;
            const char* a3 = a2 + kstep; const char* b3 = b2 + kstep;
            asm volatile("" : "+s"(a1), "+s"(a2), "+s"(b2), "+s"(a3), "+s"(b3));
            const unsigned o00 = last ? n00 : c00, o01 = last ? n01 : c01, o10 = last ? n10 : c10, o11 = last ? n11 : c11;
            PG8_LDB(B0, 0, 0); PG8_LDB(B1, 0, 1); PG8_SCHED; PG8_LDA(At, 0, 0); PG8_STAGE_A(PG8_SA(1, 1), a1, 1, c10, c11);
            PG8_WAIT_V(8); PG8_WAIT_L(0); PG8_BAR; PG8_MMA(0, 0, At, B0); PG8_MMA(0, 1, At, B1); PG8_BAR; PG8_SCHED;
            PG8_LDA(At, 0, 1); PG8_STAGE_B(PG8_SB(0, 0), b2); PG8_STAGE_B(PG8_SB(0, 1), b2 + hstepB); PG8_STAGE_A(PG8_SA(0, 0), a2, 0, o00, o01);
            PG8_WAIT_V(8); PG8_WAIT_L(0); PG8_BAR; PG8_MMA(1, 0, At, B0); PG8_MMA(1, 1, At, B1);
            PG8_BAR; PG8_SCHED;
            PG8_LDB(B0, 1, 0); PG8_LDB(B1, 1, 1); PG8_SCHED; PG8_LDA(At, 1, 0); PG8_STAGE_A(PG8_SA(0, 1), a2, 1, o10, o11);
            PG8_WAIT_V(8); PG8_WAIT_L(0); PG8_BAR; PG8_MMA(0, 0, At, B0); PG8_MMA(0, 1, At, B1); PG8_BAR; PG8_SCHED;
            PG8_LDA(At, 1, 1); PG8_STAGE_B(PG8_SB(1, 0), b3); PG8_STAGE_B(PG8_SB(1, 1), b3 + hstepB); PG8_STAGE_A(PG8_SA(1, 0), a3, 0, o00, o01);
            PG8_WAIT_V(8); PG8_WAIT_L(0); PG8_BAR; PG8_MMA(1, 0, At, B0); PG8_MMA(1, 1, At, B1); PG8_BAR; PG8_SCHED;
        }
        if (PG8_ALIGN) { if (wr == 0) PG8_BAR; }
        { int tz = threadIdx.x; asm volatile("" : "+v"(tz));
          const int wz = tz >> 6, lz = tz & 63, wrz = wz >> 2, wcz = wz & 3, frz = lz & 15, fqz = lz >> 4;
          const int clz = wcz * 32 + (Epi::PERM ? 8 : 4) * fqz, rbz = wrz * 64 + frz;
          typename Epi::UPre UP; E.upre(cur, clz, UP);
          if constexpr (Epi::EARLY) { typename Epi::Pre P2[4];
#pragma unroll
              for (int g = 0; g < 4; ++g) E.pre(cur, HALF + rbz + g * 16, clz, P2[g]);
#pragma unroll
              for (int g = 0; g < 4; ++g) E(cur, rbz + g * 16, clz, acc[0][0][g][0], acc[0][0][g][1], acc[0][1][g][0], acc[0][1][g][1], UP, PE[g]);
#pragma unroll
              for (int g = 0; g < 4; ++g) E(cur, HALF + rbz + g * 16, clz, acc[1][0][g][0], acc[1][0][g][1], acc[1][1][g][0], acc[1][1][g][1], UP, P2[g]); }
          else {
#pragma unroll
          for (int gb = 0; gb < 8; gb += Epi::BATCH) { typename Epi::Pre PP[Epi::BATCH];
#pragma unroll
              for (int j = 0; j < Epi::BATCH; ++j) { if constexpr (Epi::LDSMETA) E.pre_lds(cur, lds + 131072 + (ui & 1) * 2048, ((gb + j) >> 2) * HALF + rbz + ((gb + j) & 3) * 16, PP[j]); else E.pre(cur, ((gb + j) >> 2) * HALF + rbz + ((gb + j) & 3) * 16, clz, PP[j]); }
#pragma unroll
              for (int j = 0; j < Epi::BATCH; ++j) { const int ai = (gb + j) >> 2, m = (gb + j) & 3;
                  E(cur, ai * HALF + rbz + m * 16, clz, acc[ai][0][m][0], acc[ai][0][m][1], acc[ai][1][m][0], acc[ai][1][m][1], UP, PP[j]); } } }
        }
        if (!has_next) break;
#pragma unroll
        for (int a_ = 0; a_ < 2; ++a_)
#pragma unroll
            for (int b_ = 0; b_ < 2; ++b_)
#pragma unroll
                for (int m = 0; m < 4; ++m)
#pragma unroll
                    for (int n = 0; n < 2; ++n) acc[a_][b_][m][n] = (f32x4){0.f, 0.f, 0.f, 0.f};
        cur = nxt; cA = nA; cB = nB; c00 = n00; c01 = n01; c10 = n10; c11 = n11; ++ui;
        if (PG8_ALIGN) { if (wr == 1) PG8_BAR; }
    }
    PG8_WAIT_V(0);
    if (!PG8_ALIGN) { if (wr == 0) PG8_BAR; }
    PG8_BAR;
#undef PG8_SA
#undef PG8_SB
#undef PG8_GLDS
#undef PG8_STAGE_A
#undef PG8_STAGE_B
#undef PG8_LDA
#undef PG8_LDB
#undef PG8_MMA
#undef PG8_WAIT_V
#undef PG8_WAIT_L
#undef PG8_BAR
#undef PG8_SCHED
#undef PG8_AOFFS
}
template <bool FAST, class Sched, class Epi>
DI void gemm_units(LAS unsigned char* lds, const Sched& S, const Epi& E, int K, int ldb) { if constexpr (FAST) gemm_fast(lds, S, E, K, ldb); else gemm_naive(S, E, K, ldb); }

struct SchedDense {
    static constexpr bool GATHER = false;
    const bf16_t* A; const bf16_t* B; int lda, ldb, nM, nN, G, c;
    DI bool next(int i, GU& u) const { const int L = i * G + c; const int nwg = nM * nN; if (L >= nwg) return false;
        int wgid = L; { const int q = nwg >> 3, r = nwg & 7, xcd = wgid & 7, off = wgid >> 3; wgid = (xcd < r ? xcd * (q + 1) : r * (q + 1) + (xcd - r) * q) + off; }
        const int nig = 8 * nN, gid = wgid / nig, fm = gid * 8, gsz = (nM - fm) < 8 ? (nM - fm) : 8; u.pm = fm + ((wgid % nig) % gsz); u.pn = (wgid % nig) / gsz;
        u.A = A + (size_t)u.pm * 256 * lda; u.B = B + (size_t)u.pn * 256 * ldb; u.e = 0; u.ti = 0; u.nvalid = 256; return true; }
    DI size_t arow_off(const GU&, int r) const { return (size_t)r * lda; }
};
struct SchedGates {
    static constexpr bool GATHER = false;
    const bf16_t* A; const bf16_t* B; int nM, G, c;
    DI bool next(int i, GU& u) const { const int L = i * G + c; const int nwg = nM * 16; if (L >= nwg) return false;
        int wgid = L; { const int q = nwg >> 3, r = nwg & 7, xcd = wgid & 7, off = wgid >> 3; wgid = (xcd < r ? xcd * (q + 1) : r * (q + 1) + (xcd - r) * q) + off; }
        u.pm = wgid >> 4; u.pn = wgid & 15;
        u.A = A + (size_t)u.pm * 256 * 1024 + (u.pn >> 1) * 128; u.B = B + (size_t)u.pn * 256 * 128; u.e = 0; u.ti = 0; u.nvalid = 256; return true; }
    DI size_t arow_off(const GU&, int r) const { return (size_t)r * 1024; }
};
template <bool GATH> struct SchedMoeT {
    static constexpr bool GATHER = GATH;
    const bf16_t* A; const bf16_t* B; const int* cnt; const int2* list; volatile LAS int* toff; volatile LAS unsigned char* rt2e; int NT, NJ, G, c; size_t bstride;
    DI bool next(int i, GU& u) const {
        const int xcd = c & 7, k = c >> 3, nk = G >> 3, base = NT >> 3, rem = NT & 7, start = xcd * base + (xcd < rem ? xcd : rem), len = base + (xcd < rem ? 1 : 0);
        const int full = len / nk, remt = len - full * nk;
        int rt;
        if (GATH) { const int uu = k + i * nk; if (uu >= len * NJ) return false; rt = start + uu / NJ; u.pn = uu % NJ; }
        else if (i < full * NJ) { const int ti_ = i / NJ; rt = start + k + ti_ * nk; u.pn = i - ti_ * NJ; }
        else { const int uu = k + (i - full * NJ) * nk; if (uu >= remt * NJ) return false; rt = start + full * nk + uu / NJ; u.pn = uu % NJ; }
        u.pm = rt;
        const int e = __builtin_amdgcn_readfirstlane((int)rt2e[rt]);
        u.e = e; u.ti = rt - __builtin_amdgcn_readfirstlane(toff[e]); u.nvalid = __builtin_amdgcn_readfirstlane((int)((volatile LAS unsigned short*)(toff + 128 + 352))[rt]);
        u.A = GATH ? A : A + (size_t)rt * 256 * 256; u.B = B + (size_t)e * bstride + (size_t)u.pn * 256 * (GATH ? 1024 : 256); return true; }
    DI size_t arow_off(const GU& u, int r) const {
        if (!GATH) return (size_t)r * 256;
        int tok; if (u.e < 64) tok = (r < u.nvalid) ? (list[(size_t)u.e * T + u.ti * 256 + r].x >> 3) : 0; else tok = u.ti * 256 + r;
        return (size_t)tok * 1024; }
};

struct PreNone {};
struct PreRope { f32x4 t0, t1; };
struct EpiAbIn { bf16_t *PH, *QB, *KB, *VB; const float* rope; typedef PreNone UPre; typedef PreRope Pre; static constexpr int BATCH = 8; static constexpr bool LDSMETA = false, EARLY = false, PERM = false;
    DI void upre(const GU&, int, UPre&) const {}
    DI void pre(const GU& u, int rl, int cl, Pre& P) const { P.t0 = (f32x4){1.f, 0.f, 1.f, 0.f}; P.t1 = P.t0;
        const int row = u.pm * 256 + rl;
        if (u.pn >= 6 && u.pn < 10 && row < TL) { const int d = cl & 63, axis = d >> 5, f0 = d & 15, pos = row & (SEQ - 1), p = axis ? (pos & 63) : (pos >> 6);
            P.t0 = *(const f32x4*)(rope + (p * 16 + f0) * 2); P.t1 = *(const f32x4*)(rope + (p * 16 + f0) * 2 + 4); } }
    DI void put(int row, int col, f32x4 v0, f32x4 v1, const Pre& P) const {
        if (col < 1536) { store_bf4(PH + (size_t)row * 1536 + col, v0); store_bf4(PH + (size_t)row * 1536 + col + 16, v1); }
        else if (col < 2560) { int cc = col - 1536; bf16_t* dst = cc < 512 ? QB : KB; const float sc = cc < 512 ? C2 : 1.f; cc &= 511;
            const f32x4 cs = {P.t0[0], P.t0[2], P.t1[0], P.t1[2]}, sn = {P.t0[1], P.t0[3], P.t1[1], P.t1[3]};
            const f32x4 xa = v0, xb = v1; v0 = (xa * cs - xb * sn) * sc; v1 = (xb * cs + xa * sn) * sc;
            store_bf4(dst + (size_t)row * 512 + cc, v0); store_bf4(dst + (size_t)row * 512 + cc + 16, v1); }
        else { const int cc = col - 2560; store_bf4(VB + (size_t)row * 512 + cc, v0); store_bf4(VB + (size_t)row * 512 + cc + 16, v1); }
    }
    DI void operator()(const GU& u, int rl, int cl, f32x4 a0, f32x4 a1, f32x4 b0, f32x4 b1, const UPre&, const Pre& P) const {
        const int row = u.pm * 256 + rl, col = u.pn * 256 + cl; put(row, col, a0, a1, P); put(row, col + 128, b0, b1, P); }
};
DI float gelu_tanh(float x) { const float y = 0.7978845608028654f * (x + 0.044715f * x * x * x); const float t = 1.f - 2.f * __builtin_amdgcn_rcpf(1.f + __expf(2.f * y)); return 0.5f * x * (1.f + t); }
struct EpiRgIn { bf16_t *GATE, *REC; typedef PreNone UPre; typedef PreNone Pre; static constexpr int BATCH = 8; static constexpr bool LDSMETA = false, EARLY = false, PERM = true;
    DI void upre(const GU&, int, UPre&) const {}
    DI void pre(const GU&, int, int, Pre&) const {}
    DI void put(int row, int col, f32x4 v0, f32x4 v1) const {
        if (col < 1024) { f32x4 g0, g1;
#pragma unroll
            for (int j = 0; j < 4; ++j) { g0[j] = gelu_tanh(v0[j]); g1[j] = gelu_tanh(v1[j]); }
            store_bf8(GATE + (size_t)row * 1024 + col, g0, g1); }
        else store_bf8(REC + (size_t)row * 1024 + col - 1024, v0, v1); }
    DI void operator()(const GU& u, int rl, int cl, f32x4 a0, f32x4 a1, f32x4 b0, f32x4 b1, const UPre&, const Pre&) const {
        const int row = u.pm * 256 + rl, col = u.pn * 256 + cl; put(row, col, a0, a1); put(row, col + 128, b0, b1); }
};
struct EpiM { bf16_t* O;
    typedef PreNone UPre; typedef PreNone Pre; static constexpr int BATCH = 8; static constexpr bool LDSMETA = false, EARLY = false, PERM = true;
    DI void upre(const GU&, int, UPre&) const {}
    DI void pre(const GU&, int, int, Pre&) const {}
    DI void operator()(const GU& u, int rl, int cl, f32x4 a0, f32x4 a1, f32x4 b0, f32x4 b1, const UPre&, const Pre&) const {
        bf16_t* p = O + (size_t)(u.pm * 256 + rl) * 1024 + u.pn * 256 + cl; store_bf8(p, a0, a1); store_bf8(p + 128, b0, b1); }
};
struct PreGU { f32x4 ba0, ba1, bx0, bx1, lm0, lm1; };
struct PreGP { u32x4 u; };
struct EpiGates { const bf16_t* U; bf16_t *LA, *BB; const float *ba, *bx, *lam;
    typedef PreGU UPre; typedef PreGP Pre; static constexpr int BATCH = 8; static constexpr bool LDSMETA = false, EARLY = false, PERM = true;
    DI void upre(const GU& u, int cl, UPre& P) const { const int k = u.pn >> 1, dir = u.pn & 1, ci = dir * 1024 + k * 128 + cl;
        P.ba0 = *(const f32x4*)(ba + ci); P.ba1 = *(const f32x4*)(ba + ci + 4); P.bx0 = *(const f32x4*)(bx + ci); P.bx1 = *(const f32x4*)(bx + ci + 4);
        P.lm0 = *(const f32x4*)(lam + ci); P.lm1 = *(const f32x4*)(lam + ci + 4); }
    DI void pre(const GU& u, int rl, int cl, Pre& P) const { const int row = u.pm * 256 + rl, ch = (u.pn >> 1) * 128 + cl; P.u = *(const u32x4*)(U + (size_t)row * 1024 + ch); }
    DI void calc(f32x4 ra, f32x4 ia, unsigned ux, unsigned uy, f32x4 bav, f32x4 bxv, f32x4 lmv, f32x4& la, f32x4& bb) const {
        const float uv[4] = {__uint_as_float(ux << 16), __uint_as_float(ux & 0xffff0000u), __uint_as_float(uy << 16), __uint_as_float(uy & 0xffff0000u)};
#pragma unroll
        for (int j = 0; j < 4; ++j) {
            const float ex = __expf(-fminf(fmaxf(ra[j] + bav[j], -30.f), 30.f)) + 1.f, ey = __expf(-fminf(fmaxf(ia[j] + bxv[j], -30.f), 30.f)) + 1.f, rc = __builtin_amdgcn_rcpf(ex * ey);
            la[j] = (ey * rc) * lmv[j]; bb[j] = (ex * rc) * uv[j]; } }
    DI void operator()(const GU& u, int rl, int cl, f32x4 a0, f32x4 a1, f32x4 b0, f32x4 b1, const UPre& UP, const Pre& P) const {
        const int row = u.pm * 256 + rl, k = u.pn >> 1, dir = u.pn & 1, ch = k * 128 + cl; f32x4 la0, bb0, la1, bb1;
        calc(a0, b0, P.u.x, P.u.y, UP.ba0, UP.bx0, UP.lm0, la0, bb0); calc(a1, b1, P.u.z, P.u.w, UP.ba1, UP.bx1, UP.lm1, la1, bb1);
        store_bf8(LA + ((size_t)dir * T + row) * 1024 + ch, la0, la1); store_bf8(BB + ((size_t)dir * T + row) * 1024 + ch, bb0, bb1); }
};
struct EpiGU { bf16_t* HS; typedef PreNone UPre; typedef PreNone Pre; static constexpr int BATCH = 8; static constexpr bool LDSMETA = false, EARLY = false, PERM = true;
    DI void upre(const GU&, int, UPre&) const {}
    DI void pre(const GU&, int, int, Pre&) const {}
    DI void operator()(const GU& u, int rl, int cl, f32x4 a0, f32x4 a1, f32x4 b0, f32x4 b1, const UPre&, const Pre&) const {
        f32x4 h0, h1;
#pragma unroll
        for (int j = 0; j < 4; ++j) { h0[j] = a0[j] * sigmoidf_(a0[j]) * b0[j]; h1[j] = a1[j] * sigmoidf_(a1[j]) * b1[j]; }
        store_bf8(HS + ((size_t)u.pm * 256 + rl) * 256 + u.pn * 128 + cl, h0, h1); }
};
struct PreD { int2 meta; };
struct EpiDn { bf16_t* Y; const int2* list;
    typedef PreNone UPre; typedef PreD Pre; static constexpr int BATCH = 8; static constexpr bool LDSMETA = true, EARLY = false, PERM = true;
    DI void upre(const GU&, int, UPre&) const {}
    DI void pre(const GU& u, int rl, int, Pre& P) const { P.meta = (rl < u.nvalid) ? list[(size_t)u.e * T + u.ti * 256 + rl] : make_int2(-1, 0); }
    DI const unsigned* mptr(const GU& u, int r) const { return (const unsigned*)(list + (size_t)u.e * T + u.ti * 256 + r); }
    DI void pre_lds(const GU& u, const LAS unsigned char* mb, int rl, Pre& P) const { const int px = *(const LAS int*)(mb + rl * 4), py = *(const LAS int*)(mb + 1024 + rl * 4); P.meta = (rl < u.nvalid) ? make_int2(px, py) : make_int2(-1, 0); }
    DI void operator()(const GU& u, int, int cl, f32x4 a0, f32x4 a1, f32x4 b0, f32x4 b1, const UPre&, const Pre& P) const {
        if (P.meta.x >= 0) { const float w = __int_as_float(P.meta.y); bf16_t* y = Y + (size_t)P.meta.x * 1024 + u.pn * 256 + cl;
            store_bf8(y, a0 * w, a1 * w); store_bf8(y + 128, b0 * w, b1 * w); } }
};

DI void phase_mod(const Args& a, LAS unsigned char* lds) {
    const float* kp_I_BMOD = kin(I_BMOD); const float* kp_I_C = kin(I_C); const float* kp_I_CCTX = kin(I_CCTX); const float* kp_I_WMOD = kin(I_WMOD);
    LAS float* sc = (LAS float*)lds;
    LAS float* red = sc + 17 * 1024;
    float* MOD = (float*)(a.ws + WS_MOD);
    const int tid = otid(), wave = tid >> 6, lane = tid & 63;
    for (int i = tid; i < 17 * 1024; i += NTH) { const float v = (i < 16384) ? kp_I_C[i] : kp_I_CCTX[i - 16384]; sc[i] = v / (1.f + expf(-v)); }
    __syncthreads();
    const int wv = __builtin_amdgcn_readfirstlane(wave), col = lane & 31, kh = lane >> 5;
    const unsigned voff = (unsigned)(kh * 64 * 6144 + col) * 4u;
    for (int unit = obid(); unit < 4 * 192; unit += gridDim.x) {
        const int l = unit / 192, n0 = (unit % 192) * 32;
        const float* Wb = kp_I_WMOD + (size_t)l * 1024 * 6144 + n0 + (size_t)(wv * 128) * 6144;
        float w[64];
#pragma unroll
        for (int u = 0; u < 64; ++u) w[u] = *(const float*)((const char*)(Wb + (size_t)u * 6144) + voff);
        float acc[17];
#pragma unroll
        for (int r = 0; r < 17; ++r) acc[r] = 0.f;
        const LAS float* scp = sc + wv * 128 + kh * 64;
#pragma unroll
        for (int u4 = 0; u4 < 16; ++u4) {
#pragma unroll
            for (int r = 0; r < 17; ++r) { const f32x4 s = *(const LAS f32x4*)(scp + r * 1024 + 4 * u4); acc[r] += (s[0] * w[4 * u4] + s[1] * w[4 * u4 + 1]) + (s[2] * w[4 * u4 + 2] + s[3] * w[4 * u4 + 3]); } }
#pragma unroll
        for (int r = 0; r < 17; ++r) red[((wv * 2 + kh) * 17 + r) * 32 + col] = acc[r];
        __syncthreads();
        for (int i = tid; i < 17 * 32; i += NTH) { const int r = i >> 5, cl = i & 31; float s = 0.f;
#pragma unroll
            for (int p = 0; p < 16; ++p) s += red[(p * 17 + r) * 32 + cl];
            MOD[((size_t)l * 17 + r) * 6144 + n0 + cl] = s + kp_I_BMOD[l * 6144 + n0 + cl]; }
        __syncthreads();
    }
}
DI void phase_hdn(const Args& a) {
    const float* kp_I_FB1 = kin(I_FB1); const float* kp_I_FB2 = kin(I_FB2); const float* kp_I_FB3 = kin(I_FB3); const float* kp_I_FREQ = kin(I_FREQ); const float* kp_I_FW1 = kin(I_FW1); const float* kp_I_FW2 = kin(I_FW2); const float* kp_I_FW3 = kin(I_FW3);
    float* HDN = (float*)(a.ws + WS_HDN);
    const int tid = otid(); const int lane = tid & 63, gw = obid() * NWV + (tid >> 6), NGW = gridDim.x * NWV;
    for (int task = gw; task < 2 * 2304; task += NGW) {
        const int e = task / 2304, p = task % 2304, nsel = p >= 2048, t = nsel ? p - 2048 : p, n = nsel ? 256 : 2048;
        const float tt = (float)t / (float)(n - 1);
        const float fm = 1e-4f + (float)(lane & 15) * ((15.f - 1e-4f) / 15.f);
        const float ang = (6.283185307179586f / (float)n) * (float)t * fm;
        const float cs = cosf(ang), sn = sinf(ang);
        const float* w1 = kp_I_FW1 + e * 33 * 64; const float* w2 = kp_I_FW2 + e * 64 * 64; const float* w3 = kp_I_FW3 + e * 64 * 64;
        const float fr = kp_I_FREQ[e * 64 + lane];
        float s = tt * w1[lane];
#pragma unroll
        for (int m = 0; m < 16; ++m) { s += lane_bcast(cs, m) * w1[(1 + m) * 64 + lane]; s -= lane_bcast(sn, m) * w1[(17 + m) * 64 + lane]; }
        float h = sinf(fr * (s + kp_I_FB1[e * 64 + lane]));
        s = 0.f;
#pragma unroll 8
        for (int i = 0; i < 64; ++i) s += lane_bcast(h, i) * w2[i * 64 + lane];
        h = sinf(fr * (s + kp_I_FB2[e * 64 + lane]));
        s = 0.f;
#pragma unroll 8
        for (int i = 0; i < 64; ++i) s += lane_bcast(h, i) * w3[i * 64 + lane];
        h = sinf(fr * (s + kp_I_FB3[e * 64 + lane]));
        HDN[(size_t)task * 64 + lane] = h;
    }
}
DI void phase_rope(const Args& a) {
    const float* kp_I_RGLAM = kin(I_RGLAM);
    float* R = (float*)(a.ws + WS_ROPE);
    const int gt = obid() * NTH + otid();
    if (gt < 64 * 16) { const int p = gt >> 4, f = gt & 15; const float inv = powf(10000.f, -(float)f / 16.f); const float ang = (float)p * inv; R[gt * 2] = cosf(ang); R[gt * 2 + 1] = sinf(ang); }
    if (gt < 2 * 2048) { float* LSG = (float*)(a.ws + WS_ROPE + 65536); LSG[gt] = -8.f * log1pf(expf(-kp_I_RGLAM[gt])); }
}
DI void transpose_item(const float* W, int ldw, bf16_t* WT, int ldt, int k0, int n0, int drow0, int dcol0, LAS float* scr, int lane) {
    const int c4 = (lane & 15) * 4, kr = lane >> 4;
    f32x4 tv[16];
#pragma unroll
    for (int i = 0; i < 16; ++i) tv[i] = *(const f32x4*)(W + (size_t)(k0 + 4 * i + kr) * ldw + n0 + c4);
#pragma unroll
    for (int i = 0; i < 16; ++i) { LAS float* d = scr + (4 * i + kr) * 65 + c4; d[0] = tv[i][0]; d[1] = tv[i][1]; d[2] = tv[i][2]; d[3] = tv[i][3]; }
    LDS_WAIT();
    const int c = lane & 7;
#pragma unroll
    for (int j = 0; j < 8; ++j) { const int n = (lane >> 3) + 8 * j; const LAS float* s = scr + (8 * c) * 65 + n;
        u32x4 o; o.x = pk2(s[0 * 65], s[1 * 65]); o.y = pk2(s[2 * 65], s[3 * 65]); o.z = pk2(s[4 * 65], s[5 * 65]); o.w = pk2(s[6 * 65], s[7 * 65]);
        *(u32x4*)(WT + (size_t)(drow0 + n) * ldt + dcol0 + 8 * c) = o; }
    LDS_WAIT();
}
DI void phase_weights(const Args& a, int l, LAS unsigned char* lds) {
    const int tid = otid(), wave = tid >> 6, lane = tid & 63, gw = obid() * NWV + wave, NGW = gridDim.x * NWV;
    LAS float* scr = (LAS float*)(lds + wave * 16896);
    bf16_t* WIN = (bf16_t*)(a.ws + WS_WIN); bf16_t* WOUT = (bf16_t*)(a.ws + WS_WOUT); bf16_t* WG = (bf16_t*)(a.ws + WS_WG);
    bf16_t* WGU = (bf16_t*)(a.ws + WS_WGU); bf16_t* WD = (bf16_t*)(a.ws + WS_WD);
    const int half = l >> 1;
    const float* p_exg = kin(I_EXG); const float* p_exu = kin(I_EXU); const float* p_exd = kin(I_EXD); const float* p_shg = kin(I_SHG); const float* p_shu = kin(I_SHU); const float* p_shd = kin(I_SHD);
    for (int it = gw; it < 65 * 192; it += NGW) {
        const int e = it / 192, m = (it % 192) >> 6, r = it & 63;
        if (m < 2) { const float* src = (e < 64) ? (m ? p_exu : p_exg) + ((size_t)l * 64 + e) * 1024 * 256 : (m ? p_shu : p_shg) + (size_t)l * 1024 * 256;
            const int kb = r >> 2, nb = r & 3, n0 = nb * 64; const int drow0 = (n0 >> 7) * 256 + (n0 & 127) + (m ? 128 : 0);
            transpose_item(src, 256, WGU + (size_t)e * 512 * 1024, 1024, kb * 64, n0, drow0, kb * 64, scr, lane); }
        else { const float* src = (e < 64) ? p_exd + ((size_t)l * 64 + e) * 256 * 1024 : p_shd + (size_t)l * 256 * 1024;
            const int kb = r >> 4, nb = r & 15; transpose_item(src, 1024, WD + (size_t)e * 1024 * 256, 256, kb * 64, nb * 64, nb * 64, kb * 64, scr, lane); }
    }
    { const float* rw = kin(I_ROUTW) + (size_t)l * 1024 * 64; bf16_t* RWT = (bf16_t*)(a.ws + WS_ROPE + 131072);
      for (int idx = obid() * NTH + tid; idx < 64 * 1024; idx += gridDim.x * NTH) { const int e = idx >> 10, k = idx & 1023; const float w = rw[k * 64 + e]; const unsigned hi = f2bf(w);
          RWT[idx] = (bf16_t)hi; RWT[65536 + idx] = (bf16_t)f2bf(w - __uint_as_float(hi << 16)); } }
    if ((l & 1) == 0) {
        const float* win = kin(I_ABWIN) + (size_t)half * 1024 * 3072; const float* wout = kin(I_ABWOUT) + (size_t)half * 1024 * 1024;
        for (int it = gw; it < 768 + 256; it += NGW) {
            if (it < 768) { const int kb = it / 48, nb = it % 48; transpose_item(win, 3072, WIN, 1024, kb * 64, nb * 64, nb * 64, kb * 64, scr, lane); }
            else { const int r = it - 768, kb = r >> 4, nb = r & 15; transpose_item(wout, 1024, WOUT, 1024, kb * 64, nb * 64, nb * 64, kb * 64, scr, lane); }
        }
    } else {
        const float* win = kin(I_RGWIN) + (size_t)half * 1024 * 2048; const float* wout = kin(I_RGWOUT) + (size_t)half * 1024 * 1024;
        for (int it = gw; it < 512 + 256; it += NGW) {
            if (it < 512) { const int kb = it >> 5, nb = it & 31; transpose_item(win, 2048, WIN, 1024, kb * 64, nb * 64, nb * 64, kb * 64, scr, lane); }
            else { const int r = it - 512, kb = r >> 4, nb = r & 15; transpose_item(wout, 1024, WOUT, 1024, kb * 64, nb * 64, nb * 64, kb * 64, scr, lane); }
        }
        const float* wa = kin(I_RGWA) + (size_t)half * 2 * 8 * 128 * 128; const float* wx = kin(I_RGWX) + (size_t)half * 2 * 8 * 128 * 128;
        for (int idx = obid() * NTH + tid; idx < 4096 * 128; idx += gridDim.x * NTH) {
            const int n = idx >> 7, kk = idx & 127, pn = n >> 8, hf = (n >> 7) & 1, c = n & 127, k = pn >> 1, dir = pn & 1;
            const float v = (hf ? wx : wa)[(((size_t)dir * 8 + k) * 128 + kk) * 128 + c];
            WG[idx] = (bf16_t)f2bf(v);
        }
    }
}
DI void split8(f32x4 v0, f32x4 v1, bf16x8& hi, bf16x8& lo) {
    u32x4 hp; hp.x = pk2(v0[0], v0[1]); hp.y = pk2(v0[2], v0[3]); hp.z = pk2(v1[0], v1[1]); hp.w = pk2(v1[2], v1[3]);
    u32x4 lp; lp.x = pk2(v0[0] - __uint_as_float(hp.x << 16), v0[1] - __uint_as_float(hp.x & 0xffff0000u)); lp.y = pk2(v0[2] - __uint_as_float(hp.y << 16), v0[3] - __uint_as_float(hp.y & 0xffff0000u));
    lp.z = pk2(v1[0] - __uint_as_float(hp.z << 16), v1[1] - __uint_as_float(hp.z & 0xffff0000u)); lp.w = pk2(v1[2] - __uint_as_float(hp.w << 16), v1[3] - __uint_as_float(hp.w & 0xffff0000u));
    hi = __builtin_bit_cast(bf16x8, hp); lo = __builtin_bit_cast(bf16x8, lp);
}
DI void phase_kr(const Args& a) {
    const float* kp_I_DECAY = kin(I_DECAY); const float* kp_I_FW4 = kin(I_FW4); const float* kp_I_SKIP = kin(I_SKIP);
    const float* HDN = (const float*)(a.ws + WS_HDN);
    bf16_t* KRL = (bf16_t*)(a.ws + WS_KRL); bf16_t* KRC = (bf16_t*)(a.ws + WS_KRC);
    const int tid = otid(); const int lane = tid & 63, i = lane & 15, q = lane >> 4, gw = obid() * NWV + __builtin_amdgcn_readfirstlane(tid >> 6), NGW = gridDim.x * NWV;
    const unsigned voffb = (unsigned)(8 * q * 2048 + i) * 4u;
    for (int item = gw; item < 2 * 72 * 8; item += NGW) {
        const int part = item & 7, rest = item >> 3, e = rest / 72, xc = rest % 72, nsel = xc >= 64, n = nsel ? 256 : 2048, x0 = (nsel ? xc - 64 : xc) * 64;
        const int dir = (x0 >= n) ? 1 : 0; const bool lag0 = (x0 == n);
        const float invn = nsel ? (1.f / 255.f) : (1.f / 2047.f);
        const float* w4 = kp_I_FW4 + (size_t)e * 64 * 2048; const float* dec = kp_I_DECAY + e * 2048;
        bf16x8 ah[4][2], al[4][2];
#pragma unroll
        for (int mt = 0; mt < 4; ++mt) { const int x = x0 + mt * 16 + i, d = n - x, t = d < 0 ? -d : d; const bool valid = t < n;
            const float* hr = HDN + ((size_t)e * 2304 + (nsel ? 2048 : 0) + (valid ? t : 0)) * 64 + 8 * q;
#pragma unroll
            for (int ks = 0; ks < 2; ++ks) split8(*(const f32x4*)(hr + ks * 32), *(const f32x4*)(hr + ks * 32 + 4), ah[mt][ks], al[mt][ks]); }
#pragma unroll 1
        for (int half = 0; half < 2; ++half) {
            float wv[4][16];
#pragma unroll
            for (int nt = 0; nt < 4; ++nt) { const int oc0 = part * 128 + half * 64 + nt * 16, f0 = (oc0 >> 9) * 1024 + dir * 512 + (oc0 & 511);
#pragma unroll
                for (int k = 0; k < 16; ++k) wv[nt][k] = *(const float*)((const char*)(w4 + f0 + ((k >> 3) * 32 + (k & 7)) * 2048) + voffb); }
#pragma unroll
            for (int nt = 0; nt < 4; ++nt) { const int oc0 = part * 128 + half * 64 + nt * 16, ord = oc0 >> 9, c0 = oc0 & 511, f0 = ord * 1024 + dir * 512 + c0;
                bf16x8 bh[2], bl[2];
#pragma unroll
                for (int ks = 0; ks < 2; ++ks) split8((f32x4){wv[nt][ks * 8], wv[nt][ks * 8 + 1], wv[nt][ks * 8 + 2], wv[nt][ks * 8 + 3]}, (f32x4){wv[nt][ks * 8 + 4], wv[nt][ks * 8 + 5], wv[nt][ks * 8 + 6], wv[nt][ks * 8 + 7]}, bh[ks], bl[ks]);
                f32x4 acc[4];
#pragma unroll
                for (int mt = 0; mt < 4; ++mt) { acc[mt] = (f32x4){0.f, 0.f, 0.f, 0.f};
#pragma unroll
                    for (int ks = 0; ks < 2; ++ks) { acc[mt] = mfma16(ah[mt][ks], bh[ks], acc[mt]); acc[mt] = mfma16(ah[mt][ks], bl[ks], acc[mt]); acc[mt] = mfma16(al[mt][ks], bh[ks], acc[mt]); } }
                const float dv = fabsf(dec[f0 + i]); float s0 = 0.f;
                if (lag0) {
                    f32x4 a0 = {0.f, 0.f, 0.f, 0.f};
#pragma unroll
                    for (int ks = 0; ks < 2; ++ks) { float w0[8];
#pragma unroll
                        for (int r = 0; r < 8; ++r) w0[r] = *(const float*)((const char*)(w4 + ord * 1024 + c0 + (ks * 32 + r) * 2048) + voffb);
                        bf16x8 b0h, b0l; split8((f32x4){w0[0], w0[1], w0[2], w0[3]}, (f32x4){w0[4], w0[5], w0[6], w0[7]}, b0h, b0l);
                        a0 = mfma16(ah[0][ks], b0h, a0); a0 = mfma16(ah[0][ks], b0l, a0); a0 = mfma16(al[0][ks], b0h, a0); }
                    s0 = a0[0] + kp_I_SKIP[(e * 2 + ord) * 512 + c0 + i]; }
                bf16_t* dst = (nsel ? KRC + ((size_t)(e * 2 + ord) * 512 + c0 + i) * 512 : KRL + ((size_t)(e * 2 + ord) * 512 + c0 + i) * 4096) + x0 + 4 * q;
#pragma unroll
                for (int mt = 0; mt < 4; ++mt) { float val[4];
#pragma unroll
                    for (int r = 0; r < 4; ++r) { const int x = x0 + mt * 16 + 4 * q + r, d = n - x, t = d < 0 ? -d : d;
                        val[r] = acc[mt][r] * __expf(-((float)t * invn) * dv);
                        if (lag0 && mt == 0 && r == 0 && q == 0) val[r] += s0;
                        if (t >= n) val[r] = 0.f; }
                    u32x2 pk; pk.x = pk2(val[0], val[1]); pk.y = pk2(val[2], val[3]); *(u32x2*)(dst + mt * 16) = pk; }
            }
        }
    }
}
DI void phase_init(const Args& a) {
    const float* kp_I_CTX = kin(I_CTX); const float* kp_I_X = kin(I_X);
    bf16_t* XS = (bf16_t*)(a.ws + WS_XS);        bf16_t* AB = (bf16_t*)((unsigned char*)a.out + O_ABUF); const float* MOD = (const float*)(a.ws + WS_MOD);
    const int tid = otid(); const int lane = tid & 63, gw = obid() * NWV + (tid >> 6), NGW = gridDim.x * NWV;
    for (int row = gw; row < T; row += NGW) {
        const float* src = row < TL ? kp_I_X + (size_t)row * 1024 : kp_I_CTX + (size_t)(row - TL) * 1024;
        const int mrow = row < TL ? (row >> 11) : 16; const float* md = MOD + (size_t)mrow * 6144;
#pragma unroll
        for (int j = 0; j < 4; ++j) { const int col = 4 * lane + 256 * j; const f32x4 v = *(const f32x4*)(src + col);
            const f32x4 sh = *(const f32x4*)(md + col), sc = *(const f32x4*)(md + 1024 + col);
            store_bf4(AB + (size_t)row * 1024 + col, v * (sc + 1.f) + sh); }
    }
}

DI void phase_uc(const Args& a, int e, LAS unsigned char* lds) {
    const float* kp_I_HYSB = kin(I_HYSB); const float* kp_I_HYSW = kin(I_HYSW);
    const bf16_t* PH = (const bf16_t*)(a.ws + WS_BIG + B_PH); bf16_t* UC = (bf16_t*)(a.ws + WS_BIG + B_UC);
    LAS float* buf = (LAS float*)lds;
    const float* sw = kp_I_HYSW + (size_t)e * 3 * 1536; const float* sb = kp_I_HYSB + (size_t)e * 1536;
    const int tid = otid();
    u32x4 pv[3];
#define UC_LOAD(tile_) do { const int tt_ = (tile_) / 24, cb_ = (tile_) % 24, tok0_ = tt_ * 128; int s0_, s1_; \
        if (tok0_ < TL) { s0_ = tok0_ & ~(SEQ - 1); s1_ = s0_ + SEQ; } else { s0_ = TL + ((tok0_ - TL) & ~(CTXL - 1)); s1_ = s0_ + CTXL; } \
        _Pragma("unroll") for (int k_ = 0; k_ < 3; ++k_) { const int i_ = tid + k_ * NTH; pv[k_] = (u32x4){0u, 0u, 0u, 0u}; \
            if (i_ < 130 * 8) { const int rr_ = i_ >> 3, c8_ = i_ & 7, tok_ = tok0_ - 1 + rr_; if (tok_ >= s0_ && tok_ < s1_) pv[k_] = *(const u32x4*)(PH + (size_t)tok_ * 1536 + cb_ * 64 + c8_ * 8); } } } while (0)
    int tile = obid();
    if (tile < 288 * 24) UC_LOAD(tile);
    for (; tile < 288 * 24; tile += gridDim.x) {
        const int tt = tile / 24, cb = tile % 24, tok0 = tt * 128;
#pragma unroll
        for (int k = 0; k < 3; ++k) { const int i = tid + k * NTH; if (i < 130 * 8) { const int rr = i >> 3, c8 = i & 7; const u32x4 v = pv[k];
            LAS float* d = buf + rr * 97 + c8 * 8 + 2 * (rr >> 3);
            d[0] = __uint_as_float(v.x << 16); d[1] = __uint_as_float(v.x & 0xffff0000u); d[2] = __uint_as_float(v.y << 16); d[3] = __uint_as_float(v.y & 0xffff0000u);
            d[4] = __uint_as_float(v.z << 16); d[5] = __uint_as_float(v.z & 0xffff0000u); d[6] = __uint_as_float(v.w << 16); d[7] = __uint_as_float(v.w & 0xffff0000u); } }
        __syncthreads();
        if (tile + (int)gridDim.x < 288 * 24) UC_LOAD(tile + (int)gridDim.x);
        for (int i = tid; i < 64 * 16; i += NTH) { const int c = i >> 4, ch = i & 15, cg = cb * 64 + c;
            const float w0 = sw[cg], w1 = sw[1536 + cg], w2 = sw[3072 + cg], bb = sb[cg]; float o[8];
#pragma unroll
            for (int j = 0; j < 8; ++j) { const int t = ch * 8 + j; o[j] = w0 * buf[t * 97 + c + 2 * (ch + (j >> 3))] + w1 * buf[(t + 1) * 97 + c + 2 * (ch + ((j + 1) >> 3))] + w2 * buf[(t + 2) * 97 + c + 2 * (ch + ((j + 2) >> 3))] + bb; }
            u32x4 w; w.x = pk2(o[0], o[1]); w.y = pk2(o[2], o[3]); w.z = pk2(o[4], o[5]); w.w = pk2(o[6], o[7]);
            *(u32x4*)(UC + (size_t)cg * T + tok0 + ch * 8) = w; }
        __syncthreads();
    }
#undef UC_LOAD
}
template <class F> DI void hy_conv_naive(const LAS bf16_t* U, const LAS bf16_t* KR, int n, const F& out) {
    const int tid = otid(); const int nt4 = n >> 2;
    for (int task = tid; task < 16 * nt4; task += NTH) {
        const int b = task / nt4, t0 = (task % nt4) * 4;
        const LAS bf16_t* ub = U + b * n; float y0 = 0.f, y1 = 0.f, y2 = 0.f, y3 = 0.f;
        int base = n - t0;
        float w1 = base - 1 >= 0 ? bf2f(KR[base - 1]) : 0.f, w2 = base - 2 >= 0 ? bf2f(KR[base - 2]) : 0.f, w3 = base - 3 >= 0 ? bf2f(KR[base - 3]) : 0.f;
        for (int s = 0; s < n; ++s) { const float w0 = bf2f(KR[base + s]); const float uv = bf2f(ub[s]);
            y0 += w0 * uv; y1 += w1 * uv; y2 += w2 * uv; y3 += w3 * uv; w3 = w2; w2 = w1; w1 = w0; }
        out(b, t0, y0, y1, y2, y3);
    }
}
struct HyOutZ { LAS bf16_t* Z; const bf16_t* x1; int n; int tokbase; int tstride;
    DI void operator()(int b, int t0, float y0, float y1, float y2, float y3) const { const u32x2 xv = *(const u32x2*)(x1 + tokbase + b * tstride + t0);
        const float a0 = __uint_as_float(xv.x << 16), a1 = __uint_as_float(xv.x & 0xffff0000u), a2 = __uint_as_float(xv.y << 16), a3 = __uint_as_float(xv.y & 0xffff0000u);
        u32x2 w; w.x = pk2(a0 * y0, a1 * y1); w.y = pk2(a2 * y2, a3 * y3); *(LAS u32x2*)(Z + b * n + t0) = w; } };
struct HyOutY { bf16_t* yh; const bf16_t* x2; int tokbase; int tstride;
    DI void operator()(int b, int t0, float y0, float y1, float y2, float y3) const { const u32x2 xv = *(const u32x2*)(x2 + tokbase + b * tstride + t0);
        const float a0 = __uint_as_float(xv.x << 16), a1 = __uint_as_float(xv.x & 0xffff0000u), a2 = __uint_as_float(xv.y << 16), a3 = __uint_as_float(xv.y & 0xffff0000u);
        u32x2 w; w.x = pk2(a0 * y0, a1 * y1); w.y = pk2(a2 * y2, a3 * y3); *(u32x2*)(yh + tokbase + b * tstride + t0) = w; } };
DI void hyena_unit_naive(const Args& a, int e, int c, int nsel, LAS unsigned char* lds) {
    const int n = nsel ? CTXL : SEQ, tokbase = nsel ? TL : 0, tid = otid();
    const bf16_t* UC = (const bf16_t*)(a.ws + WS_BIG + B_UC); bf16_t* YH = (bf16_t*)(a.ws + WS_BIG + B_YH);
    const bf16_t* kr0 = nsel ? (const bf16_t*)(a.ws + WS_KRC) + ((size_t)(e * 2 + 0) * 512 + c) * 512 : (const bf16_t*)(a.ws + WS_KRL) + ((size_t)(e * 2 + 0) * 512 + c) * 4096;
    const bf16_t* kr1 = nsel ? (const bf16_t*)(a.ws + WS_KRC) + ((size_t)(e * 2 + 1) * 512 + c) * 512 : (const bf16_t*)(a.ws + WS_KRL) + ((size_t)(e * 2 + 1) * 512 + c) * 4096;
    LAS bf16_t* U = (LAS bf16_t*)lds; LAS bf16_t* Z = U + 16 * SEQ; LAS bf16_t* KR = Z + 16 * SEQ;
    const bf16_t* vrow = UC + (size_t)c * T + tokbase;
    for (int i = tid; i < 16 * n / 8; i += NTH) { const int el = i * 8; *(LAS u32x4*)(U + el) = *(const u32x4*)(vrow + el); }
    for (int i = tid; i < 2 * n / 8; i += NTH) *(LAS u32x4*)(KR + i * 8) = *(const u32x4*)(kr0 + i * 8);
    __syncthreads();
    { HyOutZ o{Z, UC + (size_t)(512 + c) * T, n, tokbase, n}; hy_conv_naive(U, KR, n, o); }
    __syncthreads();
    for (int i = tid; i < 2 * n / 8; i += NTH) *(LAS u32x4*)(KR + i * 8) = *(const u32x4*)(kr1 + i * 8);
    __syncthreads();
    { HyOutY o{YH + (size_t)c * T, UC + (size_t)(1024 + c) * T, tokbase, n}; hy_conv_naive(Z, KR, n, o); }
    __syncthreads();
}
constexpr int HY_RS = 4112, HY_CS = 8208;
DI void hy_build_kc(const bf16_t* kr, int n, LAS unsigned char* KC, int tid) {
    for (int x8 = tid; x8 < 2 * n / 8; x8 += NTH) {
        const u32x4 lo = *(const u32x4*)(kr + x8 * 8); u32x4 hi = {0u, 0u, 0u, 0u}; if (x8 + 1 < 2 * n / 8) hi = *(const u32x4*)(kr + x8 * 8 + 8);
        const unsigned w[9] = {lo.x, lo.y, lo.z, lo.w, hi.x, hi.y, hi.z, hi.w, 0u};
#pragma unroll
        for (int r = 0; r < 8; ++r) { u32x4 o; const int k = r >> 1;
            if ((r & 1) == 0) { o.x = w[k]; o.y = w[k + 1]; o.z = w[k + 2]; o.w = w[k + 3]; }
            else { o.x = __builtin_amdgcn_alignbit(w[k + 1], w[k], 16); o.y = __builtin_amdgcn_alignbit(w[k + 2], w[k + 1], 16); o.z = __builtin_amdgcn_alignbit(w[k + 3], w[k + 2], 16); o.w = __builtin_amdgcn_alignbit(w[k + 4], w[k + 3], 16); }
            *(LAS u32x4*)(KC + r * HY_CS + x8 * 16) = o; }
    }
}
template <int NTW> DI void hy_conv_mfma(const LAS unsigned char* Ub, const LAS unsigned char* KC, int wave, int lane, f32x4 (&acc)[NTW]) {
    constexpr int n = NTW * 128;
    const int i = lane & 15, q = lane >> 4, r = (8 - (i & 7)) & 7, t0w = wave * NTW * 16;
    const LAS unsigned char* ap = KC + r * HY_CS + 2 * (8 * q - t0w - 16 * (NTW - 1) - i + n - r);
    const LAS unsigned char* bp = Ub + i * HY_RS + 16 * q;
#pragma unroll
    for (int k = 0; k < NTW; ++k) acc[k] = (f32x4){0.f, 0.f, 0.f, 0.f};
    if constexpr (NTW == 16) {
        bf16x8 R[16];
#pragma unroll
        for (int k = 0; k < 16; ++k) R[k] = *(const LAS bf16x8*)(ap + 32 * (15 - k));
        for (int s8 = 0; s8 < n / 32; s8 += 8) {
#pragma unroll
            for (int ss = 0; ss < 8; ++ss) { const int s = s8 + ss;
                const bf16x8 bf = *(const LAS bf16x8*)(bp + 64 * s);
                bf16x8 n0, n1; const bool more = (s + 1 < n / 32);
                if (more) { n0 = *(const LAS bf16x8*)(ap + 64 * (s + 1) + 32 * 15); n1 = *(const LAS bf16x8*)(ap + 64 * (s + 1) + 32 * 14); }
#pragma unroll
                for (int k = 0; k < 16; ++k) acc[k] = mfma16(R[(k - 2 * ss) & 15], bf, acc[k]);
                if (more) { R[(0 - 2 * (ss + 1)) & 15] = n0; R[(1 - 2 * (ss + 1)) & 15] = n1; } }
        }
    } else {
#pragma unroll 2
        for (int s0c = 0; s0c < n / 32; ++s0c) {
            const bf16x8 bf = *(const LAS bf16x8*)(bp + 64 * s0c);
#pragma unroll
            for (int k = 0; k < NTW; ++k) { const bf16x8 af = *(const LAS bf16x8*)(ap + 64 * s0c + 32 * (NTW - 1 - k)); acc[k] = mfma16(af, bf, acc[k]); }
        }
    }
}
template <int NTW> DI void hyena_unit_fast(const Args& a, int e, int c, LAS unsigned char* lds) {
    constexpr int n = NTW * 128; constexpr int nsel = (n == CTXL) ? 1 : 0; constexpr int tokbase = nsel ? TL : 0;
    const int tid = otid(), wave = tid >> 6, lane = tid & 63, b = lane & 15, q = lane >> 4;
    const bf16_t* UC = (const bf16_t*)(a.ws + WS_BIG + B_UC); bf16_t* YH = (bf16_t*)(a.ws + WS_BIG + B_YH);
    const bf16_t* kr0 = nsel ? (const bf16_t*)(a.ws + WS_KRC) + ((size_t)(e * 2 + 0) * 512 + c) * 512 : (const bf16_t*)(a.ws + WS_KRL) + ((size_t)(e * 2 + 0) * 512 + c) * 4096;
    const bf16_t* kr1 = nsel ? (const bf16_t*)(a.ws + WS_KRC) + ((size_t)(e * 2 + 1) * 512 + c) * 512 : (const bf16_t*)(a.ws + WS_KRL) + ((size_t)(e * 2 + 1) * 512 + c) * 4096;
    LAS unsigned char* Ub = lds; LAS unsigned char* KC = lds + 16 * HY_RS;
    const bf16_t* vrow = UC + (size_t)c * T + tokbase; const bf16_t* x1row = UC + (size_t)(512 + c) * T + tokbase; const bf16_t* x2row = UC + (size_t)(1024 + c) * T + tokbase;
    bf16_t* yrow = YH + (size_t)c * T + tokbase;
    for (int idx = tid; idx < 16 * n / 8; idx += NTH) { const int bb = idx / (n / 8), ch = idx % (n / 8); *(LAS u32x4*)(Ub + bb * HY_RS + ch * 16) = *(const u32x4*)(vrow + bb * n + ch * 8); }
    hy_build_kc(kr0, n, KC, tid);
    __syncthreads();
    f32x4 acc[NTW]; u32x2 zp[NTW];
    hy_conv_mfma<NTW>(Ub, KC, wave, lane, acc);
#pragma unroll
    for (int k = 0; k < NTW; ++k) { const int t = wave * NTW * 16 + 16 * k + 4 * q; const u32x2 xv = *(const u32x2*)(x1row + b * n + t);
        zp[k].x = pk2(__uint_as_float(xv.x << 16) * acc[k][0], __uint_as_float(xv.x & 0xffff0000u) * acc[k][1]); zp[k].y = pk2(__uint_as_float(xv.y << 16) * acc[k][2], __uint_as_float(xv.y & 0xffff0000u) * acc[k][3]); }
    __syncthreads();
#pragma unroll
    for (int k = 0; k < NTW; ++k) { const int t = wave * NTW * 16 + 16 * k + 4 * q; *(LAS u32x2*)(Ub + b * HY_RS + t * 2) = zp[k]; }
    hy_build_kc(kr1, n, KC, tid);
    __syncthreads();
    hy_conv_mfma<NTW>(Ub, KC, wave, lane, acc);
#pragma unroll
    for (int k = 0; k < NTW; ++k) { const int t = wave * NTW * 16 + 16 * k + 4 * q; const u32x2 xv = *(const u32x2*)(x2row + b * n + t);
        zp[k].x = pk2(__uint_as_float(xv.x << 16) * acc[k][0], __uint_as_float(xv.x & 0xffff0000u) * acc[k][1]); zp[k].y = pk2(__uint_as_float(xv.y << 16) * acc[k][2], __uint_as_float(xv.y & 0xffff0000u) * acc[k][3]); }
    __syncthreads();
#pragma unroll
    for (int k = 0; k < NTW; ++k) { const int t = wave * NTW * 16 + 16 * k + 4 * q; *(LAS u32x2*)(Ub + b * HY_RS + t * 2) = zp[k]; }
    __syncthreads();
    for (int idx = tid; idx < 16 * n / 8; idx += NTH) { const int bb = idx / (n / 8), ch = idx % (n / 8); *(u32x4*)(yrow + bb * n + ch * 8) = *(const LAS u32x4*)(Ub + bb * HY_RS + ch * 16); }
    __syncthreads();
}
DI void attn_unit_naive(const Args& a, int l, int isctx, int b, int h, int qb, LAS unsigned char* lds) {
    const float* kp_I_LK1 = kin(I_LK1); const float* kp_I_LK2 = kin(I_LK2); const float* kp_I_LQ1 = kin(I_LQ1); const float* kp_I_LQ2 = kin(I_LQ2); const float* kp_I_SUBG = kin(I_SUBG);
    const bf16_t* QB = (const bf16_t*)(a.ws + WS_BIG + B_QB); const bf16_t* KB = (const bf16_t*)(a.ws + WS_BIG + B_KB); const bf16_t* VB = (const bf16_t*)(a.ws + WS_BIG + B_VB);
    bf16_t* MIXA = (bf16_t*)(a.ws + WS_BIG + B_MIXA_E);
    LAS bf16_t* Ks = (LAS bf16_t*)lds; LAS bf16_t* Vs = Ks + 64 * 128; LAS float* ex = (LAS float*)(lds + 32768); LAS float* ssq = ex + 64 * 128;
    const int tid = otid(), r = tid & 63, s = (tid >> 6) & 1, qt = tid >> 7, e = l >> 1;
    const int qrow = isctx ? TL + b * CTXL + qb * 64 + r : b * SEQ + qb * 64 + r;
    float q[64], o[32];
    { const bf16_t* qp = QB + (size_t)qrow * 512 + h * 128 + s * 64;
#pragma unroll
      for (int d8 = 0; d8 < 8; ++d8) { const u32x4 v = *(const u32x4*)(qp + d8 * 8);
          q[d8 * 8 + 0] = __uint_as_float(v.x << 16); q[d8 * 8 + 1] = __uint_as_float(v.x & 0xffff0000u); q[d8 * 8 + 2] = __uint_as_float(v.y << 16); q[d8 * 8 + 3] = __uint_as_float(v.y & 0xffff0000u);
          q[d8 * 8 + 4] = __uint_as_float(v.z << 16); q[d8 * 8 + 5] = __uint_as_float(v.z & 0xffff0000u); q[d8 * 8 + 6] = __uint_as_float(v.w << 16); q[d8 * 8 + 7] = __uint_as_float(v.w & 0xffff0000u); } }
#pragma unroll
    for (int i = 0; i < 32; ++i) o[i] = 0.f;
    float m = -INFINITY, lsum = 0.f;
    const int ntiles = isctx ? 4 : 36;
    for (int kt = 0; kt < ntiles; ++kt) {
        const int krow0 = (kt < 4) ? TL + b * CTXL + kt * 64 : b * SEQ + (kt - 4) * 64;
        __syncthreads();
        for (int i = tid; i < 1024; i += NTH) { const int key = i >> 4, ch = i & 15;
            *(LAS u32x4*)(Ks + key * 128 + ch * 8) = *(const u32x4*)(KB + (size_t)(krow0 + key) * 512 + h * 128 + ch * 8);
            *(LAS u32x4*)(Vs + key * 128 + ch * 8) = *(const u32x4*)(VB + (size_t)(krow0 + key) * 512 + h * 128 + ch * 8); }
        __syncthreads();
        for (int kg = 0; kg < 64; kg += 4) {
            float sc[4];
#pragma unroll
            for (int kk = 0; kk < 4; ++kk) { const LAS bf16_t* kp = Ks + (kg + kk) * 128 + s * 64; float acc = 0.f;
#pragma unroll
                for (int d8 = 0; d8 < 8; ++d8) { const u32x4 v = *(const LAS u32x4*)(kp + d8 * 8);
                    acc += q[d8 * 8 + 0] * __uint_as_float(v.x << 16) + q[d8 * 8 + 1] * __uint_as_float(v.x & 0xffff0000u) + q[d8 * 8 + 2] * __uint_as_float(v.y << 16) + q[d8 * 8 + 3] * __uint_as_float(v.y & 0xffff0000u)
                         + q[d8 * 8 + 4] * __uint_as_float(v.z << 16) + q[d8 * 8 + 5] * __uint_as_float(v.z & 0xffff0000u) + q[d8 * 8 + 6] * __uint_as_float(v.w << 16) + q[d8 * 8 + 7] * __uint_as_float(v.w & 0xffff0000u); }
                sc[kk] = acc; }
            const float mx = fmaxf(fmaxf(sc[0], sc[1]), fmaxf(sc[2], sc[3]));
            const float mn = fmaxf(m, mx); const float corr = exp2f(m - mn); m = mn; lsum *= corr;
#pragma unroll
            for (int i = 0; i < 32; ++i) o[i] *= corr;
#pragma unroll
            for (int kk = 0; kk < 4; ++kk) { const float p = exp2f(sc[kk] - mn); lsum += p; const LAS bf16_t* vp = Vs + (kg + kk) * 128 + qt * 32;
#pragma unroll
                for (int d8 = 0; d8 < 4; ++d8) { const u32x4 v = *(const LAS u32x4*)(vp + d8 * 8);
                    o[d8 * 8 + 0] += p * __uint_as_float(v.x << 16); o[d8 * 8 + 1] += p * __uint_as_float(v.x & 0xffff0000u); o[d8 * 8 + 2] += p * __uint_as_float(v.y << 16); o[d8 * 8 + 3] += p * __uint_as_float(v.y & 0xffff0000u);
                    o[d8 * 8 + 4] += p * __uint_as_float(v.z << 16); o[d8 * 8 + 5] += p * __uint_as_float(v.z & 0xffff0000u); o[d8 * 8 + 6] += p * __uint_as_float(v.w << 16); o[d8 * 8 + 7] += p * __uint_as_float(v.w & 0xffff0000u); } }
        }
    }
    const float inv = 1.f / lsum;
    float d1 = 0.f, d2 = 0.f;
    for (int i = 0; i < 64; ++i) { d1 += kp_I_LQ1[e * 64 + i] * kp_I_LK1[e * 64 + i]; d2 += kp_I_LQ2[e * 64 + i] * kp_I_LK2[e * 64 + i]; }
    const float lam_init = 0.8f - 0.6f * expf(-0.3f * (float)l);
    const float lam = expf(d1) - expf(d2) + lam_init;
    __syncthreads();
    if (s == 1) {
#pragma unroll
        for (int i = 0; i < 32; ++i) ex[r * 128 + qt * 32 + i] = o[i] * inv; }
    __syncthreads();
    if (s == 0) { float ss = 0.f;
#pragma unroll
        for (int i = 0; i < 32; ++i) { o[i] = o[i] * inv - lam * ex[r * 128 + qt * 32 + i]; ss += o[i] * o[i]; }
        ssq[r * 4 + qt] = ss; }
    __syncthreads();
    if (s == 0) { const float tot = (ssq[r * 4] + ssq[r * 4 + 1]) + (ssq[r * 4 + 2] + ssq[r * 4 + 3]); const float rs = rsqrtf(tot * (1.f / 128.f) + LN_EPS) * (1.f - lam_init);
        const float* g = kp_I_SUBG + e * 128 + qt * 32; bf16_t* dst = MIXA + (size_t)qrow * 1024 + 512 + h * 128 + qt * 32;
#pragma unroll
        for (int i = 0; i < 32; i += 4) { f32x4 v = {o[i] * rs * g[i], o[i + 1] * rs * g[i + 1], o[i + 2] * rs * g[i + 2], o[i + 3] * rs * g[i + 3]}; store_bf4(dst + i, v); } }
    __syncthreads();
}
typedef float f32x16 __attribute__((ext_vector_type(16)));
typedef short s16x4 __attribute__((ext_vector_type(4)));
constexpr int AT_KS = 272, AT_VS = 288, AT_KB = 64 * AT_KS, AT_VB = 64 * AT_VS;
constexpr int AT_EX = 2 * AT_KB + 2 * AT_VB;
DI f32x16 mfma32(bf16x8 a, bf16x8 b, f32x16 c) { return __builtin_amdgcn_mfma_f32_32x32x16_bf16(a, b, c, 0, 0, 0); }
DI s16x4 tr_read(const LAS unsigned char* p) { return __builtin_bit_cast(s16x4, __builtin_amdgcn_ds_read_tr16_b64_v4i16((LAS s16x4*)p)); }
DI void attn_unit_fast(const Args& a, int l, int isctx, int b, int hd, int qb, LAS unsigned char* lds) {
    const float* kp_I_LK1 = kin(I_LK1); const float* kp_I_LK2 = kin(I_LK2); const float* kp_I_LQ1 = kin(I_LQ1); const float* kp_I_LQ2 = kin(I_LQ2); const float* kp_I_SUBG = kin(I_SUBG);
    const bf16_t* QB = (const bf16_t*)(a.ws + WS_BIG + B_QB); const bf16_t* KB = (const bf16_t*)(a.ws + WS_BIG + B_KB); const bf16_t* VB = (const bf16_t*)(a.ws + WS_BIG + B_VB);
    bf16_t* MIXA = (bf16_t*)(a.ws + WS_BIG + B_MIXA_E);
    const int tid = otid(), wave = tid >> 6, lane = tid & 63, s = wave >> 2, r32 = lane & 31, hi = lane >> 5, e = l >> 1;
    const int qrow0 = isctx ? TL + b * CTXL + qb * 128 : b * SEQ + qb * 128;
    const int qrow = qrow0 + 32 * (wave & 3) + r32;
    bf16x8 qf[4];
#pragma unroll
    for (int d0 = 0; d0 < 4; ++d0) qf[d0] = *(const bf16x8*)(QB + (size_t)qrow * 512 + hd * 128 + s * 64 + 16 * d0 + 8 * hi);
    f32x16 O[4];
#pragma unroll
    for (int eb = 0; eb < 4; ++eb)
#pragma unroll
        for (int r = 0; r < 16; ++r) O[eb][r] = 0.f;
    float m = -INFINITY, lsum = 0.f;
    const int ntiles = isctx ? 4 : 36;
    u32x4 preK[2], preV[2];
    const int ck = tid >> 4, cc = tid & 15;
#define AT_ROW0(kt_) (((kt_) < 4) ? TL + b * CTXL + (kt_) * 64 : b * SEQ + ((kt_) - 4) * 64)
#define AT_LOADK(kt_) do { const int kr0_ = AT_ROW0(kt_); preK[0] = *(const u32x4*)(KB + (size_t)(kr0_ + ck) * 512 + hd * 128 + cc * 8); preK[1] = *(const u32x4*)(KB + (size_t)(kr0_ + ck + 32) * 512 + hd * 128 + cc * 8); } while (0)
#define AT_LOADV(kt_) do { const int kr0_ = AT_ROW0(kt_); preV[0] = *(const u32x4*)(VB + (size_t)(kr0_ + ck) * 512 + hd * 128 + cc * 8); preV[1] = *(const u32x4*)(VB + (size_t)(kr0_ + ck + 32) * 512 + hd * 128 + cc * 8); } while (0)
#define AT_STOREK(buf_) do { *(LAS u32x4*)(lds + (buf_) * AT_KB + ck * AT_KS + cc * 16) = preK[0]; *(LAS u32x4*)(lds + (buf_) * AT_KB + (ck + 32) * AT_KS + cc * 16) = preK[1]; } while (0)
#define AT_STOREV(buf_) do { *(LAS u32x4*)(lds + 2 * AT_KB + (buf_) * AT_VB + ck * AT_VS + cc * 16) = preV[0]; *(LAS u32x4*)(lds + 2 * AT_KB + (buf_) * AT_VB + (ck + 32) * AT_VS + cc * 16) = preV[1]; } while (0)
#define AT_QK(P0_, P1_, buf_) do { const LAS unsigned char* Kt_ = lds + (buf_) * AT_KB + koff; \
        _Pragma("unroll") for (int r = 0; r < 16; ++r) { P0_[r] = 0.f; P1_[r] = 0.f; } \
        bf16x8 kf_[8]; _Pragma("unroll") for (int d0 = 0; d0 < 4; ++d0) { kf_[2 * d0] = *(const LAS bf16x8*)(Kt_ + d0 * 32); kf_[2 * d0 + 1] = *(const LAS bf16x8*)(Kt_ + 32 * AT_KS + d0 * 32); } \
        __builtin_amdgcn_sched_barrier(0); \
        _Pragma("unroll") for (int d0 = 0; d0 < 4; ++d0) { P0_ = mfma32(kf_[2 * d0], qf[d0], P0_); P1_ = mfma32(kf_[2 * d0 + 1], qf[d0], P1_); } } while (0)
    const int i16 = lane & 15, qq = i16 >> 2, p4 = i16 & 3, blk16 = (lane >> 4) & 1;
    const int koff = r32 * AT_KS + s * 128 + hi * 16;
    const int voff = (4 * hi + qq) * AT_VS + (16 * blk16 + 4 * p4) * 2;
    AT_LOADK(0); AT_LOADV(0); AT_STOREK(0); AT_STOREV(0);
    AT_LOADK(1); AT_STOREK(1);
    __syncthreads();
    f32x16 P0, P1, N0, N1;
    AT_QK(P0, P1, 0);
    for (int kt = 0; kt < ntiles; ++kt) {
        const int buf = kt & 1;
        if (kt + 2 < ntiles) AT_LOADK(kt + 2);
        if (kt + 1 < ntiles) { AT_LOADV(kt + 1); AT_QK(N0, N1, buf ^ 1); }
        const LAS unsigned char* Vt = lds + 2 * AT_KB + buf * AT_VB + voff;
        float mx = fmaxf(P0[0], P1[0]);
#pragma unroll
        for (int r = 1; r < 16; ++r) mx = fmaxf(mx, fmaxf(P0[r], P1[r]));
        mx = xor32_max(mx);
        if (__any(mx > m + 6.f)) { const float mn = fmaxf(m, mx); const float corr = __builtin_amdgcn_exp2f(m - mn); m = mn; lsum *= corr;
#pragma unroll
            for (int eb = 0; eb < 4; ++eb) O[eb] = O[eb] * corr; }
        float ps = 0.f;
#pragma unroll
        for (int r = 0; r < 16; ++r) { P0[r] = __builtin_amdgcn_exp2f(P0[r] - m); P1[r] = __builtin_amdgcn_exp2f(P1[r] - m); ps += P0[r] + P1[r]; }
        lsum += ps;
        bf16x8 pa[4];
#pragma unroll
        for (int s2 = 0; s2 < 2; ++s2) { u32x4 w0, w1;
            w0.x = pk2(P0[8 * s2 + 0], P0[8 * s2 + 1]); w0.y = pk2(P0[8 * s2 + 2], P0[8 * s2 + 3]); w0.z = pk2(P0[8 * s2 + 4], P0[8 * s2 + 5]); w0.w = pk2(P0[8 * s2 + 6], P0[8 * s2 + 7]);
            w1.x = pk2(P1[8 * s2 + 0], P1[8 * s2 + 1]); w1.y = pk2(P1[8 * s2 + 2], P1[8 * s2 + 3]); w1.z = pk2(P1[8 * s2 + 4], P1[8 * s2 + 5]); w1.w = pk2(P1[8 * s2 + 6], P1[8 * s2 + 7]);
            pa[s2] = __builtin_bit_cast(bf16x8, w0); pa[2 + s2] = __builtin_bit_cast(bf16x8, w1); }
        { s16x4 vl[2][4], vh[2][4];
#pragma unroll
          for (int ks = 0; ks < 4; ++ks) { vl[0][ks] = tr_read(Vt + ks * 16 * AT_VS); vh[0][ks] = tr_read(Vt + ks * 16 * AT_VS + 8 * AT_VS); }
#pragma unroll
          for (int eb = 0; eb < 4; ++eb) {
              if (eb < 3) {
#pragma unroll
                  for (int ks = 0; ks < 4; ++ks) { vl[(eb + 1) & 1][ks] = tr_read(Vt + ks * 16 * AT_VS + (eb + 1) * 64); vh[(eb + 1) & 1][ks] = tr_read(Vt + ks * 16 * AT_VS + (eb + 1) * 64 + 8 * AT_VS); } }
              __builtin_amdgcn_sched_barrier(0);
#pragma unroll
              for (int ks = 0; ks < 4; ++ks) { const bf16x8 vf = __builtin_shufflevector(vl[eb & 1][ks], vh[eb & 1][ks], 0, 1, 2, 3, 4, 5, 6, 7); O[eb] = mfma32(vf, pa[ks], O[eb]); }
              __builtin_amdgcn_sched_barrier(0); } }
        if (kt + 2 < ntiles) AT_STOREK(buf);
        if (kt + 1 < ntiles) AT_STOREV(buf ^ 1);
        __syncthreads();
        P0 = N0; P1 = N1;
    }
#undef AT_ROW0
#undef AT_LOADK
#undef AT_LOADV
#undef AT_STOREK
#undef AT_STOREV
#undef AT_QK
    const float ltot = xor32_sum(lsum); const float inv = 1.f / ltot;
    float d1 = 0.f, d2 = 0.f;
    for (int i = 0; i < 64; ++i) { d1 += kp_I_LQ1[e * 64 + i] * kp_I_LK1[e * 64 + i]; d2 += kp_I_LQ2[e * 64 + i] * kp_I_LK2[e * 64 + i]; }
    const float lam_init = 0.8f - 0.6f * expf(-0.3f * (float)l);
    const float lam = expf(d1) - expf(d2) + lam_init;
    LAS float* ex = (LAS float*)(lds + AT_EX); const int lrow = 32 * (wave & 3) + r32;
    if (s == 1) {
#pragma unroll
        for (int eb = 0; eb < 4; ++eb)
#pragma unroll
            for (int r = 0; r < 16; ++r) ex[lrow * 129 + eb * 32 + (r & 3) + 8 * (r >> 2) + 4 * hi] = O[eb][r] * inv; }
    __syncthreads();
    if (s == 0) { float ss = 0.f;
#pragma unroll
        for (int eb = 0; eb < 4; ++eb)
#pragma unroll
            for (int r = 0; r < 16; ++r) { const float dv = O[eb][r] * inv - lam * ex[lrow * 129 + eb * 32 + (r & 3) + 8 * (r >> 2) + 4 * hi]; O[eb][r] = dv; ss += dv * dv; }
        ss = xor32_sum(ss);
        const float rs = rsqrtf(ss * (1.f / 128.f) + LN_EPS) * (1.f - lam_init); const float* g = kp_I_SUBG + e * 128;
        LAS bf16_t* st = (LAS bf16_t*)lds;
#pragma unroll
        for (int eb = 0; eb < 4; ++eb)
#pragma unroll
            for (int r4 = 0; r4 < 4; ++r4) { const int e0 = eb * 32 + 8 * r4 + 4 * hi; u32x2 w;
                w.x = pk2(O[eb][4 * r4] * rs * g[e0], O[eb][4 * r4 + 1] * rs * g[e0 + 1]); w.y = pk2(O[eb][4 * r4 + 2] * rs * g[e0 + 2], O[eb][4 * r4 + 3] * rs * g[e0 + 3]);
                *(LAS u32x2*)(st + lrow * 136 + e0) = w; } }
    __syncthreads();
    { const LAS bf16_t* st = (const LAS bf16_t*)lds;
      for (int i = tid; i < 128 * 16; i += NTH) { const int row = i >> 4, ch = i & 15; *(u32x4*)(MIXA + (size_t)(qrow0 + row) * 1024 + 512 + hd * 128 + ch * 8) = *(const LAS u32x4*)(st + row * 136 + ch * 8); } }
    __syncthreads();
}
DI void phase_yh_t(const Args& a, LAS unsigned char* lds, int vbx, int vG) {
    const bf16_t* YH = (const bf16_t*)(a.ws + WS_BIG + B_YH); bf16_t* MIXA = (bf16_t*)(a.ws + WS_BIG + B_MIXA_E);
    LAS bf16_t* buf = (LAS bf16_t*)lds;
    const int tid = otid();
    u32x4 pv[2];
#define YT_LOAD(tile_) do { const int tt_ = (tile_) >> 3, cb_ = (tile_) & 7; _Pragma("unroll") for (int k_ = 0; k_ < 2; ++k_) { const int i_ = tid + k_ * NTH, c_ = i_ >> 4, ch_ = i_ & 15; \
        pv[k_] = *(const u32x4*)(YH + (size_t)(cb_ * 64 + c_) * T + tt_ * 128 + ch_ * 8); } } while (0)
    int tile = vbx;
    if (tile < 288 * 8) YT_LOAD(tile);
    for (; tile < 288 * 8; tile += vG) {
        const int tt = tile >> 3, cb = tile & 7, tok0 = tt * 128;
#pragma unroll
        for (int k = 0; k < 2; ++k) { const int i = tid + k * NTH, c = i >> 4, ch = i & 15; *(LAS u32x4*)(buf + c * 136 + ch * 8) = pv[k]; }
        __syncthreads();
        if (tile + vG < 288 * 8) YT_LOAD(tile + vG);
        for (int i = tid; i < 128 * 8; i += NTH) { const int tk = i >> 3, c8 = i & 7; unsigned short v[8];
#pragma unroll
            for (int j = 0; j < 8; ++j) v[j] = buf[(c8 * 8 + j) * 136 + tk];
            u32x4 w; w.x = v[0] | ((unsigned)v[1] << 16); w.y = v[2] | ((unsigned)v[3] << 16); w.z = v[4] | ((unsigned)v[5] << 16); w.w = v[6] | ((unsigned)v[7] << 16);
            *(u32x4*)(MIXA + (size_t)(tok0 + tk) * 1024 + cb * 64 + c8 * 8) = w; }
        __syncthreads();
    }
#undef YT_LOAD
}

DI void phase_rgconv(const Args& a, int o) {
    const float* kp_I_RGCB = kin(I_RGCB); const float* kp_I_RGCW = kin(I_RGCW);
    const bf16_t* REC = (const bf16_t*)(a.ws + WS_BIG + B_REC); bf16_t* U = (bf16_t*)(a.ws + WS_BIG + B_U);
    const float* cw = kp_I_RGCW + (size_t)o * 4 * 1024; const float* cb = kp_I_RGCB + (size_t)o * 1024;
    for (int task = obid() * NTH + otid(); task < 1024 * 128; task += gridDim.x * NTH) {
        const int rb = task >> 7, c8 = (task & 127) * 8, r0 = rb * 36;
        float w[4][8], bias[8];
#pragma unroll
        for (int k = 0; k < 4; ++k) { const f32x4 wa = *(const f32x4*)(cw + k * 1024 + c8), wb = *(const f32x4*)(cw + k * 1024 + c8 + 4);
            w[k][0] = wa[0]; w[k][1] = wa[1]; w[k][2] = wa[2]; w[k][3] = wa[3]; w[k][4] = wb[0]; w[k][5] = wb[1]; w[k][6] = wb[2]; w[k][7] = wb[3]; }
        { const f32x4 ba = *(const f32x4*)(cb + c8), bb = *(const f32x4*)(cb + c8 + 4); bias[0] = ba[0]; bias[1] = ba[1]; bias[2] = ba[2]; bias[3] = ba[3]; bias[4] = bb[0]; bias[5] = bb[1]; bias[6] = bb[2]; bias[7] = bb[3]; }
#define RG_LD(rr_) (*(const u32x4*)(REC + (size_t)((rr_) < 0 ? 0 : ((rr_) > T - 1 ? T - 1 : (rr_))) * 1024 + c8))
#define RG_TAP(k_, v_, rr_) do { if ((rr_) >= s0 && (rr_) < s1) { const u32x4 t_ = (v_); \
            acc[0] += w[k_][0] * __uint_as_float(t_.x << 16); acc[1] += w[k_][1] * __uint_as_float(t_.x & 0xffff0000u); acc[2] += w[k_][2] * __uint_as_float(t_.y << 16); acc[3] += w[k_][3] * __uint_as_float(t_.y & 0xffff0000u); \
            acc[4] += w[k_][4] * __uint_as_float(t_.z << 16); acc[5] += w[k_][5] * __uint_as_float(t_.z & 0xffff0000u); acc[6] += w[k_][6] * __uint_as_float(t_.w << 16); acc[7] += w[k_][7] * __uint_as_float(t_.w & 0xffff0000u); } } while (0)
        u32x4 p0 = RG_LD(r0 - 2), p1 = RG_LD(r0 - 1), p2 = RG_LD(r0);
#pragma unroll 1
        for (int b = 0; b < 3; ++b) { u32x4 nv[12];
#pragma unroll
            for (int j = 0; j < 12; ++j) nv[j] = RG_LD(r0 + b * 12 + j + 1);
#pragma unroll
            for (int j = 0; j < 12; ++j) { const int row = r0 + b * 12 + j;
                int s0, s1; if (row < TL) { s0 = row & ~(SEQ - 1); s1 = s0 + SEQ; } else { s0 = TL + ((row - TL) & ~(CTXL - 1)); s1 = s0 + CTXL; }
                float acc[8];
#pragma unroll
                for (int jj = 0; jj < 8; ++jj) acc[jj] = bias[jj];
                RG_TAP(0, p0, row - 2); RG_TAP(1, p1, row - 1); RG_TAP(2, p2, row); RG_TAP(3, nv[j], row + 1);
                u32x4 ov; ov.x = pk2(acc[0], acc[1]); ov.y = pk2(acc[2], acc[3]); ov.z = pk2(acc[4], acc[5]); ov.w = pk2(acc[6], acc[7]);
                *(u32x4*)(U + (size_t)row * 1024 + c8) = ov;
                p0 = p1; p1 = p2; p2 = nv[j]; }
        }
#undef RG_LD
#undef RG_TAP
    }
}
DI int scan_chunk_of(int dir, int jj) { return dir == 0 ? jj : (jj < 8 ? 7 - jj : 79 - jj); }
DI int chunk_row0(int b, int chunk) { return chunk < 8 ? TL + b * CTXL + chunk * 32 : b * SEQ + (chunk - 8) * 32; }
DI void phase_scan1(const Args& a) {
    const bf16_t* LA = (const bf16_t*)(a.ws + WS_BIG + B_LA); const bf16_t* BB = (const bf16_t*)(a.ws + WS_BIG + B_BB);
    float* CT = (float*)((unsigned char*)a.out + O_CT);
    for (int idx = obid() * NTH + otid(); idx < 2 * 16 * 72 * 512; idx += gridDim.x * NTH) {
        const int ch = (idx & 511) * 2, g = idx >> 9, chunk = g % 72, b = (g / 72) & 15, dir = g / (72 * 16);
        const int row0 = chunk_row0(b, chunk); const bf16_t* la = LA + ((size_t)dir * T + row0) * 1024 + ch; const bf16_t* bb = BB + ((size_t)dir * T + row0) * 1024 + ch;
        float P0 = 1.f, Q0 = 0.f, P1 = 1.f, Q1 = 0.f;
        for (int i0 = 0; i0 < 32; i0 += 16) { unsigned lv[16], bv[16];
#pragma unroll
            for (int i = 0; i < 16; ++i) { const int ii = dir ? 31 - (i0 + i) : i0 + i; lv[i] = *(const unsigned*)(la + (size_t)ii * 1024); bv[i] = *(const unsigned*)(bb + (size_t)ii * 1024); }
#pragma unroll
            for (int i = 0; i < 16; ++i) { const float a0 = __expf(__uint_as_float(lv[i] << 16)), a1 = __expf(__uint_as_float(lv[i] & 0xffff0000u));
                P0 *= a0; Q0 = a0 * Q0 + __builtin_amdgcn_sqrtf(1.f - a0 * a0) * __uint_as_float(bv[i] << 16); P1 *= a1; Q1 = a1 * Q1 + __builtin_amdgcn_sqrtf(1.f - a1 * a1) * __uint_as_float(bv[i] & 0xffff0000u); } }
        const size_t o = (size_t)g * 1024 + ch; *(f32x4*)(CT + o * 2) = (f32x4){P0, Q0, P1, Q1};
    }
}
DI void phase_scan2(const Args& a) {
    const float* CT = (const float*)((unsigned char*)a.out + O_CT); float* CARRY = (float*)((unsigned char*)a.out + O_CARRY);
    for (int idx = obid() * NTH + otid(); idx < 2 * 16 * 1024; idx += gridDim.x * NTH) {
        const int ch = idx & 1023, b = (idx >> 10) & 15, dir = idx >> 14; float h = 0.f;
        float pq[72];
#pragma unroll 1
        for (int hh = 0; hh < 2; ++hh) {
#pragma unroll
            for (int j = 0; j < 36; ++j) { const int chunk = scan_chunk_of(dir, hh * 36 + j); const size_t o = (((size_t)dir * 16 + b) * 72 + chunk) * 1024 + ch; pq[2 * j] = CT[o * 2]; pq[2 * j + 1] = CT[o * 2 + 1]; }
#pragma unroll
            for (int j = 0; j < 36; ++j) { const int chunk = scan_chunk_of(dir, hh * 36 + j); const size_t o = (((size_t)dir * 16 + b) * 72 + chunk) * 1024 + ch; CARRY[o] = h; h = pq[2 * j] * h + pq[2 * j + 1]; } }
    }
}
DI void phase_scan3(const Args& a) {
    const bf16_t* LA = (const bf16_t*)(a.ws + WS_BIG + B_LA); const bf16_t* BB = (const bf16_t*)(a.ws + WS_BIG + B_BB); const bf16_t* GATE = (const bf16_t*)(a.ws + WS_BIG + B_GATE);
    bf16_t* MIXA = (bf16_t*)(a.ws + WS_BIG + B_MIXA_O); const float* CARRY = (const float*)((unsigned char*)a.out + O_CARRY);
    for (int idx = obid() * NTH + otid(); idx < 16 * 72 * 512; idx += gridDim.x * NTH) {
        const int ch = (idx & 511) * 2, g = idx >> 9, chunk = g % 72, b = g / 72; const int row0 = chunk_row0(b, chunk);
        unsigned hfp[32];
        float hf0[32];
        { const bf16_t* la = LA + ((size_t)row0) * 1024 + ch; const bf16_t* bb = BB + ((size_t)row0) * 1024 + ch;
          const float* cp = CARRY + (((size_t)0 * 16 + b) * 72 + chunk) * 1024 + ch; float h0 = cp[0], h1 = cp[1];
#pragma unroll
          for (int i0 = 0; i0 < 32; i0 += 16) { unsigned lv[16], bv[16];
#pragma unroll
              for (int i = 0; i < 16; ++i) { lv[i] = *(const unsigned*)(la + (size_t)(i0 + i) * 1024); bv[i] = *(const unsigned*)(bb + (size_t)(i0 + i) * 1024); }
#pragma unroll
              for (int i = 0; i < 16; ++i) { const float a0 = __expf(__uint_as_float(lv[i] << 16)), a1 = __expf(__uint_as_float(lv[i] & 0xffff0000u));
                  h0 = a0 * h0 + __builtin_amdgcn_sqrtf(1.f - a0 * a0) * __uint_as_float(bv[i] << 16); h1 = a1 * h1 + __builtin_amdgcn_sqrtf(1.f - a1 * a1) * __uint_as_float(bv[i] & 0xffff0000u);
                  hf0[i0 + i] = h0; hfp[i0 + i] = __float_as_uint(h1); } } }
        { const bf16_t* la = LA + ((size_t)T + row0) * 1024 + ch; const bf16_t* bb = BB + ((size_t)T + row0) * 1024 + ch;
          const float* cp = CARRY + (((size_t)1 * 16 + b) * 72 + chunk) * 1024 + ch; float h0 = cp[0], h1 = cp[1];
          const bf16_t* gp = GATE + (size_t)row0 * 1024 + ch; bf16_t* mo = MIXA + (size_t)row0 * 1024 + ch;
#pragma unroll
          for (int i0 = 16; i0 >= 0; i0 -= 16) { unsigned lv[16], bv[16], gv[16];
#pragma unroll
              for (int i = 0; i < 16; ++i) { lv[i] = *(const unsigned*)(la + (size_t)(i0 + i) * 1024); bv[i] = *(const unsigned*)(bb + (size_t)(i0 + i) * 1024); gv[i] = *(const unsigned*)(gp + (size_t)(i0 + i) * 1024); }
#pragma unroll
              for (int i = 15; i >= 0; --i) { const float a0 = __expf(__uint_as_float(lv[i] << 16)), a1 = __expf(__uint_as_float(lv[i] & 0xffff0000u));
                  h0 = a0 * h0 + __builtin_amdgcn_sqrtf(1.f - a0 * a0) * __uint_as_float(bv[i] << 16); h1 = a1 * h1 + __builtin_amdgcn_sqrtf(1.f - a1 * a1) * __uint_as_float(bv[i] & 0xffff0000u);
                  *(unsigned*)(mo + (size_t)(i0 + i) * 1024) = pk2(__uint_as_float(gv[i] << 16) * (hf0[i0 + i] + h0), __uint_as_float(gv[i] & 0xffff0000u) * (__uint_as_float(hfp[i0 + i]) + h1)); } } }
    }
}

DI int route_row(float logit, int lane, float bias, float* wout) {
    const float score = 1.f / (1.f + expf(-logit)); const float sel = score + bias;
    float m1 = sel; m1 = fmaxf(m1, xor_lane<1>(m1)); m1 = fmaxf(m1, xor_lane<2>(m1)); m1 = fmaxf(m1, xor_lane<4>(m1));
    const unsigned long long eq = __ballot(sel == m1); const int g = lane >> 3; const unsigned gm = (unsigned)(eq >> (g * 8)) & 0xffu; const int first = __ffs(gm) - 1;
    float m2 = ((lane & 7) == first) ? -INFINITY : sel; m2 = fmaxf(m2, xor_lane<1>(m2)); m2 = fmaxf(m2, xor_lane<2>(m2)); m2 = fmaxf(m2, xor_lane<4>(m2));
    const float gs = m1 + m2; int grank = 0;
#pragma unroll
    for (int gg = 0; gg < 8; ++gg) { const float o = lane_bcast(gs, gg * 8); grank += ((o > gs) || (o == gs && gg < g)) ? 1 : 0; }
    const float msel = grank < 4 ? sel : -INFINITY; int rank = 0;
    unsigned ub = __float_as_uint(msel); ub = (ub & 0x80000000u) ? ~ub : (ub | 0x80000000u);
    const unsigned long long key = ((unsigned long long)ub << 6) | (unsigned)(63 - lane);
    const unsigned klo = (unsigned)key, khi = (unsigned)(key >> 32);
#pragma unroll
    for (int e2 = 0; e2 < 64; ++e2) { const unsigned long long ok = ((unsigned long long)(unsigned)__builtin_amdgcn_readlane((int)khi, e2) << 32) | (unsigned)__builtin_amdgcn_readlane((int)klo, e2); rank += (ok > key) ? 1 : 0; }
    const bool chosen = rank < 8; const float wsum = wave_sum(chosen ? score : 0.f);
    *wout = score / wsum * 2.5f;
    return chosen ? rank : -1;
}
constexpr int RW_ROWB = 528;
DI void phase_router(const Args& a, int l, int Mrows, const bf16_t* MB, LAS unsigned char* lds) {
    const float* kp_I_ROUTB = kin(I_ROUTB);
    bf16_t* XS = (bf16_t*)(a.ws + WS_XS); const float* MOD = (const float*)(a.ws + WS_MOD) + (size_t)l * 17 * 6144;
    const bf16_t* RWT = (const bf16_t*)(a.ws + WS_ROPE + 131072);
    int* cnt = (int*)(a.ws + WS_CTL) + CW_CNT + l * 64 * 32; int2* LIST = (int2*)((unsigned char*)a.out + O_LIST); bf16_t* TM = (bf16_t*)((unsigned char*)a.out + O_ABUF);
    const float* ln1g = kin(I_LN1G) + l * 1024; const float* ln1b = kin(I_LN1B) + l * 1024; const float* xin_l = kin(I_X); const float* xin_c = kin(I_CTX);
    const int tid = otid(); const int wave = tid >> 6, lane = tid & 63, i = lane & 15, q = lane >> 4;
    const float rb = kp_I_ROUTB[l * 64 + lane];
    const int R = Mrows >> 8, RW8 = R >> 3, NG = R >> 4;
    LAS float* lg = (LAS float*)lds;
    LAS unsigned char* rwb = lds + 40960;
    LAS int* lcnt = (LAS int*)(lds + 38912); LAS int* wgbase = lcnt + 64;
    LAS unsigned char* sb = lds + 39424;
    LAS float* part8 = (LAS float*)(lds + 110592);
    for (int tile = obid(); tile < 256; tile += gridDim.x) {
        const int rbase = tile * R, r0 = rbase + wave * RW8;
        u32x4 st[8];
#define RW_LOAD(c_) do { _Pragma("unroll") for (int j_ = 0; j_ < 8; ++j_) st[j_] = *(const u32x4*)((const char*)RWT + (rwoff + (unsigned)(j_ * 32768 + (c_) * 512))); } while (0)
#define RW_STORE() do { _Pragma("unroll") for (int j_ = 0; j_ < 8; ++j_) *(LAS u32x4*)(rwb + rwl + j_ * 16 * RW_ROWB) = st[j_]; } while (0)
        { f32x4 lg_[4], lb_[4];
#pragma unroll
          for (int j = 0; j < 4; ++j) { const int col = 4 * lane + 256 * j; lg_[j] = *(const f32x4*)(ln1g + col); lb_[j] = *(const f32x4*)(ln1b + col); }
#define LN_LOAD(row_, XQ, MQ) do { const int rw_ = (row_); const bf16_t* xr_ = XS + (size_t)rw_ * 1024; const bf16_t* mr_ = MB + (size_t)rw_ * 1024; \
              const float* xi_ = rw_ < TL ? xin_l + (size_t)rw_ * 1024 : xin_c + (size_t)(rw_ - TL) * 1024;          \
              _Pragma("unroll") for (int j = 0; j < 4; ++j) { const int col = 4 * lane + 256 * j; \
                  if (l == 0) XQ[j] = *(const f32x4*)(xi_ + col); else { const u32x2 xv = *(const u32x2*)(xr_ + col); XQ[j] = (f32x4){__uint_as_float(xv.x << 16), __uint_as_float(xv.x & 0xffff0000u), __uint_as_float(xv.y << 16), __uint_as_float(xv.y & 0xffff0000u)}; } \
                  MQ[j] = *(const u32x2*)(mr_ + col); } } while (0)
          f32x4 xa[4], xb[4]; u32x2 ma[4], mb[4];
          LN_LOAD(r0, xa, ma);
#pragma unroll 1
          for (int rr = 0; rr < RW8; ++rr) { const int row = r0 + rr; bf16_t* xrow = XS + (size_t)row * 1024; f32x4 v[4]; float s = 0.f;
              if (rr + 1 < RW8) LN_LOAD(row + 1, xb, mb);
              const float* md = MOD + (size_t)(row < TL ? (row >> 11) : 16) * 6144;
#pragma unroll
              for (int j = 0; j < 4; ++j) { const int col = 4 * lane + 256 * j; const f32x4 gvj = *(const f32x4*)(md + 2048 + col);
                  const f32x4 mf = {__uint_as_float(ma[j].x << 16), __uint_as_float(ma[j].x & 0xffff0000u), __uint_as_float(ma[j].y << 16), __uint_as_float(ma[j].y & 0xffff0000u)};
                  v[j] = xa[j] * DN_ALPHA + gvj * mf; s += (v[j][0] + v[j][1]) + (v[j][2] + v[j][3]); }
              const float mean = wave_sum(s) * (1.f / 1024.f); float s2 = 0.f;
#pragma unroll
              for (int j = 0; j < 4; ++j) { v[j] = v[j] - mean; s2 += (v[j][0] * v[j][0] + v[j][1] * v[j][1]) + (v[j][2] * v[j][2] + v[j][3] * v[j][3]); }
              const float rstd = rsqrtf(wave_sum(s2) * (1.f / 1024.f) + LN_EPS);
#pragma unroll
              for (int j = 0; j < 4; ++j) { const int col = 4 * lane + 256 * j; const f32x4 y = v[j] * rstd * lg_[j] + lb_[j];
                  store_bf4(xrow + col, y); const f32x4 shf = *(const f32x4*)(md + 3072 + col), scf = *(const f32x4*)(md + 4096 + col);
                  store_bf4(TM + (size_t)row * 1024 + col, y * (scf + 1.f) + shf); }
#pragma unroll
              for (int j = 0; j < 4; ++j) { xa[j] = xb[j]; ma[j] = mb[j]; } } }
#undef LN_LOAD
        unsigned rwoff = ((tid >> 5) * 1024 + (tid & 31) * 8) * 2, rwl = (tid >> 5) * RW_ROWB + (tid & 31) * 16; asm volatile("" : "+v"(rwoff), "+v"(rwl));
        RW_LOAD(0);
        asm volatile("s_waitcnt vmcnt(0)" ::: "memory");
        RW_STORE();
        if (tid < 64) lcnt[tid] = 0;
        __syncthreads();
        f32x4 acc[2][4];
#pragma unroll
        for (int gi = 0; gi < 2; ++gi)
#pragma unroll
            for (int eb = 0; eb < 4; ++eb) acc[gi][eb] = (f32x4){0.f, 0.f, 0.f, 0.f};
        const int wvu = __builtin_amdgcn_readfirstlane(wave);
        const bool g8 = (NG == 9) && (wvu < 4);
        const bf16_t* ta0 = TM + (size_t)(rbase + wave * 16 + i) * 1024 + 8 * q; const bf16_t* ta8 = TM + (size_t)(rbase + 128 + i) * 1024 + 8 * q + wvu * 256;
        constexpr int PD = 2;
        u32x4 xq[PD], a8[4];
#pragma unroll
        for (int ss = 0; ss < PD; ++ss) xq[ss] = __builtin_nontemporal_load((const u32x4*)(ta0 + 32 * ss));
#pragma unroll
        for (int s = 0; s < 4; ++s) a8[s] = g8 ? __builtin_nontemporal_load((const u32x4*)(ta8 + 32 * s)) : xq[0];
#pragma unroll
        for (int c = 0; c < 4; ++c) {
            if (c + 1 < 4) RW_LOAD(c + 1);
#pragma unroll
            for (int s = 0; s < 8; ++s) { const int ss = c * 8 + s;
                bf16x8 bh[4], bl[4];
#pragma unroll
                for (int eb = 0; eb < 4; ++eb) { bh[eb] = *(const LAS bf16x8*)(rwb + (eb * 16 + i) * RW_ROWB + (32 * s + 8 * q) * 2); bl[eb] = *(const LAS bf16x8*)(rwb + (64 + eb * 16 + i) * RW_ROWB + (32 * s + 8 * q) * 2); }
                const bf16x8 a0_ = __builtin_bit_cast(bf16x8, xq[s % PD]), a1_ = __builtin_bit_cast(bf16x8, a8[s & 3]);
                if (ss + PD < 32) xq[s % PD] = __builtin_nontemporal_load((const u32x4*)(ta0 + 32 * (ss + PD)));
                if (s < 4 && g8 && wvu == c) a8[s] = __builtin_nontemporal_load((const u32x4*)(ta8 + 32 * (s + 4)));
#pragma unroll
                for (int eb = 0; eb < 4; ++eb) { acc[0][eb] = mfma16(a0_, bh[eb], acc[0][eb]); acc[0][eb] = mfma16(a0_, bl[eb], acc[0][eb]); }
                if (g8 && wvu == c) {
#pragma unroll
                    for (int eb = 0; eb < 4; ++eb) { acc[1][eb] = mfma16(a1_, bh[eb], acc[1][eb]); acc[1][eb] = mfma16(a1_, bl[eb], acc[1][eb]); } }
            }
            if (c + 1 < 4) { LDS_WAIT(); __builtin_amdgcn_s_barrier();
                asm volatile("s_waitcnt vmcnt(0)" ::: "memory"); RW_STORE(); LDS_WAIT(); __builtin_amdgcn_s_barrier(); }
        }
#undef RW_LOAD
#undef RW_STORE
#pragma unroll
        for (int eb = 0; eb < 4; ++eb)
#pragma unroll
            for (int r = 0; r < 4; ++r) lg[(wave * 16 + 4 * q + r) * 65 + eb * 16 + i] = acc[0][eb][r];
        if (g8) {
#pragma unroll
            for (int eb = 0; eb < 4; ++eb)
#pragma unroll
                for (int r = 0; r < 4; ++r) part8[(wvu * 16 + 4 * q + r) * 64 + eb * 16 + i] = acc[1][eb][r]; }
        __syncthreads();
        if (NG == 9 && wvu == 2) {
#pragma unroll 1
            for (int idx = lane; idx < 1024; idx += 64) lg[(128 + (idx >> 6)) * 65 + (idx & 63)] = (part8[idx] + part8[1024 + idx]) + (part8[2048 + idx] + part8[3072 + idx]); }
        const int rl = wave * 64 + lane; const bool rok = rl < R;
        int pe[8], pp[8]; float pw[8];
        if (rok) {
            const LAS float* lrow = lg + rl * 65; float sel[64];
#pragma unroll
            for (int e = 0; e < 64; ++e) sel[e] = sigmoidf_(lrow[e]) + lane_bcast(rb, e);
            float gs[8];
#pragma unroll
            for (int g = 0; g < 8; ++g) { float m1 = sel[g * 8], m2 = -INFINITY;
#pragma unroll
                for (int j = 1; j < 8; ++j) { m2 = fmaxf(m2, fminf(m1, sel[g * 8 + j])); m1 = fmaxf(m1, sel[g * 8 + j]); }
                gs[g] = m1 + m2; }
#pragma unroll
            for (int g = 0; g < 8; ++g) { int grank = 0;
#pragma unroll
                for (int g2 = 0; g2 < 8; ++g2) { if (g2 == g) continue; grank += ((gs[g2] > gs[g]) || (gs[g2] == gs[g] && g2 < g)) ? 1 : 0; }
#pragma unroll
                for (int j = 0; j < 8; ++j) sel[g * 8 + j] = grank < 4 ? sel[g * 8 + j] : -INFINITY; }
#pragma unroll 1
            for (int k = 0; k < 8; ++k) { float best = sel[0]; int bi = 0;
#pragma unroll
                for (int e = 1; e < 64; ++e) { const bool c = sel[e] > best; best = c ? sel[e] : best; bi = c ? e : bi; }
#pragma unroll
                for (int e = 0; e < 64; ++e) sel[e] = (bi == e) ? -INFINITY : sel[e];
                sb[rl * 8 + k] = (unsigned char)bi; }
            float wsum = 0.f;
#pragma unroll
            for (int k = 0; k < 8; ++k) { pe[k] = sb[rl * 8 + k]; pw[k] = sigmoidf_(lrow[pe[k]]); wsum += pw[k]; pp[k] = __hip_atomic_fetch_add(lcnt + pe[k], 1, __ATOMIC_RELAXED, __HIP_MEMORY_SCOPE_WORKGROUP); }
            const float wn = __builtin_amdgcn_rcpf(wsum) * 2.5f;
#pragma unroll
            for (int k = 0; k < 8; ++k) pw[k] *= wn;
        }
        __syncthreads();
        if (wave == 0) wgbase[lane] = atomicAdd(&cnt[lane * 32], lcnt[lane]);
        __syncthreads();
        if (rok) {
#pragma unroll
            for (int k = 0; k < 8; ++k) LIST[(size_t)pe[k] * T + wgbase[pe[k]] + pp[k]] = make_int2((rbase + rl) * 8 + k, __float_as_int(pw[k])); }
        __syncthreads();
    }
}
DI void build_toff(const Args& a, int l, int Mrows, volatile LAS int* toff) {
    const int* cnt = (const int*)(a.ws + WS_CTL) + CW_CNT + l * 64 * 32;
    __syncthreads();
    if (otid() == 0) { int acc = 0;
#pragma unroll 1
        for (int e = 0; e < 64; ++e) { toff[e] = acc; acc += (cnt[e * 32] + 255) >> 8; }
        toff[64] = acc; acc += Mrows >> 8; toff[65] = acc; }
    __syncthreads();
    volatile LAS unsigned char* rt2e = (volatile LAS unsigned char*)(toff + 128); volatile LAS unsigned short* rtnv = (volatile LAS unsigned short*)(toff + 128 + 352);
    for (int rt = otid(); rt < toff[65]; rt += NTH) { int e = 0;
#pragma unroll 1
        while (e < 64 && toff[e + 1] <= rt) ++e;
        rt2e[rt] = (unsigned char)e;
        int nv = 256; if (e < 64) { const int rem = cnt[e * 32] - (rt - toff[e]) * 256; nv = rem < 256 ? rem : 256; } rtnv[rt] = (unsigned short)nv; }
    __syncthreads();
}
DI void phase_ln2(const Args& a, int l, int Mrows) {
    const float* kp_I_LN2B = kin(I_LN2B); const float* kp_I_LN2G = kin(I_LN2G);
    bf16_t* XS = (bf16_t*)(a.ws + WS_XS); const bf16_t* Y = (const bf16_t*)(a.ws + WS_BIG); bf16_t* AB = (bf16_t*)((unsigned char*)a.out + O_ABUF);
    const bf16_t* SHB = (l == DEPTH - 1) ? (const bf16_t*)(a.ws + WS_WGU) : (const bf16_t*)AB;
    const float* MOD = (const float*)(a.ws + WS_MOD) + (size_t)l * 17 * 6144; const float* MODN = MOD + 17 * 6144;
    const float* g = kp_I_LN2G + l * 1024; const float* bta = kp_I_LN2B + l * 1024;
    const int tid = otid(); const int lane = tid & 63, gw = obid() * NWV + (tid >> 6), NGW = gridDim.x * NWV;
    for (int row0 = gw * 2; row0 < Mrows; row0 += NGW * 2) {
        f32x4 v[2][4]; float s[2] = {0.f, 0.f};
#pragma unroll
        for (int h = 0; h < 2; ++h) { const int row = row0 + h; const bf16_t* xr = XS + (size_t)row * 1024; const int mrow = row < TL ? (row >> 11) : 16; const float* md = MOD + (size_t)mrow * 6144;
#pragma unroll
            for (int j = 0; j < 4; ++j) { const int col = 4 * lane + 256 * j; f32x4 ys = {0.f, 0.f, 0.f, 0.f};
#pragma unroll
                for (int k = 0; k < 8; ++k) { const u32x2 yv = *(const u32x2*)(Y + ((size_t)row * 8 + k) * 1024 + col);
                    ys[0] += __uint_as_float(yv.x << 16); ys[1] += __uint_as_float(yv.x & 0xffff0000u); ys[2] += __uint_as_float(yv.y << 16); ys[3] += __uint_as_float(yv.y & 0xffff0000u); }
                { const u32x2 sv = *(const u32x2*)(SHB + (size_t)row * 1024 + col);
                  ys[0] += __uint_as_float(sv.x << 16); ys[1] += __uint_as_float(sv.x & 0xffff0000u); ys[2] += __uint_as_float(sv.y << 16); ys[3] += __uint_as_float(sv.y & 0xffff0000u); }
                { const u32x2 xv = *(const u32x2*)(xr + col); const f32x4 x = {__uint_as_float(xv.x << 16), __uint_as_float(xv.x & 0xffff0000u), __uint_as_float(xv.y << 16), __uint_as_float(xv.y & 0xffff0000u)};
                  v[h][j] = x * DN_ALPHA + *(const f32x4*)(md + 5120 + col) * ys; } s[h] += (v[h][j][0] + v[h][j][1]) + (v[h][j][2] + v[h][j][3]); } }
        asm volatile("" ::: "memory");
#pragma unroll
        for (int h = 0; h < 2; ++h) { const int row = row0 + h; bf16_t* xr = XS + (size_t)row * 1024; const int mrow = row < TL ? (row >> 11) : 16;
            const float mean = wave_sum(s[h]) * (1.f / 1024.f); float s2 = 0.f;
#pragma unroll
            for (int j = 0; j < 4; ++j) { v[h][j] = v[h][j] - mean; s2 += (v[h][j][0] * v[h][j][0] + v[h][j][1] * v[h][j][1]) + (v[h][j][2] * v[h][j][2] + v[h][j][3] * v[h][j][3]); }
            const float rstd = rsqrtf(wave_sum(s2) * (1.f / 1024.f) + LN_EPS);
            if (l == DEPTH - 1) {
#pragma unroll
                for (int j = 0; j < 4; ++j) { const int col = 4 * lane + 256 * j; *(f32x4*)(a.out + (size_t)row * 1024 + col) = v[h][j] * rstd * *(const f32x4*)(g + col) + *(const f32x4*)(bta + col); }
            } else { const float* mdn = MODN + (size_t)mrow * 6144;
#pragma unroll
                for (int j = 0; j < 4; ++j) { const int col = 4 * lane + 256 * j; const f32x4 y = v[h][j] * rstd * *(const f32x4*)(g + col) + *(const f32x4*)(bta + col);
                    store_bf4(xr + col, y); const f32x4 sh = *(const f32x4*)(mdn + col), sc = *(const f32x4*)(mdn + 1024 + col);
                    store_bf4(AB + (size_t)row * 1024 + col, y * (sc + 1.f) + sh); } } }
    }
}

#ifndef FASTMASK
#define FASTMASK 0xff
#endif
constexpr bool F_ABIN = FASTMASK & 1, F_RGIN = FASTMASK & 2, F_OUT = FASTMASK & 4, F_GATES = FASTMASK & 8, F_GU = FASTMASK & 16, F_DN = FASTMASK & 32, F_HY = FASTMASK & 64, F_AT = FASTMASK & 128;
__global__ void __launch_bounds__(NTH, 2) mega(Args a0) {
    extern __shared__ __attribute__((aligned(16))) unsigned char lds_raw[];
    LAS unsigned char* lds = (LAS unsigned char*)lds_raw;
    const int tid = threadIdx.x;
    volatile LAS unsigned* MISC = (volatile LAS unsigned*)(lds + LDS_MISC);
    volatile LAS int* toff = (volatile LAS int*)(lds + LDS_TOFF);
    if (tid < 64) MISC[tid] = 0u;
    if (tid < 46) { LAS unsigned long long* tb = (LAS unsigned long long*)(lds + LDS_PTRS); tb[tid] = ((const __attribute__((address_space(4))) unsigned long long*)__builtin_amdgcn_kernarg_segment_ptr())[tid]; }
    __syncthreads();
    XcdBarrier bar = xcd_barrier_post((unsigned*)(a0.ws + WS_CTL) + CW_BAR, MISC);
    const int G = gridDim.x, bx = blockIdx.x; const bool EARLY_T = F_AT && F_HY && (G == 256);
#define GRID_BAR() xcd_barrier(bar)
#ifndef TMASK
#define TMASK 0u
#endif
#ifndef TMULT
#define TMULT 10ull
#endif
    unsigned long long tacc = 0ull;
#define PH_ENV() const int bx = obid(); unsigned long long wsi_ = (unsigned long long)uni_ptr(a0.ws), oui_ = (unsigned long long)uni_ptr(a0.out); asm volatile("" : "+s"(wsi_), "+s"(oui_)); unsigned char* ws = (unsigned char*)(GAS unsigned char*)wsi_; float* outp_ = (float*)(GAS float*)oui_; const Args& a = a0; unsigned char* ob = (unsigned char*)outp_; \
    const float* MOD = (const float*)(ws + WS_MOD); bf16_t* ABUF = (bf16_t*)(ob + O_ABUF); const int2* LIST = (const int2*)(ob + O_LIST); (void)MOD; (void)ABUF; (void)LIST
#define PH(id, ...) do { unsigned long long t0_ = 0ull; if ((TMASK >> (id)) & 1u) t0_ = __builtin_amdgcn_s_memrealtime(); { PH_ENV(); __VA_ARGS__; } GRID_BAR(); if ((TMASK >> (id)) & 1u) tacc += __builtin_amdgcn_s_memrealtime() - t0_; } while (0)
#define PHN(id, ...) do { unsigned long long t0_ = 0ull; if ((TMASK >> (id)) & 1u) t0_ = __builtin_amdgcn_s_memrealtime(); __VA_ARGS__; if ((TMASK >> (id)) & 1u) tacc += __builtin_amdgcn_s_memrealtime() - t0_; } while (0)
    PH(0, phase_mod(a, lds); phase_hdn(a); phase_rope(a); phase_weights(a, 0, lds));
    PH(1, phase_kr(a); phase_init(a));

    for (int l = 0; l < DEPTH; ++l) {
        const int Mrows = (l == DEPTH - 1) ? TL : T;
        if ((l & 1) == 0) {
            const int e = l >> 1;
            PH(3, { SchedDense S{ABUF, (const bf16_t*)(ws + WS_WIN), 1024, 1024, T / 256, 12, G, bx};
              EpiAbIn E{(bf16_t*)(ws + WS_BIG + B_PH), (bf16_t*)(ws + WS_BIG + B_QB), (bf16_t*)(ws + WS_BIG + B_KB), (bf16_t*)(ws + WS_BIG + B_VB), (const float*)(ws + WS_ROPE)};
              gemm_units<F_ABIN>(lds, S, E, 1024, 1024); });
            PH(4, phase_uc(a, e, lds));
            PH(5, PHN(19, { if constexpr (F_HY) { for (int c = bx; c < 1024; c += G) { if (c < 512) hyena_unit_fast<16>(a, e, c, lds); else hyena_unit_fast<2>(a, e, c - 512, lds); } }
                          else { for (int c = bx; c < 1024; c += G) hyena_unit_naive(a, e, c & 511, c >> 9, lds); } });
                  if (EARLY_T) hy_signal((unsigned*)(ws + WS_CTL) + CW_HYC + e * 32);
                  PHN(20, { if constexpr (F_AT) { for (int u = bx; u < 1024 + 128; u += G) { if (u < 1024) attn_unit_fast(a, l, 0, u >> 6, (u >> 4) & 3, u & 15, lds); else { const int v = u - 1024; attn_unit_fast(a, l, 1, v >> 3, (v >> 1) & 3, v & 1, lds); } } }
                          else { for (int u = bx; u < 2048 + 256; u += G) { if (u < 2048) attn_unit_naive(a, l, 0, u >> 7, (u >> 5) & 3, u & 31, lds); else { const int v = u - 2048; attn_unit_naive(a, l, 1, v >> 4, (v >> 2) & 3, v & 3, lds); } } } });
                  if (EARLY_T && bx >= 128) { hy_wait((unsigned*)(ws + WS_CTL) + CW_HYC + e * 32, 256u, bar.bar); phase_yh_t(a, lds, bx - 128, 128); });
            if (!EARLY_T) PH(6, phase_yh_t(a, lds, bx, G));
            PH(7, { SchedDense S{(const bf16_t*)(ws + WS_BIG + B_MIXA_E), (const bf16_t*)(ws + WS_WOUT), 1024, 1024, Mrows / 256, 4, G, bx}; EpiM E{(bf16_t*)(ws + WS_BIG + B_M_E)}; gemm_units<F_OUT>(lds, S, E, 1024, 1024); });
        } else {
            const int o = l >> 1;
            PH(8, { SchedDense S{ABUF, (const bf16_t*)(ws + WS_WIN), 1024, 1024, T / 256, 8, G, bx}; EpiRgIn E{(bf16_t*)(ws + WS_BIG + B_GATE), (bf16_t*)(ws + WS_BIG + B_REC)}; gemm_units<F_RGIN>(lds, S, E, 1024, 1024); });
            PH(9, phase_rgconv(a, o));
            PH(10, { SchedGates S{(const bf16_t*)(ws + WS_BIG + B_U), (const bf16_t*)(ws + WS_WG), T / 256, G, bx};
              EpiGates E{(const bf16_t*)(ws + WS_BIG + B_U), (bf16_t*)(ws + WS_BIG + B_LA), (bf16_t*)(ws + WS_BIG + B_BB), kin(I_RGBA) + o * 2048, kin(I_RGBX) + o * 2048, (const float*)(ws + WS_ROPE + 65536) + o * 2048};
              gemm_units<F_GATES>(lds, S, E, 128, 128); });
            PH(11, phase_scan1(a));
            PH(12, phase_scan2(a));
            PH(13, phase_scan3(a));
            PH(7, { SchedDense S{(const bf16_t*)(ws + WS_BIG + B_MIXA_O), (const bf16_t*)(ws + WS_WOUT), 1024, 1024, Mrows / 256, 4, G, bx}; EpiM E{(bf16_t*)(ws + WS_BIG + B_M_O)}; gemm_units<F_OUT>(lds, S, E, 1024, 1024); });
        }
        PH(15, phase_router(a, l, Mrows, (const bf16_t*)(ws + WS_BIG + ((l & 1) ? B_M_O : B_M_E)), lds));
        build_toff(a0, l, Mrows, toff);
        PH(16, { const int* cnt = (const int*)(ws + WS_CTL) + CW_CNT + l * 64 * 32; SchedMoeT<true> S{ABUF, (const bf16_t*)(ws + WS_WGU), cnt, LIST, toff, (volatile LAS unsigned char*)(toff + 128), toff[65], 2, G, bx, (size_t)512 * 1024}; EpiGU E{(bf16_t*)(ws + WS_HS)}; gemm_units<F_GU>(lds, S, E, 1024, 1024); });
        PH(17, { const int* cnt = (const int*)(ws + WS_CTL) + CW_CNT + l * 64 * 32; { SchedMoeT<false> S{(const bf16_t*)(ws + WS_HS), (const bf16_t*)(ws + WS_WD), cnt, LIST, toff, (volatile LAS unsigned char*)(toff + 128), toff[64], 4, G, bx, (size_t)1024 * 256};
          EpiDn E{(bf16_t*)(ws + WS_BIG), LIST}; gemm_units<F_DN>(lds, S, E, 256, 256); }
          { SchedDense S{(const bf16_t*)(ws + WS_HS) + (size_t)toff[64] * 256 * 256, (const bf16_t*)(ws + WS_WD) + (size_t)64 * 1024 * 256, 256, 256, Mrows / 256, 4, G, (G == 256) ? ((bx + 128) & 255) : bx}; EpiM E{(l == DEPTH - 1) ? (bf16_t*)(ws + WS_WGU) : ABUF}; gemm_units<F_DN>(lds, S, E, 256, 256); } });
        PH(18, phase_ln2(a, l, Mrows); if (l + 1 < DEPTH) phase_weights(a, l + 1, lds));
    }
    if (TMASK != 0u) { if (bx == 0 && tid == 0) { const unsigned long long t1 = __builtin_amdgcn_s_memrealtime(); while (__builtin_amdgcn_s_memrealtime() - t1 < TMULT * tacc) __builtin_amdgcn_s_sleep(8); } }
}

extern "C" void kernel_launch(void* const* d_in, const int* in_sizes, int n_in, void* d_out, int out_size, void* d_ws, size_t ws_size, hipStream_t stream) {
    static int grid = 0;
    if (grid == 0) {
        int dev = 0, cus = 0;
        if (hipGetDevice(&dev) != hipSuccess || hipDeviceGetAttribute(&cus, hipDeviceAttributeMultiprocessorCount, dev) != hipSuccess) { grid = -1; return; }
        if (hipFuncSetAttribute((const void*)mega, hipFuncAttributeMaxDynamicSharedMemorySize, LDS_BYTES) != hipSuccess) { grid = -1; return; }
        int per_cu = 0; (void)hipOccupancyMaxActiveBlocksPerMultiprocessor(&per_cu, (const void*)mega, NTH, LDS_BYTES); (void)hipGetLastError();
        grid = cus;
        if (per_cu < 1) grid = cus;
    }
    if (grid < 0) return;
    (void)hipMemsetAsync((char*)d_ws + WS_CTL, 0, CTL_BYTES, stream);
    Args a{};
    for (int i = 0; i < 46; ++i) a.in[i] = (const float*)d_in[i];
    a.out = (float*)d_out; a.ws = (unsigned char*)d_ws;
    hipLaunchKernelGGL(mega, dim3(grid), dim3(NTH), LDS_BYTES, stream, a);
}
```

```cpp
#include <hip/hip_runtime.h>
#include <stdint.h>
#include <math.h>

#define GAS __attribute__((address_space(1)))
#define LAS __attribute__((address_space(3)))
#define DI __device__ __forceinline__
typedef unsigned short bf16_t;
typedef short bf16x8 __attribute__((ext_vector_type(8)));
typedef float f32x4 __attribute__((ext_vector_type(4)));
typedef unsigned u32x4 __attribute__((ext_vector_type(4)));
typedef unsigned u32x2 __attribute__((ext_vector_type(2)));

constexpr int D = 1024, NB = 16, SEQ = 2048, CTXL = 256, DEPTH = 4;
constexpr int TL = NB * SEQ, TC = NB * CTXL, T = TL + TC;
constexpr float LN_EPS = 1e-5f;
constexpr float DN_ALPHA = 1.6817928305074290861f;
constexpr float C2 = 0.125f * 1.4426950408889634f;
constexpr int NTH = 512, NWV = 8;

constexpr size_t MiB = 1u << 20;
constexpr size_t WS_CTL = 0, CTL_BYTES = 1 * MiB;
constexpr size_t WS_MOD = 1 * MiB;
constexpr size_t WS_HDN = 3 * MiB;
constexpr size_t WS_ROPE = 5 * MiB;
constexpr size_t WS_KRL = 6 * MiB;
constexpr size_t WS_KRC = 22 * MiB;
constexpr size_t WS_WIN = 24 * MiB;
constexpr size_t WS_WOUT = 30 * MiB;
constexpr size_t WS_WG = 32 * MiB;
constexpr size_t WS_WGU = 36 * MiB;
constexpr size_t WS_WD = 101 * MiB;
constexpr size_t WS_XS = 134 * MiB;
constexpr size_t WS_HS = 278 * MiB;
constexpr size_t WS_BIG = 448 * MiB;
constexpr size_t B_PH = 0, B_QB = 108 * MiB, B_KB = 144 * MiB, B_VB = 180 * MiB, B_UC = 216 * MiB, B_YH = 324 * MiB, B_MIXA_E = 360 * MiB, B_M_E = 432 * MiB;
constexpr size_t B_GATE = 0, B_REC = 72 * MiB, B_U = 144 * MiB, B_LA = 216 * MiB, B_BB = 360 * MiB, B_MIXA_O = 504 * MiB, B_M_O = 0;
constexpr size_t O_ABUF = 0, O_LIST = 72 * MiB, O_CT = 92 * MiB, O_CARRY = 112 * MiB;
constexpr int CW_BAR = 4096, CW_CNT = 8192, CW_HYC = 16384;

constexpr int LDS_SCR = 143360;
constexpr int LDS_MISC = LDS_SCR;
constexpr int LDS_TOFF = LDS_SCR + 256;
constexpr int LDS_PTRS = LDS_SCR + 5120;
constexpr int LDS_BYTES = 151552;

DI float bf2f(bf16_t b) { return __uint_as_float(((unsigned)b) << 16); }
DI unsigned f2bf(float f) { unsigned u = __float_as_uint(f); return (u + 0x7fffu + ((u >> 16) & 1u)) >> 16; }
typedef float f32x2_t __attribute__((ext_vector_type(2))); typedef __bf16 bf16x2_t __attribute__((ext_vector_type(2)));
DI unsigned pk2(float lo, float hi) { const f32x2_t v = {lo, hi}; const bf16x2_t b = __builtin_convertvector(v, bf16x2_t); return __builtin_bit_cast(unsigned, b); }
DI void store_bf8(bf16_t* p, f32x4 v0, f32x4 v1) { u32x4 w; w.x = pk2(v0[0], v0[1]); w.y = pk2(v0[2], v0[3]); w.z = pk2(v1[0], v1[1]); w.w = pk2(v1[2], v1[3]); *(u32x4*)p = w; }
DI void store_bf4(bf16_t* p, f32x4 v) { u32x2 w; w.x = pk2(v[0], v[1]); w.y = pk2(v[2], v[3]); *(u32x2*)p = w; }
template <int X> DI float xor_lane(float v) {
    if constexpr (X == 32) { const auto rr = __builtin_amdgcn_permlane32_swap(__float_as_uint(v), __float_as_uint(v), false, false); return __uint_as_float(rr[0] == __float_as_uint(v) ? rr[1] : rr[0]); }
    else return __uint_as_float((unsigned)__builtin_amdgcn_ds_swizzle((int)__float_as_uint(v), 0x1f | (X << 10)));
}
DI float xor32_sum(float v) { const auto rr = __builtin_amdgcn_permlane32_swap(__float_as_uint(v), __float_as_uint(v), false, false); return __uint_as_float(rr[0]) + __uint_as_float(rr[1]); }
DI float xor32_max(float v) { const auto rr = __builtin_amdgcn_permlane32_swap(__float_as_uint(v), __float_as_uint(v), false, false); return fmaxf(__uint_as_float(rr[0]), __uint_as_float(rr[1])); }
DI float lane_bcast(float v, int l) { return __uint_as_float((unsigned)__builtin_amdgcn_readlane((int)__float_as_uint(v), l)); }
DI float wave_sum(float v) { v += xor_lane<1>(v); v += xor_lane<2>(v); v += xor_lane<4>(v); v += xor_lane<8>(v); v += xor_lane<16>(v); return xor32_sum(v); }
DI float sigmoidf_(float x) { return __builtin_amdgcn_rcpf(1.f + __expf(-x)); }
#define LDS_WAIT() asm volatile("s_waitcnt lgkmcnt(0)" ::: "memory")
DI int otid() { int t = threadIdx.x; asm volatile("" : "+v"(t)); return t; }
DI const char* uni_ptr(const void* p) { const unsigned long long v = (unsigned long long)p; const unsigned lo = __builtin_amdgcn_readfirstlane((unsigned)v), hi = __builtin_amdgcn_readfirstlane((unsigned)(v >> 32)); return (const char*)(GAS const char*)(((unsigned long long)hi << 32) | lo); }
DI int obid() { int b = blockIdx.x; asm volatile("" : "+s"(b)); return b; }

#define XB_TMO      128
#define XB_XCNT(j)  (256  + 64 * (j))
#define XB_XSUB(j)  (1280 + 64 * (j))
#define XB_XGEN(j)  (2304 + 64 * (j))
#define XB_TOP      3328
#define XB_TOPGEN   3392
#define XCD_BAR_WORDS 3456
#define XB_SPIN_CAP (1u << 22)
DI unsigned xb_ld(unsigned* p)              { return __hip_atomic_load(p, __ATOMIC_RELAXED, __HIP_MEMORY_SCOPE_AGENT); }
DI unsigned xb_add(unsigned* p, unsigned v) { return __hip_atomic_fetch_add(p, v, __ATOMIC_RELAXED, __HIP_MEMORY_SCOPE_AGENT); }
DI unsigned xb_xcc_id() { return (unsigned)__builtin_amdgcn_s_getreg((3 << 11) | 20) & 0xFu; }
#define XB_SPIN(cond, bar) do { unsigned _sp = 0; while (cond) { __builtin_amdgcn_s_sleep(1); \
    if ((++_sp & 255u) == 0u) { if (xb_ld(&(bar)[XB_TMO])) break; if (_sp > XB_SPIN_CAP) { atomicAdd(&(bar)[XB_TMO], 1u); break; } } } } while (0)
struct XcdBarrier { unsigned* bar; unsigned x; volatile LAS unsigned* st; };
DI XcdBarrier xcd_barrier_post(unsigned* bar, volatile LAS unsigned* st) {
    XcdBarrier b; b.bar = bar; b.x = xb_xcc_id(); b.st = st;
    if (threadIdx.x == 0) (void)xb_add(&bar[XB_XCNT(b.x)], 1u);
    return b;
}
DI void xcd_barrier_complete(unsigned* bar, unsigned x, unsigned& nloc, unsigned& nx) {
    const unsigned G = gridDim.x * gridDim.y * gridDim.z;
    unsigned sum, cnt, mine, sp = 0u;
    for (;;) {
        sum = 0u; cnt = 0u; mine = 0u;
#pragma unroll
        for (unsigned j = 0; j < 16; ++j) { const unsigned c = xb_ld(&bar[XB_XCNT(j)]); sum += c; cnt += (c > 0u) ? 1u : 0u; mine = (j == x) ? c : mine; }
        if (sum == G) break;
        __builtin_amdgcn_s_sleep(1);
        if ((++sp & 255u) == 0u) { if (xb_ld(&bar[XB_TMO])) break; if (sp > XB_SPIN_CAP) { atomicAdd(&bar[XB_TMO], 1u); break; } }
    }
    nloc = mine > 0u ? mine : 1u; nx = cnt > 0u ? cnt : 1u;
}
DI void xcd_barrier(const XcdBarrier& b) {
    asm volatile("s_waitcnt vmcnt(0)" ::: "memory");
    __syncthreads();
    unsigned long long bi_ = (unsigned long long)uni_ptr(b.bar); asm volatile("" : "+s"(bi_));
    if (threadIdx.x == 0) {
        unsigned* bar = (unsigned*)(GAS unsigned*)bi_;
        __builtin_amdgcn_s_waitcnt(0);
        unsigned nloc = b.st[0], nx = b.st[1];
        if (nloc == 0u) { xcd_barrier_complete(bar, xb_xcc_id(), nloc, nx); b.st[0] = nloc; b.st[1] = nx; }
        const unsigned bx_ = xb_xcc_id();
        const unsigned old = xb_add(&bar[XB_XSUB(bx_)], 1u);
        const unsigned gen = old / nloc;
        if (old + 1u == (gen + 1u) * nloc) {
            __builtin_amdgcn_fence(__ATOMIC_RELEASE, "agent");
            asm volatile("s_waitcnt vmcnt(0)" ::: "memory");
            const unsigned og = xb_add(&bar[XB_TOP], 1u);
            const unsigned tg = og / nx;
            if (og + 1u == (tg + 1u) * nx) xb_add(&bar[XB_TOPGEN], 1u);
            else XB_SPIN(xb_ld(&bar[XB_TOPGEN]) == tg, bar);
            __builtin_amdgcn_fence(__ATOMIC_ACQUIRE, "agent");
            xb_add(&bar[XB_XGEN(bx_)], 1u);
            asm volatile("s_waitcnt vmcnt(0)" ::: "memory");
        } else {
            XB_SPIN(xb_ld(&bar[XB_XGEN(bx_)]) == gen, bar);
            __builtin_amdgcn_fence(__ATOMIC_ACQUIRE, "agent");
            asm volatile("s_waitcnt vmcnt(0)" ::: "memory");
        }
    }
    __syncthreads();
}

DI void hy_signal(unsigned* cw) { asm volatile("s_waitcnt vmcnt(0)" ::: "memory"); __syncthreads();
    if (threadIdx.x == 0) { __builtin_amdgcn_fence(__ATOMIC_RELEASE, "agent"); asm volatile("s_waitcnt vmcnt(0)" ::: "memory"); (void)xb_add(cw, 1u); } }
DI void hy_wait(unsigned* cw, unsigned target, unsigned* bar) {
    if (threadIdx.x == 0) { XB_SPIN(xb_ld(cw) < target, bar); __builtin_amdgcn_fence(__ATOMIC_ACQUIRE, "agent"); asm volatile("s_waitcnt vmcnt(0)" ::: "memory"); }
    __syncthreads(); }

struct Args { const float* in[46]; float* out; unsigned char* ws; };
enum { I_X = 0, I_C, I_CTX, I_CCTX, I_WMOD, I_BMOD, I_LN1G, I_LN1B, I_LN2G, I_LN2B, I_ABWIN, I_ABWOUT, I_HYSW, I_HYSB, I_FW1, I_FB1, I_FW2, I_FB2,
       I_FW3, I_FB3, I_FW4, I_FREQ, I_DECAY, I_SKIP, I_LQ1, I_LK1, I_LQ2, I_LK2, I_SUBG, I_RGWIN, I_RGWOUT, I_RGCW, I_RGCB, I_RGWA, I_RGBA, I_RGWX, I_RGBX,
       I_RGLAM, I_ROUTW, I_ROUTB, I_EXG, I_EXU, I_EXD, I_SHG, I_SHU, I_SHD };
DI const float* kin(int i) { const volatile LAS unsigned* tb = (const volatile LAS unsigned*)(size_t)LDS_PTRS; const unsigned lo = tb[2 * i], hi = tb[2 * i + 1];
    return (const float*)(GAS const float*)(((unsigned long long)(unsigned)__builtin_amdgcn_readfirstlane((int)hi) << 32) | (unsigned)__builtin_amdgcn_readfirstlane((int)lo)); }

struct GU { const bf16_t* A; const bf16_t* B; int pm, pn, e, ti, nvalid; };

DI f32x4 mfma16(bf16x8 a, bf16x8 b, f32x4 c) { return __builtin_amdgcn_mfma_f32_16x16x32_bf16(a, b, c, 0, 0, 0); }

namespace pg8 {
constexpr int BK = 64, HALF = 128, HTB = HALF * BK * 2, STAGE_BYTES = 8 * HTB;
DI int lds_byte(int r, int c) { const int st = (r >> 4) * 2 + (c >> 5), rr = r & 15, cc = c & 31, ob = rr * 64 + cc * 2; return st * 1024 + (ob ^ (((ob >> 9) & 1) << 5)); }
DI int perm32(int rho) { const int n = rho >> 4, i = rho & 15; return 8 * (i >> 2) + 4 * n + (i & 3); }
DI void stage_rc(int b, int& R, int& C) { const int st = b / 1024, sb = b % 1024, swz = sb ^ (((sb >> 9) & 1) << 5); R = (st >> 1) * 16 + swz / 64; C = (st & 1) * 32 + (swz % 64) / 2; }
template <class Sched, class Epi>
DI void gemm_naive(const Sched& S, const Epi& E, int K, int ldb) {
    const int tid = otid(), wave = tid >> 6, lane = tid & 63, fr = lane & 15, fq = lane >> 4;
    GU u;
    for (int i = 0; S.next(i, u); ++i) {
        for (int task = wave; task < 64; task += NWV) {
            const int rg = task >> 2, c0 = (task & 3) * 32, r = rg * 16 + fr;
            const bf16_t* arow = u.A + S.arow_off(u, r) + 8 * fq;
            const int br0 = Epi::PERM ? pg8::perm32(fr) : fr, br1 = Epi::PERM ? pg8::perm32(16 + fr) : 16 + fr;
            const bf16_t* b00 = u.B + (size_t)(c0 + br0) * ldb + 8 * fq; const bf16_t* b01 = u.B + (size_t)(c0 + br1) * ldb + 8 * fq;
            const bf16_t* b10 = b00 + (size_t)128 * ldb; const bf16_t* b11 = b01 + (size_t)128 * ldb;
            f32x4 a0 = {0.f, 0.f, 0.f, 0.f}, a1 = a0, b0 = a0, b1 = a0;
            for (int k0 = 0; k0 < K; k0 += 32) {
                const bf16x8 af = *(const bf16x8*)(arow + k0);
                const bf16x8 w00 = *(const bf16x8*)(b00 + k0), w01 = *(const bf16x8*)(b01 + k0), w10 = *(const bf16x8*)(b10 + k0), w11 = *(const bf16x8*)(b11 + k0);
                a0 = mfma16(w00, af, a0); a1 = mfma16(w01, af, a1); b0 = mfma16(w10, af, b0); b1 = mfma16(w11, af, b1);
            }
            const int cle = c0 + (Epi::PERM ? 8 : 4) * fq; typename Epi::UPre UP; typename Epi::Pre P; E.upre(u, cle, UP); E.pre(u, r, cle, P); E(u, r, cle, a0, a1, b0, b1, UP, P);
        }
    }
}

}
#ifndef PG8_ALIGN
#define PG8_ALIGN false
#endif
template <class Sched, class Epi>
DI void gemm_fast(LAS unsigned char* lds, const Sched& S, const Epi& E, const int K, const int ldb) {
    using namespace pg8;
    const int tid = otid(), wid = __builtin_amdgcn_readfirstlane(tid >> 6), lane = tid & 63, wr = wid >> 2, wc = wid & 3, fr = lane & 15, fq = lane >> 4;
    const int nt = K / BK;
    int R0, C0, R1, C1; stage_rc(tid * 16, R0, C0); stage_rc(tid * 16 + 8192, R1, C1);
    const int Rb0 = Epi::PERM ? ((R0 & ~31) + perm32(R0 & 31)) : R0, Rb1 = Epi::PERM ? ((R1 & ~31) + perm32(R1 & 31)) : R1;
    unsigned voffB[2]; voffB[0] = (unsigned)(Rb0 * ldb + C0) * 2u; voffB[1] = (unsigned)(Rb1 * ldb + C1) * 2u;
    GU cur, nxt; int ui = 0;
    if (!S.next(0, cur)) return;
    const size_t lda_ = S.arow_off(cur, 1);
    unsigned voffA[2]; voffA[0] = (unsigned)(R0 * lda_ + C0) * 2u; voffA[1] = (unsigned)(R1 * lda_ + C1) * 2u;
    const size_t kstep = (size_t)(BK * 2), hstepB = (size_t)HALF * ldb * 2, hstepA = (size_t)HALF * lda_ * 2;
    const unsigned ldsw = (unsigned)wid * 1024u;
    const int aoff = lds_byte(wr * 64 + fr, fq * 8), boff = lds_byte(wc * 32 + fr, fq * 8);
#define PG8_SA(b, h) (((b) * 2 + (h)) * HTB)
#define PG8_SB(b, h) ((4 + (b) * 2 + (h)) * HTB)
#define PG8_GLDS(gp, ldsoff) __builtin_amdgcn_global_load_lds((const unsigned*)(gp), (LAS unsigned*)(lds + (ldsoff)), 16, 0, 0)
#define PG8_STAGE_B(bufoff, gbase) do { PG8_GLDS((const char*)(gbase) + voffB[0], (bufoff) + ldsw); PG8_GLDS((const char*)(gbase) + voffB[1], (bufoff) + ldsw + 8192); } while (0)
#define PG8_STAGE_A(bufoff, gbase, h, o0, o1) do { if constexpr (Sched::GATHER) { PG8_GLDS((const char*)(gbase) + (o0), (bufoff) + ldsw); PG8_GLDS((const char*)(gbase) + (o1), (bufoff) + ldsw + 8192); } \
        else { PG8_GLDS((const char*)(gbase) + (h) * hstepA + voffA[0], (bufoff) + ldsw); PG8_GLDS((const char*)(gbase) + (h) * hstepA + voffA[1], (bufoff) + ldsw + 8192); } } while (0)
#define PG8_LDA(dst, b, h) do { _Pragma("unroll") for (int m = 0; m < 4; ++m) _Pragma("unroll") for (int k = 0; k < 2; ++k) dst[m][k] = *(const LAS bf16x8*)(lds + PG8_SA(b, h) + aoff + m * 2048 + k * 1024); } while (0)
#define PG8_LDB(dst, b, h) do { _Pragma("unroll") for (int n = 0; n < 2; ++n) _Pragma("unroll") for (int k = 0; k < 2; ++k) dst[n][k] = *(const LAS bf16x8*)(lds + PG8_SB(b, h) + boff + n * 2048 + k * 1024); } while (0)
#define PG8_MMA(ai, bj, At, Bt) do { __builtin_amdgcn_s_setprio(1); _Pragma("unroll") for (int m = 0; m < 4; ++m) _Pragma("unroll") for (int n = 0; n < 2; ++n) _Pragma("unroll") for (int k = 0; k < 2; ++k) \
        acc[ai][bj][m][n] = __builtin_amdgcn_mfma_f32_16x16x32_bf16(Bt[n][k], At[m][k], acc[ai][bj][m][n], 0, 0, 0); __builtin_amdgcn_s_setprio(0); } while (0)
#define PG8_WAIT_V(n) asm volatile("s_waitcnt vmcnt(" #n ")" ::: "memory")
#define PG8_WAIT_L(n) asm volatile("s_waitcnt lgkmcnt(" #n ")" ::: "memory")
#define PG8_BAR __builtin_amdgcn_s_barrier()
#define PG8_SCHED __builtin_amdgcn_sched_barrier(0)
#define PG8_AOFFS(d00, d01, d10, d11, u) do { if constexpr (Sched::GATHER) { d00 = (unsigned)(S.arow_off(u, R0) + C0) * 2u; d01 = (unsigned)(S.arow_off(u, R1) + C1) * 2u; \
        d10 = (unsigned)(S.arow_off(u, R0 + 128) + C0) * 2u; d11 = (unsigned)(S.arow_off(u, R1 + 128) + C1) * 2u; } } while (0)
    f32x4 acc[2][2][4][2];
#pragma unroll
    for (int a_ = 0; a_ < 2; ++a_)
#pragma unroll
        for (int b_ = 0; b_ < 2; ++b_)
#pragma unroll
            for (int m = 0; m < 4; ++m)
#pragma unroll
                for (int n = 0; n < 2; ++n) acc[a_][b_][m][n] = (f32x4){0.f, 0.f, 0.f, 0.f};
    bf16x8 At[4][2], B0[2][2], B1[2][2];
    const char* cA = uni_ptr(cur.A); const char* cB = uni_ptr(cur.B);
    unsigned c00 = 0, c01 = 0, c10 = 0, c11 = 0, n00 = 0, n01 = 0, n10 = 0, n11 = 0;
    PG8_AOFFS(c00, c01, c10, c11, cur);
    PG8_STAGE_B(PG8_SB(0, 0), cB); PG8_STAGE_B(PG8_SB(0, 1), cB + hstepB); PG8_STAGE_A(PG8_SA(0, 0), cA, 0, c00, c01); PG8_STAGE_A(PG8_SA(0, 1), cA, 1, c10, c11);
    if (wr == 1) PG8_BAR;
    PG8_WAIT_V(2); PG8_BAR;
    PG8_STAGE_B(PG8_SB(1, 0), cB + kstep); PG8_STAGE_A(PG8_SA(1, 0), cA + kstep, 0, c00, c01); PG8_STAGE_B(PG8_SB(1, 1), cB + hstepB + kstep);
    PG8_WAIT_V(6); PG8_BAR;
    for (;;) {
        const bool has_next = S.next(ui + 1, nxt);
        const char* nA = has_next ? uni_ptr(nxt.A) : cA; const char* nB = has_next ? uni_ptr(nxt.B) : cB;
        if (has_next) { PG8_AOFFS(n00, n01, n10, n11, nxt); } else { n00 = c00; n01 = c01; n10 = c10; n11 = c11; }
        if constexpr (Epi::LDSMETA) { int tq = threadIdx.x; asm volatile("" : "+v"(tq));
            if (tq < 256) { const unsigned* gp = E.mptr(cur, tq); LAS unsigned* lp = (LAS unsigned*)(lds + 131072 + (ui & 1) * 2048 + __builtin_amdgcn_readfirstlane(tq >> 6) * 256);
                __builtin_amdgcn_global_load_lds(gp, lp, 4, 0, 0); __builtin_amdgcn_global_load_lds(gp + 1, lp + 256, 4, 0, 0); } }
        typename Epi::Pre PE[Epi::EARLY ? 4 : 1];
        if constexpr (Epi::EARLY) { int tq = threadIdx.x; asm volatile("" : "+v"(tq)); const int wq = tq >> 6, lq = tq & 63, rbq = (wq >> 2) * 64 + (lq & 15), clq = (wq & 3) * 32 + (Epi::PERM ? 8 : 4) * (lq >> 4);
#pragma unroll
            for (int g = 0; g < 4; ++g) E.pre(cur, rbq + g * 16, clq, PE[g]); }
        for (int t = 0; t < nt; t += 2) {
            const bool last = (t == nt - 2);
            const char* a1 = cA + (size_t)(t + 1) * kstep;
            const char* a2 = last ? nA : cA + (size_t)(t + 2) * kstep; const char* b2 = last ? nB : cB + (size_t)(t + 2) * kstep;
            const char* a3 = a2 + kstep; const char* b3 = b2 + kstep;
            asm volatile("" : "+s"(a1), "+s"(a2), "+s"(b2), "+s"(a3), "+s"(b3));
            const unsigned o00 = last ? n00 : c00, o01 = last ? n01 : c01, o10 = last ? n10 : c10, o11 = last ? n11 : c11;
            PG8_LDB(B0, 0, 0); PG8_LDB(B1, 0, 1); PG8_SCHED; PG8_LDA(At, 0, 0); PG8_STAGE_A(PG8_SA(1, 1), a1, 1, c10, c11);
            PG8_WAIT_V(8); PG8_WAIT_L(0); PG8_BAR; PG8_MMA(0, 0, At, B0); PG8_MMA(0, 1, At, B1); PG8_BAR; PG8_SCHED;
            PG8_LDA(At, 0, 1); PG8_STAGE_B(PG8_SB(0, 0), b2); PG8_STAGE_B(PG8_SB(0, 1), b2 + hstepB); PG8_STAGE_A(PG8_SA(0, 0), a2, 0, o00, o01);
            PG8_WAIT_V(8); PG8_WAIT_L(0); PG8_BAR; PG8_MMA(1, 0, At, B0); PG8_MMA(1, 1, At, B1);
            PG8_BAR; PG8_SCHED;
            PG8_LDB(B0, 1, 0); PG8_LDB(B1, 1, 1); PG8_SCHED; PG8_LDA(At, 1, 0); PG8_STAGE_A(PG8_SA(0, 1), a2, 1, o10, o11);
            PG8_WAIT_V(8); PG8_WAIT_L(0); PG8_BAR; PG8_MMA(0, 0, At, B0); PG8_MMA(0, 1, At, B1); PG8_BAR; PG8_SCHED;
            PG8_LDA(At, 1, 1); PG8_STAGE_B(PG8_SB(1, 0), b3); PG8_STAGE_B(PG8_SB(1, 1), b3 + hstepB); PG8_STAGE_A(PG8_SA(1, 0), a3, 0, o00, o01);
            PG8_WAIT_V(8); PG8_WAIT_L(0); PG8_BAR; PG8_MMA(1, 0, At, B0); PG8_MMA(1, 1, At, B1); PG8_BAR; PG8_SCHED;
        }
        if (PG8_ALIGN) { if (wr == 0) PG8_BAR; }
        { int tz = threadIdx.x; asm volatile("" : "+v"(tz));
          const int wz = tz >> 6, lz = tz & 63, wrz = wz >> 2, wcz = wz & 3, frz = lz & 15, fqz = lz >> 4;
          const int clz = wcz * 32 + (Epi::PERM ? 8 : 4) * fqz, rbz = wrz * 64 + frz;
          typename Epi::UPre UP; E.upre(cur, clz, UP);
          if constexpr (Epi::EARLY) { typename Epi::Pre P2[4];
#pragma unroll
              for (int g = 0; g < 4; ++g) E.pre(cur, HALF + rbz + g * 16, clz, P2[g]);
#pragma unroll
              for (int g = 0; g < 4; ++g) E(cur, rbz + g * 16, clz, acc[0][0][g][0], acc[0][0][g][1], acc[0][1][g][0], acc[0][1][g][1], UP, PE[g]);
#pragma unroll
              for (int g = 0; g < 4; ++g) E(cur, HALF + rbz + g * 16, clz, acc[1][0][g][0], acc[1][0][g][1], acc[1][1][g][0], acc[1][1][g][1], UP, P2[g]); }
          else {
#pragma unroll
          for (int gb = 0; gb < 8; gb += Epi::BATCH) { typename Epi::Pre PP[Epi::BATCH];
#pragma unroll
              for (int j = 0; j < Epi::BATCH; ++j) { if constexpr (Epi::LDSMETA) E.pre_lds(cur, lds + 131072 + (ui & 1) * 2048, ((gb + j) >> 2) * HALF + rbz + ((gb + j) & 3) * 16, PP[j]); else E.pre(cur, ((gb + j) >> 2) * HALF + rbz + ((gb + j) & 3) * 16, clz, PP[j]); }
#pragma unroll
              for (int j = 0; j < Epi::BATCH; ++j) { const int ai = (gb + j) >> 2, m = (gb + j) & 3;
                  E(cur, ai * HALF + rbz + m * 16, clz, acc[ai][0][m][0], acc[ai][0][m][1], acc[ai][1][m][0], acc[ai][1][m][1], UP, PP[j]); } } }
        }
        if (!has_next) break;
#pragma unroll
        for (int a_ = 0; a_ < 2; ++a_)
#pragma unroll
            for (int b_ = 0; b_ < 2; ++b_)
#pragma unroll
                for (int m = 0; m < 4; ++m)
#pragma unroll
                    for (int n = 0; n < 2; ++n) acc[a_][b_][m][n] = (f32x4){0.f, 0.f, 0.f, 0.f};
        cur = nxt; cA = nA; cB = nB; c00 = n00; c01 = n01; c10 = n10; c11 = n11; ++ui;
        if (PG8_ALIGN) { if (wr == 1) PG8_BAR; }
    }
    PG8_WAIT_V(0);
    if (!PG8_ALIGN) { if (wr == 0) PG8_BAR; }
    PG8_BAR;
#undef PG8_SA
#undef PG8_SB
#undef PG8_GLDS
#undef PG8_STAGE_A
#undef PG8_STAGE_B
#undef PG8_LDA
#undef PG8_LDB
#undef PG8_MMA
#undef PG8_WAIT_V
#undef PG8_WAIT_L
#undef PG8_BAR
#undef PG8_SCHED
#undef PG8_AOFFS
}
template <bool FAST, class Sched, class Epi>
DI void gemm_units(LAS unsigned char* lds, const Sched& S, const Epi& E, int K, int ldb) { if constexpr (FAST) gemm_fast(lds, S, E, K, ldb); else gemm_naive(S, E, K, ldb); }

struct SchedDense {
    static constexpr bool GATHER = false;
    const bf16_t* A; const bf16_t* B; int lda, ldb, nM, nN, G, c;
    DI bool next(int i, GU& u) const { const int L = i * G + c; const int nwg = nM * nN; if (L >= nwg) return false;
        int wgid = L; { const int q = nwg >> 3, r = nwg & 7, xcd = wgid & 7, off = wgid >> 3; wgid = (xcd < r ? xcd * (q + 1) : r * (q + 1) + (xcd - r) * q) + off; }
        const int nig = 8 * nN, gid = wgid / nig, fm = gid * 8, gsz = (nM - fm) < 8 ? (nM - fm) : 8; u.pm = fm + ((wgid % nig) % gsz); u.pn = (wgid % nig) / gsz;
        u.A = A + (size_t)u.pm * 256 * lda; u.B = B + (size_t)u.pn * 256 * ldb; u.e = 0; u.ti = 0; u.nvalid = 256; return true; }
    DI size_t arow_off(const GU&, int r) const { return (size_t)r * lda; }
};
struct SchedGates {
    static constexpr bool GATHER = false;
    const bf16_t* A; const bf16_t* B; int nM, G, c;
    DI bool next(int i, GU& u) const { const int L = i * G + c; const int nwg = nM * 16; if (L >= nwg) return false;
        int wgid = L; { const int q = nwg >> 3, r = nwg & 7, xcd = wgid & 7, off = wgid >> 3; wgid = (xcd < r ? xcd * (q + 1) : r * (q + 1) + (xcd - r) * q) + off; }
        u.pm = wgid >> 4; u.pn = wgid & 15;
        u.A = A + (size_t)u.pm * 256 * 1024 + (u.pn >> 1) * 128; u.B = B + (size_t)u.pn * 256 * 128; u.e = 0; u.ti = 0; u.nvalid = 256; return true; }
    DI size_t arow_off(const GU&, int r) const { return (size_t)r * 1024; }
};
template <bool GATH> struct SchedMoeT {
    static constexpr bool GATHER = GATH;
    const bf16_t* A; const bf16_t* B; const int* cnt; const int2* list; volatile LAS int* toff; volatile LAS unsigned char* rt2e; int NT, NJ, G, c; size_t bstride;
    DI bool next(int i, GU& u) const {
        const int xcd = c & 7, k = c >> 3, nk = G >> 3, base = NT >> 3, rem = NT & 7, start = xcd * base + (xcd < rem ? xcd : rem), len = base + (xcd < rem ? 1 : 0);
        const int full = len / nk, remt = len - full * nk;
        int rt;
        if (GATH) { const int uu = k + i * nk; if (uu >= len * NJ) return false; rt = start + uu / NJ; u.pn = uu % NJ; }
        else if (i < full * NJ) { const int ti_ = i / NJ; rt = start + k + ti_ * nk; u.pn = i - ti_ * NJ; }
        else { const int uu = k + (i - full * NJ) * nk; if (uu >= remt * NJ) return false; rt = start + full * nk + uu / NJ; u.pn = uu % NJ; }
        u.pm = rt;
        const int e = __builtin_amdgcn_readfirstlane((int)rt2e[rt]);
        u.e = e; u.ti = rt - __builtin_amdgcn_readfirstlane(toff[e]); u.nvalid = __builtin_amdgcn_readfirstlane((int)((volatile LAS unsigned short*)(toff + 128 + 352))[rt]);
        u.A = GATH ? A : A + (size_t)rt * 256 * 256; u.B = B + (size_t)e * bstride + (size_t)u.pn * 256 * (GATH ? 1024 : 256); return true; }
    DI size_t arow_off(const GU& u, int r) const {
        if (!GATH) return (size_t)r * 256;
        int tok; if (u.e < 64) tok = (r < u.nvalid) ? (list[(size_t)u.e * T + u.ti * 256 + r].x >> 3) : 0; else tok = u.ti * 256 + r;
        return (size_t)tok * 1024; }
};

struct PreNone {};
struct PreRope { f32x4 t0, t1; };
struct EpiAbIn { bf16_t *PH, *QB, *KB, *VB; const float* rope; typedef PreNone UPre; typedef PreRope Pre; static constexpr int BATCH = 8; static constexpr bool LDSMETA = false, EARLY = false, PERM = false;
    DI void upre(const GU&, int, UPre&) const {}
    DI void pre(const GU& u, int rl, int cl, Pre& P) const { P.t0 = (f32x4){1.f, 0.f, 1.f, 0.f}; P.t1 = P.t0;
        const int row = u.pm * 256 + rl;
        if (u.pn >= 6 && u.pn < 10 && row < TL) { const int d = cl & 63, axis = d >> 5, f0 = d & 15, pos = row & (SEQ - 1), p = axis ? (pos & 63) : (pos >> 6);
            P.t0 = *(const f32x4*)(rope + (p * 16 + f0) * 2); P.t1 = *(const f32x4*)(rope + (p * 16 + f0) * 2 + 4); } }
    DI void put(int row, int col, f32x4 v0, f32x4 v1, const Pre& P) const {
        if (col < 1536) { store_bf4(PH + (size_t)row * 1536 + col, v0); store_bf4(PH + (size_t)row * 1536 + col + 16, v1); }
        else if (col < 2560) { int cc = col - 1536; bf16_t* dst = cc < 512 ? QB : KB; const float sc = cc < 512 ? C2 : 1.f; cc &= 511;
            const f32x4 cs = {P.t0[0], P.t0[2], P.t1[0], P.t1[2]}, sn = {P.t0[1], P.t0[3], P.t1[1], P.t1[3]};
            const f32x4 xa = v0, xb = v1; v0 = (xa * cs - xb * sn) * sc; v1 = (xb * cs + xa * sn) * sc;
            store_bf4(dst + (size_t)row * 512 + cc, v0); store_bf4(dst + (size_t)row * 512 + cc + 16, v1); }
        else { const int cc = col - 2560; store_bf4(VB + (size_t)row * 512 + cc, v0); store_bf4(VB + (size_t)row * 512 + cc + 16, v1); }
    }
    DI void operator()(const GU& u, int rl, int cl, f32x4 a0, f32x4 a1, f32x4 b0, f32x4 b1, const UPre&, const Pre& P) const {
        const int row = u.pm * 256 + rl, col = u.pn * 256 + cl; put(row, col, a0, a1, P); put(row, col + 128, b0, b1, P); }
};
DI float gelu_tanh(float x) { const float y = 0.7978845608028654f * (x + 0.044715f * x * x * x); const float t = 1.f - 2.f * __builtin_amdgcn_rcpf(1.f + __expf(2.f * y)); return 0.5f * x * (1.f + t); }
struct EpiRgIn { bf16_t *GATE, *REC; typedef PreNone UPre; typedef PreNone Pre; static constexpr int BATCH = 8; static constexpr bool LDSMETA = false, EARLY = false, PERM = true;
    DI void upre(const GU&, int, UPre&) const {}
    DI void pre(const GU&, int, int, Pre&) const {}
    DI void put(int row, int col, f32x4 v0, f32x4 v1) const {
        if (col < 1024) { f32x4 g0, g1;
#pragma unroll
            for (int j = 0; j < 4; ++j) { g0[j] = gelu_tanh(v0[j]); g1[j] = gelu_tanh(v1[j]); }
            store_bf8(GATE + (size_t)row * 1024 + col, g0, g1); }
        else store_bf8(REC + (size_t)row * 1024 + col - 1024, v0, v1); }
    DI void operator()(const GU& u, int rl, int cl, f32x4 a0, f32x4 a1, f32x4 b0, f32x4 b1, const UPre&, const Pre&) const {
        const int row = u.pm * 256 + rl, col = u.pn * 256 + cl; put(row, col, a0, a1); put(row, col + 128, b0, b1); }
};
struct EpiM { bf16_t* O;
    typedef PreNone UPre; typedef PreNone Pre; static constexpr int BATCH = 8; static constexpr bool LDSMETA = false, EARLY = false, PERM = true;
    DI void upre(const GU&, int, UPre&) const {}
    DI void pre(const GU&, int, int, Pre&) const {}
    DI void operator()(const GU& u, int rl, int cl, f32x4 a0, f32x4 a1, f32x4 b0, f32x4 b1, const UPre&, const Pre&) const {
        bf16_t* p = O + (size_t)(u.pm * 256 + rl) * 1024 + u.pn * 256 + cl; store_bf8(p, a0, a1); store_bf8(p + 128, b0, b1); }
};
struct PreGU { f32x4 ba0, ba1, bx0, bx1, lm0, lm1; };
struct PreGP { u32x4 u; };
struct EpiGates { const bf16_t* U; bf16_t *LA, *BB; const float *ba, *bx, *lam;
    typedef PreGU UPre; typedef PreGP Pre; static constexpr int BATCH = 8; static constexpr bool LDSMETA = false, EARLY = false, PERM = true;
    DI void upre(const GU& u, int cl, UPre& P) const { const int k = u.pn >> 1, dir = u.pn & 1, ci = dir * 1024 + k * 128 + cl;
        P.ba0 = *(const f32x4*)(ba + ci); P.ba1 = *(const f32x4*)(ba + ci + 4); P.bx0 = *(const f32x4*)(bx + ci); P.bx1 = *(const f32x4*)(bx + ci + 4);
        P.lm0 = *(const f32x4*)(lam + ci); P.lm1 = *(const f32x4*)(lam + ci + 4); }
    DI void pre(const GU& u, int rl, int cl, Pre& P) const { const int row = u.pm * 256 + rl, ch = (u.pn >> 1) * 128 + cl; P.u = *(const u32x4*)(U + (size_t)row * 1024 + ch); }
    DI void calc(f32x4 ra, f32x4 ia, unsigned ux, unsigned uy, f32x4 bav, f32x4 bxv, f32x4 lmv, f32x4& la, f32x4& bb) const {
        const float uv[4] = {__uint_as_float(ux << 16), __uint_as_float(ux & 0xffff0000u), __uint_as_float(uy << 16), __uint_as_float(uy & 0xffff0000u)};
#pragma unroll
        for (int j = 0; j < 4; ++j) {
            const float ex = __expf(-fminf(fmaxf(ra[j] + bav[j], -30.f), 30.f)) + 1.f, ey = __expf(-fminf(fmaxf(ia[j] + bxv[j], -30.f), 30.f)) + 1.f, rc = __builtin_amdgcn_rcpf(ex * ey);
            la[j] = (ey * rc) * lmv[j]; bb[j] = (ex * rc) * uv[j]; } }
    DI void operator()(const GU& u, int rl, int cl, f32x4 a0, f32x4 a1, f32x4 b0, f32x4 b1, const UPre& UP, const Pre& P) const {
        const int row = u.pm * 256 + rl, k = u.pn >> 1, dir = u.pn & 1, ch = k * 128 + cl; f32x4 la0, bb0, la1, bb1;
        calc(a0, b0, P.u.x, P.u.y, UP.ba0, UP.bx0, UP.lm0, la0, bb0); calc(a1, b1, P.u.z, P.u.w, UP.ba1, UP.bx1, UP.lm1, la1, bb1);
        store_bf8(LA + ((size_t)dir * T + row) * 1024 + ch, la0, la1); store_bf8(BB + ((size_t)dir * T + row) * 1024 + ch, bb0, bb1); }
};
struct EpiGU { bf16_t* HS; typedef PreNone UPre; typedef PreNone Pre; static constexpr int BATCH = 8; static constexpr bool LDSMETA = false, EARLY = false, PERM = true;
    DI void upre(const GU&, int, UPre&) const {}
    DI void pre(const GU&, int, int, Pre&) const {}
    DI void operator()(const GU& u, int rl, int cl, f32x4 a0, f32x4 a1, f32x4 b0, f32x4 b1, const UPre&, const Pre&) const {
        f32x4 h0, h1;
#pragma unroll
        for (int j = 0; j < 4; ++j) { h0[j] = a0[j] * sigmoidf_(a0[j]) * b0[j]; h1[j] = a1[j] * sigmoidf_(a1[j]) * b1[j]; }
        store_bf8(HS + ((size_t)u.pm * 256 + rl) * 256 + u.pn * 128 + cl, h0, h1); }
};
struct PreD { int2 meta; };
struct EpiDn { bf16_t* Y; const int2* list;
    typedef PreNone UPre; typedef PreD Pre; static constexpr int BATCH = 8; static constexpr bool LDSMETA = true, EARLY = false, PERM = true;
    DI void upre(const GU&, int, UPre&) const {}
    DI void pre(const GU& u, int rl, int, Pre& P) const { P.meta = (rl < u.nvalid) ? list[(size_t)u.e * T + u.ti * 256 + rl] : make_int2(-1, 0); }
    DI const unsigned* mptr(const GU& u, int r) const { return (const unsigned*)(list + (size_t)u.e * T + u.ti * 256 + r); }
    DI void pre_lds(const GU& u, const LAS unsigned char* mb, int rl, Pre& P) const { const int px = *(const LAS int*)(mb + rl * 4), py = *(const LAS int*)(mb + 1024 + rl * 4); P.meta = (rl < u.nvalid) ? make_int2(px, py) : make_int2(-1, 0); }
    DI void operator()(const GU& u, int, int cl, f32x4 a0, f32x4 a1, f32x4 b0, f32x4 b1, const UPre&, const Pre& P) const {
        if (P.meta.x >= 0) { const float w = __int_as_float(P.meta.y); bf16_t* y = Y + (size_t)P.meta.x * 1024 + u.pn * 256 + cl;
            store_bf8(y, a0 * w, a1 * w); store_bf8(y + 128, b0 * w, b1 * w); } }
};

DI void phase_mod(const Args& a, LAS unsigned char* lds) {
    const float* kp_I_BMOD = kin(I_BMOD); const float* kp_I_C = kin(I_C); const float* kp_I_CCTX = kin(I_CCTX); const float* kp_I_WMOD = kin(I_WMOD);
    LAS float* sc = (LAS float*)lds;
    LAS float* red = sc + 17 * 1024;
    float* MOD = (float*)(a.ws + WS_MOD);
    const int tid = otid(), wave = tid >> 6, lane = tid & 63;
    for (int i = tid; i < 17 * 1024; i += NTH) { const float v = (i < 16384) ? kp_I_C[i] : kp_I_CCTX[i - 16384]; sc[i] = v / (1.f + expf(-v)); }
    __syncthreads();
    const int wv = __builtin_amdgcn_readfirstlane(wave), col = lane & 31, kh = lane >> 5;
    const unsigned voff = (unsigned)(kh * 64 * 6144 + col) * 4u;
    for (int unit = obid(); unit < 4 * 192; unit += gridDim.x) {
        const int l = unit / 192, n0 = (unit % 192) * 32;
        const float* Wb = kp_I_WMOD + (size_t)l * 1024 * 6144 + n0 + (size_t)(wv * 128) * 6144;
        float w[64];
#pragma unroll
        for (int u = 0; u < 64; ++u) w[u] = *(const float*)((const char*)(Wb + (size_t)u * 6144) + voff);
        float acc[17];
#pragma unroll
        for (int r = 0; r < 17; ++r) acc[r] = 0.f;
        const LAS float* scp = sc + wv * 128 + kh * 64;
#pragma unroll
        for (int u4 = 0; u4 < 16; ++u4) {
#pragma unroll
            for (int r = 0; r < 17; ++r) { const f32x4 s = *(const LAS f32x4*)(scp + r * 1024 + 4 * u4); acc[r] += (s[0] * w[4 * u4] + s[1] * w[4 * u4 + 1]) + (s[2] * w[4 * u4 + 2] + s[3] * w[4 * u4 + 3]); } }
#pragma unroll
        for (int r = 0; r < 17; ++r) red[((wv * 2 + kh) * 17 + r) * 32 + col] = acc[r];
        __syncthreads();
        for (int i = tid; i < 17 * 32; i += NTH) { const int r = i >> 5, cl = i & 31; float s = 0.f;
#pragma unroll
            for (int p = 0; p < 16; ++p) s += red[(p * 17 + r) * 32 + cl];
            MOD[((size_t)l * 17 + r) * 6144 + n0 + cl] = s + kp_I_BMOD[l * 6144 + n0 + cl]; }
        __syncthreads();
    }
}
DI void phase_hdn(const Args& a) {
    const float* kp_I_FB1 = kin(I_FB1); const float* kp_I_FB2 = kin(I_FB2); const float* kp_I_FB3 = kin(I_FB3); const float* kp_I_FREQ = kin(I_FREQ); const float* kp_I_FW1 = kin(I_FW1); const float* kp_I_FW2 = kin(I_FW2); const float* kp_I_FW3 = kin(I_FW3);
    float* HDN = (float*)(a.ws + WS_HDN);
    const int tid = otid(); const int lane = tid & 63, gw = obid() * NWV + (tid >> 6), NGW = gridDim.x * NWV;
    for (int task = gw; task < 2 * 2304; task += NGW) {
        const int e = task / 2304, p = task % 2304, nsel = p >= 2048, t = nsel ? p - 2048 : p, n = nsel ? 256 : 2048;
        const float tt = (float)t / (float)(n - 1);
        const float fm = 1e-4f + (float)(lane & 15) * ((15.f - 1e-4f) / 15.f);
        const float ang = (6.283185307179586f / (float)n) * (float)t * fm;
        const float cs = cosf(ang), sn = sinf(ang);
        const float* w1 = kp_I_FW1 + e * 33 * 64; const float* w2 = kp_I_FW2 + e * 64 * 64; const float* w3 = kp_I_FW3 + e * 64 * 64;
        const float fr = kp_I_FREQ[e * 64 + lane];
        float s = tt * w1[lane];
#pragma unroll
        for (int m = 0; m < 16; ++m) { s += lane_bcast(cs, m) * w1[(1 + m) * 64 + lane]; s -= lane_bcast(sn, m) * w1[(17 + m) * 64 + lane]; }
        float h = sinf(fr * (s + kp_I_FB1[e * 64 + lane]));
        s = 0.f;
#pragma unroll 8
        for (int i = 0; i < 64; ++i) s += lane_bcast(h, i) * w2[i * 64 + lane];
        h = sinf(fr * (s + kp_I_FB2[e * 64 + lane]));
        s = 0.f;
#pragma unroll 8
        for (int i = 0; i < 64; ++i) s += lane_bcast(h, i) * w3[i * 64 + lane];
        h = sinf(fr * (s + kp_I_FB3[e * 64 + lane]));
        HDN[(size_t)task * 64 + lane] = h;
    }
}
DI void phase_rope(const Args& a) {
    const float* kp_I_RGLAM = kin(I_RGLAM);
    float* R = (float*)(a.ws + WS_ROPE);
    const int gt = obid() * NTH + otid();
    if (gt < 64 * 16) { const int p = gt >> 4, f = gt & 15; const float inv = powf(10000.f, -(float)f / 16.f); const float ang = (float)p * inv; R[gt * 2] = cosf(ang); R[gt * 2 + 1] = sinf(ang); }
    if (gt < 2 * 2048) { float* LSG = (float*)(a.ws + WS_ROPE + 65536); LSG[gt] = -8.f * log1pf(expf(-kp_I_RGLAM[gt])); }
}
DI void transpose_item(const float* W, int ldw, bf16_t* WT, int ldt, int k0, int n0, int drow0, int dcol0, LAS float* scr, int lane) {
    const int c4 = (lane & 15) * 4, kr = lane >> 4;
    f32x4 tv[16];
#pragma unroll
    for (int i = 0; i < 16; ++i) tv[i] = *(const f32x4*)(W + (size_t)(k0 + 4 * i + kr) * ldw + n0 + c4);
#pragma unroll
    for (int i = 0; i < 16; ++i) { LAS float* d = scr + (4 * i + kr) * 65 + c4; d[0] = tv[i][0]; d[1] = tv[i][1]; d[2] = tv[i][2]; d[3] = tv[i][3]; }
    LDS_WAIT();
    const int c = lane & 7;
#pragma unroll
    for (int j = 0; j < 8; ++j) { const int n = (lane >> 3) + 8 * j; const LAS float* s = scr + (8 * c) * 65 + n;
        u32x4 o; o.x = pk2(s[0 * 65], s[1 * 65]); o.y = pk2(s[2 * 65], s[3 * 65]); o.z = pk2(s[4 * 65], s[5 * 65]); o.w = pk2(s[6 * 65], s[7 * 65]);
        *(u32x4*)(WT + (size_t)(drow0 + n) * ldt + dcol0 + 8 * c) = o; }
    LDS_WAIT();
}
DI void phase_weights(const Args& a, int l, LAS unsigned char* lds) {
    const int tid = otid(), wave = tid >> 6, lane = tid & 63, gw = obid() * NWV + wave, NGW = gridDim.x * NWV;
    LAS float* scr = (LAS float*)(lds + wave * 16896);
    bf16_t* WIN = (bf16_t*)(a.ws + WS_WIN); bf16_t* WOUT = (bf16_t*)(a.ws + WS_WOUT); bf16_t* WG = (bf16_t*)(a.ws + WS_WG);
    bf16_t* WGU = (bf16_t*)(a.ws + WS_WGU); bf16_t* WD = (bf16_t*)(a.ws + WS_WD);
    const int half = l >> 1;
    const float* p_exg = kin(I_EXG); const float* p_exu = kin(I_EXU); const float* p_exd = kin(I_EXD); const float* p_shg = kin(I_SHG); const float* p_shu = kin(I_SHU); const float* p_shd = kin(I_SHD);
    for (int it = gw; it < 65 * 192; it += NGW) {
        const int e = it / 192, m = (it % 192) >> 6, r = it & 63;
        if (m < 2) { const float* src = (e < 64) ? (m ? p_exu : p_exg) + ((size_t)l * 64 + e) * 1024 * 256 : (m ? p_shu : p_shg) + (size_t)l * 1024 * 256;
            const int kb = r >> 2, nb = r & 3, n0 = nb * 64; const int drow0 = (n0 >> 7) * 256 + (n0 & 127) + (m ? 128 : 0);
            transpose_item(src, 256, WGU + (size_t)e * 512 * 1024, 1024, kb * 64, n0, drow0, kb * 64, scr, lane); }
        else { const float* src = (e < 64) ? p_exd + ((size_t)l * 64 + e) * 256 * 1024 : p_shd + (size_t)l * 256 * 1024;
            const int kb = r >> 4, nb = r & 15; transpose_item(src, 1024, WD + (size_t)e * 1024 * 256, 256, kb * 64, nb * 64, nb * 64, kb * 64, scr, lane); }
    }
    { const float* rw = kin(I_ROUTW) + (size_t)l * 1024 * 64; bf16_t* RWT = (bf16_t*)(a.ws + WS_ROPE + 131072);
      for (int idx = obid() * NTH + tid; idx < 64 * 1024; idx += gridDim.x * NTH) { const int e = idx >> 10, k = idx & 1023; const float w = rw[k * 64 + e]; const unsigned hi = f2bf(w);
          RWT[idx] = (bf16_t)hi; RWT[65536 + idx] = (bf16_t)f2bf(w - __uint_as_float(hi << 16)); } }
    if ((l & 1) == 0) {
        const float* win = kin(I_ABWIN) + (size_t)half * 1024 * 3072; const float* wout = kin(I_ABWOUT) + (size_t)half * 1024 * 1024;
        for (int it = gw; it < 768 + 256; it += NGW) {
            if (it < 768) { const int kb = it / 48, nb = it % 48; transpose_item(win, 3072, WIN, 1024, kb * 64, nb * 64, nb * 64, kb * 64, scr, lane); }
            else { const int r = it - 768, kb = r >> 4, nb = r & 15; transpose_item(wout, 1024, WOUT, 1024, kb * 64, nb * 64, nb * 64, kb * 64, scr, lane); }
        }
    } else {
        const float* win = kin(I_RGWIN) + (size_t)half * 1024 * 2048; const float* wout = kin(I_RGWOUT) + (size_t)half * 1024 * 1024;
        for (int it = gw; it < 512 + 256; it += NGW) {
            if (it < 512) { const int kb = it >> 5, nb = it & 31; transpose_item(win, 2048, WIN, 1024, kb * 64, nb * 64, nb * 64, kb * 64, scr, lane); }
            else { const int r = it - 512, kb = r >> 4, nb = r & 15; transpose_item(wout, 1024, WOUT, 1024, kb * 64, nb * 64, nb * 64, kb * 64, scr, lane); }
        }
        const float* wa = kin(I_RGWA) + (size_t)half * 2 * 8 * 128 * 128; const float* wx = kin(I_RGWX) + (size_t)half * 2 * 8 * 128 * 128;
        for (int idx = obid() * NTH + tid; idx < 4096 * 128; idx += gridDim.x * NTH) {
            const int n = idx >> 7, kk = idx & 127, pn = n >> 8, hf = (n >> 7) & 1, c = n & 127, k = pn >> 1, dir = pn & 1;
            const float v = (hf ? wx : wa)[(((size_t)dir * 8 + k) * 128 + kk) * 128 + c];
            WG[idx] = (bf16_t)f2bf(v);
        }
    }
}
DI void split8(f32x4 v0, f32x4 v1, bf16x8& hi, bf16x8& lo) {
    u32x4 hp; hp.x = pk2(v0[0], v0[1]); hp.y = pk2(v0[2], v0[3]); hp.z = pk2(v1[0], v1[1]); hp.w = pk2(v1[2], v1[3]);
    u32x4 lp; lp.x = pk2(v0[0] - __uint_as_float(hp.x << 16), v0[1] - __uint_as_float(hp.x & 0xffff0000u)); lp.y = pk2(v0[2] - __uint_as_float(hp.y << 16), v0[3] - __uint_as_float(hp.y & 0xffff0000u));
    lp.z = pk2(v1[0] - __uint_as_float(hp.z << 16), v1[1] - __uint_as_float(hp.z & 0xffff0000u)); lp.w = pk2(v1[2] - __uint_as_float(hp.w << 16), v1[3] - __uint_as_float(hp.w & 0xffff0000u));
    hi = __builtin_bit_cast(bf16x8, hp); lo = __builtin_bit_cast(bf16x8, lp);
}
DI void phase_kr(const Args& a) {
    const float* kp_I_DECAY = kin(I_DECAY); const float* kp_I_FW4 = kin(I_FW4); const float* kp_I_SKIP = kin(I_SKIP);
    const float* HDN = (const float*)(a.ws + WS_HDN);
    bf16_t* KRL = (bf16_t*)(a.ws + WS_KRL); bf16_t* KRC = (bf16_t*)(a.ws + WS_KRC);
    const int tid = otid(); const int lane = tid & 63, i = lane & 15, q = lane >> 4, gw = obid() * NWV + __builtin_amdgcn_readfirstlane(tid >> 6), NGW = gridDim.x * NWV;
    const unsigned voffb = (unsigned)(8 * q * 2048 + i) * 4u;
    for (int item = gw; item < 2 * 72 * 8; item += NGW) {
        const int part = item & 7, rest = item >> 3, e = rest / 72, xc = rest % 72, nsel = xc >= 64, n = nsel ? 256 : 2048, x0 = (nsel ? xc - 64 : xc) * 64;
        const int dir = (x0 >= n) ? 1 : 0; const bool lag0 = (x0 == n);
        const float invn = nsel ? (1.f / 255.f) : (1.f / 2047.f);
        const float* w4 = kp_I_FW4 + (size_t)e * 64 * 2048; const float* dec = kp_I_DECAY + e * 2048;
        bf16x8 ah[4][2], al[4][2];
#pragma unroll
        for (int mt = 0; mt < 4; ++mt) { const int x = x0 + mt * 16 + i, d = n - x, t = d < 0 ? -d : d; const bool valid = t < n;
            const float* hr = HDN + ((size_t)e * 2304 + (nsel ? 2048 : 0) + (valid ? t : 0)) * 64 + 8 * q;
#pragma unroll
            for (int ks = 0; ks < 2; ++ks) split8(*(const f32x4*)(hr + ks * 32), *(const f32x4*)(hr + ks * 32 + 4), ah[mt][ks], al[mt][ks]); }
#pragma unroll 1
        for (int half = 0; half < 2; ++half) {
            float wv[4][16];
#pragma unroll
            for (int nt = 0; nt < 4; ++nt) { const int oc0 = part * 128 + half * 64 + nt * 16, f0 = (oc0 >> 9) * 1024 + dir * 512 + (oc0 & 511);
#pragma unroll
                for (int k = 0; k < 16; ++k) wv[nt][k] = *(const float*)((const char*)(w4 + f0 + ((k >> 3) * 32 + (k & 7)) * 2048) + voffb); }
#pragma unroll
            for (int nt = 0; nt < 4; ++nt) { const int oc0 = part * 128 + half * 64 + nt * 16, ord = oc0 >> 9, c0 = oc0 & 511, f0 = ord * 1024 + dir * 512 + c0;
                bf16x8 bh[2], bl[2];
#pragma unroll
                for (int ks = 0; ks < 2; ++ks) split8((f32x4){wv[nt][ks * 8], wv[nt][ks * 8 + 1], wv[nt][ks * 8 + 2], wv[nt][ks * 8 + 3]}, (f32x4){wv[nt][ks * 8 + 4], wv[nt][ks * 8 + 5], wv[nt][ks * 8 + 6], wv[nt][ks * 8 + 7]}, bh[ks], bl[ks]);
                f32x4 acc[4];
#pragma unroll
                for (int mt = 0; mt < 4; ++mt) { acc[mt] = (f32x4){0.f, 0.f, 0.f, 0.f};
#pragma unroll
                    for (int ks = 0; ks < 2; ++ks) { acc[mt] = mfma16(ah[mt][ks], bh[ks], acc[mt]); acc[mt] = mfma16(ah[mt][ks], bl[ks], acc[mt]); acc[mt] = mfma16(al[mt][ks], bh[ks], acc[mt]); } }
                const float dv = fabsf(dec[f0 + i]); float s0 = 0.f;
                if (lag0) {
                    f32x4 a0 = {0.f, 0.f, 0.f, 0.f};
#pragma unroll
                    for (int ks = 0; ks < 2; ++ks) { float w0[8];
#pragma unroll
                        for (int r = 0; r < 8; ++r) w0[r] = *(const float*)((const char*)(w4 + ord * 1024 + c0 + (ks * 32 + r) * 2048) + voffb);
                        bf16x8 b0h, b0l; split8((f32x4){w0[0], w0[1], w0[2], w0[3]}, (f32x4){w0[4], w0[5], w0[6], w0[7]}, b0h, b0l);
                        a0 = mfma16(ah[0][ks], b0h, a0); a0 = mfma16(ah[0][ks], b0l, a0); a0 = mfma16(al[0][ks], b0h, a0); }
                    s0 = a0[0] + kp_I_SKIP[(e * 2 + ord) * 512 + c0 + i]; }
                bf16_t* dst = (nsel ? KRC + ((size_t)(e * 2 + ord) * 512 + c0 + i) * 512 : KRL + ((size_t)(e * 2 + ord) * 512 + c0 + i) * 4096) + x0 + 4 * q;
#pragma unroll
                for (int mt = 0; mt < 4; ++mt) { float val[4];
#pragma unroll
                    for (int r = 0; r < 4; ++r) { const int x = x0 + mt * 16 + 4 * q + r, d = n - x, t = d < 0 ? -d : d;
                        val[r] = acc[mt][r] * __expf(-((float)t * invn) * dv);
                        if (lag0 && mt == 0 && r == 0 && q == 0) val[r] += s0;
                        if (t >= n) val[r] = 0.f; }
                    u32x2 pk; pk.x = pk2(val[0], val[1]); pk.y = pk2(val[2], val[3]); *(u32x2*)(dst + mt * 16) = pk; }
            }
        }
    }
}
DI void phase_init(const Args& a) {
    const float* kp_I_CTX = kin(I_CTX); const float* kp_I_X = kin(I_X);
    bf16_t* XS = (bf16_t*)(a.ws + WS_XS);        bf16_t* AB = (bf16_t*)((unsigned char*)a.out + O_ABUF); const float* MOD = (const float*)(a.ws + WS_MOD);
    const int tid = otid(); const int lane = tid & 63, gw = obid() * NWV + (tid >> 6), NGW = gridDim.x * NWV;
    for (int row = gw; row < T; row += NGW) {
        const float* src = row < TL ? kp_I_X + (size_t)row * 1024 : kp_I_CTX + (size_t)(row - TL) * 1024;
        const int mrow = row < TL ? (row >> 11) : 16; const float* md = MOD + (size_t)mrow * 6144;
#pragma unroll
        for (int j = 0; j < 4; ++j) { const int col = 4 * lane + 256 * j; const f32x4 v = *(const f32x4*)(src + col);
            const f32x4 sh = *(const f32x4*)(md + col), sc = *(const f32x4*)(md + 1024 + col);
            store_bf4(AB + (size_t)row * 1024 + col, v * (sc + 1.f) + sh); }
    }
}

DI void phase_uc(const Args& a, int e, LAS unsigned char* lds) {
    const float* kp_I_HYSB = kin(I_HYSB); const float* kp_I_HYSW = kin(I_HYSW);
    const bf16_t* PH = (const bf16_t*)(a.ws + WS_BIG + B_PH); bf16_t* UC = (bf16_t*)(a.ws + WS_BIG + B_UC);
    LAS float* buf = (LAS float*)lds;
    const float* sw = kp_I_HYSW + (size_t)e * 3 * 1536; const float* sb = kp_I_HYSB + (size_t)e * 1536;
    const int tid = otid();
    u32x4 pv[3];
#define UC_LOAD(tile_) do { const int tt_ = (tile_) / 24, cb_ = (tile_) % 24, tok0_ = tt_ * 128; int s0_, s1_; \
        if (tok0_ < TL) { s0_ = tok0_ & ~(SEQ - 1); s1_ = s0_ + SEQ; } else { s0_ = TL + ((tok0_ - TL) & ~(CTXL - 1)); s1_ = s0_ + CTXL; } \
        _Pragma("unroll") for (int k_ = 0; k_ < 3; ++k_) { const int i_ = tid + k_ * NTH; pv[k_] = (u32x4){0u, 0u, 0u, 0u}; \
            if (i_ < 130 * 8) { const int rr_ = i_ >> 3, c8_ = i_ & 7, tok_ = tok0_ - 1 + rr_; if (tok_ >= s0_ && tok_ < s1_) pv[k_] = *(const u32x4*)(PH + (size_t)tok_ * 1536 + cb_ * 64 + c8_ * 8); } } } while (0)
    int tile = obid();
    if (tile < 288 * 24) UC_LOAD(tile);
    for (; tile < 288 * 24; tile += gridDim.x) {
        const int tt = tile / 24, cb = tile % 24, tok0 = tt * 128;
#pragma unroll
        for (int k = 0; k < 3; ++k) { const int i = tid + k * NTH; if (i < 130 * 8) { const int rr = i >> 3, c8 = i & 7; const u32x4 v = pv[k];
            LAS float* d = buf + rr * 97 + c8 * 8 + 2 * (rr >> 3);
            d[0] = __uint_as_float(v.x << 16); d[1] = __uint_as_float(v.x & 0xffff0000u); d[2] = __uint_as_float(v.y << 16); d[3] = __uint_as_float(v.y & 0xffff0000u);
            d[4] = __uint_as_float(v.z << 16); d[5] = __uint_as_float(v.z & 0xffff0000u); d[6] = __uint_as_float(v.w << 16); d[7] = __uint_as_float(v.w & 0xffff0000u); } }
        __syncthreads();
        if (tile + (int)gridDim.x < 288 * 24) UC_LOAD(tile + (int)gridDim.x);
        for (int i = tid; i < 64 * 16; i += NTH) { const int c = i >> 4, ch = i & 15, cg = cb * 64 + c;
            const float w0 = sw[cg], w1 = sw[1536 + cg], w2 = sw[3072 + cg], bb = sb[cg]; float o[8];
#pragma unroll
            for (int j = 0; j < 8; ++j) { const int t = ch * 8 + j; o[j] = w0 * buf[t * 97 + c + 2 * (ch + (j >> 3))] + w1 * buf[(t + 1) * 97 + c + 2 * (ch + ((j + 1) >> 3))] + w2 * buf[(t + 2) * 97 + c + 2 * (ch + ((j + 2) >> 3))] + bb; }
            u32x4 w; w.x = pk2(o[0], o[1]); w.y = pk2(o[2], o[3]); w.z = pk2(o[4], o[5]); w.w = pk2(o[6], o[7]);
            *(u32x4*)(UC + (size_t)cg * T + tok0 + ch * 8) = w; }
        __syncthreads();
    }
#undef UC_LOAD
}
template <class F> DI void hy_conv_naive(const LAS bf16_t* U, const LAS bf16_t* KR, int n, const F& out) {
    const int tid = otid(); const int nt4 = n >> 2;
    for (int task = tid; task < 16 * nt4; task += NTH) {
        const int b = task / nt4, t0 = (task % nt4) * 4;
        const LAS bf16_t* ub = U + b * n; float y0 = 0.f, y1 = 0.f, y2 = 0.f, y3 = 0.f;
        int base = n - t0;
        float w1 = base - 1 >= 0 ? bf2f(KR[base - 1]) : 0.f, w2 = base - 2 >= 0 ? bf2f(KR[base - 2]) : 0.f, w3 = base - 3 >= 0 ? bf2f(KR[base - 3]) : 0.f;
        for (int s = 0; s < n; ++s) { const float w0 = bf2f(KR[base + s]); const float uv = bf2f(ub[s]);
            y0 += w0 * uv; y1 += w1 * uv; y2 += w2 * uv; y3 += w3 * uv; w3 = w2; w2 = w1; w1 = w0; }
        out(b, t0, y0, y1, y2, y3);
    }
}
struct HyOutZ { LAS bf16_t* Z; const bf16_t* x1; int n; int tokbase; int tstride;
    DI void operator()(int b, int t0, float y0, float y1, float y2, float y3) const { const u32x2 xv = *(const u32x2*)(x1 + tokbase + b * tstride + t0);
        const float a0 = __uint_as_float(xv.x << 16), a1 = __uint_as_float(xv.x & 0xffff0000u), a2 = __uint_as_float(xv.y << 16), a3 = __uint_as_float(xv.y & 0xffff0000u);
        u32x2 w; w.x = pk2(a0 * y0, a1 * y1); w.y = pk2(a2 * y2, a3 * y3); *(LAS u32x2*)(Z + b * n + t0) = w; } };
struct HyOutY { bf16_t* yh; const bf16_t* x2; int tokbase; int tstride;
    DI void operator()(int b, int t0, float y0, float y1, float y2, float y3) const { const u32x2 xv = *(const u32x2*)(x2 + tokbase + b * tstride + t0);
        const float a0 = __uint_as_float(xv.x << 16), a1 = __uint_as_float(xv.x & 0xffff0000u), a2 = __uint_as_float(xv.y << 16), a3 = __uint_as_float(xv.y & 0xffff0000u);
        u32x2 w; w.x = pk2(a0 * y0, a1 * y1); w.y = pk2(a2 * y2, a3 * y3); *(u32x2*)(yh + tokbase + b * tstride + t0) = w; } };
DI void hyena_unit_naive(const Args& a, int e, int c, int nsel, LAS unsigned char* lds) {
    const int n = nsel ? CTXL : SEQ, tokbase = nsel ? TL : 0, tid = otid();
    const bf16_t* UC = (const bf16_t*)(a.ws + WS_BIG + B_UC); bf16_t* YH = (bf16_t*)(a.ws + WS_BIG + B_YH);
    const bf16_t* kr0 = nsel ? (const bf16_t*)(a.ws + WS_KRC) + ((size_t)(e * 2 + 0) * 512 + c) * 512 : (const bf16_t*)(a.ws + WS_KRL) + ((size_t)(e * 2 + 0) * 512 + c) * 4096;
    const bf16_t* kr1 = nsel ? (const bf16_t*)(a.ws + WS_KRC) + ((size_t)(e * 2 + 1) * 512 + c) * 512 : (const bf16_t*)(a.ws + WS_KRL) + ((size_t)(e * 2 + 1) * 512 + c) * 4096;
    LAS bf16_t* U = (LAS bf16_t*)lds; LAS bf16_t* Z = U + 16 * SEQ; LAS bf16_t* KR = Z + 16 * SEQ;
    const bf16_t* vrow = UC + (size_t)c * T + tokbase;
    for (int i = tid; i < 16 * n / 8; i += NTH) { const int el = i * 8; *(LAS u32x4*)(U + el) = *(const u32x4*)(vrow + el); }
    for (int i = tid; i < 2 * n / 8; i += NTH) *(LAS u32x4*)(KR + i * 8) = *(const u32x4*)(kr0 + i * 8);
    __syncthreads();
    { HyOutZ o{Z, UC + (size_t)(512 + c) * T, n, tokbase, n}; hy_conv_naive(U, KR, n, o); }
    __syncthreads();
    for (int i = tid; i < 2 * n / 8; i += NTH) *(LAS u32x4*)(KR + i * 8) = *(const u32x4*)(kr1 + i * 8);
    __syncthreads();
    { HyOutY o{YH + (size_t)c * T, UC + (size_t)(1024 + c) * T, tokbase, n}; hy_conv_naive(Z, KR, n, o); }
    __syncthreads();
}
constexpr int HY_RS = 4112, HY_CS = 8208;
DI void hy_build_kc(const bf16_t* kr, int n, LAS unsigned char* KC, int tid) {
    for (int x8 = tid; x8 < 2 * n / 8; x8 += NTH) {
        const u32x4 lo = *(const u32x4*)(kr + x8 * 8); u32x4 hi = {0u, 0u, 0u, 0u}; if (x8 + 1 < 2 * n / 8) hi = *(const u32x4*)(kr + x8 * 8 + 8);
        const unsigned w[9] = {lo.x, lo.y, lo.z, lo.w, hi.x, hi.y, hi.z, hi.w, 0u};
#pragma unroll
        for (int r = 0; r < 8; ++r) { u32x4 o; const int k = r >> 1;
            if ((r & 1) == 0) { o.x = w[k]; o.y = w[k + 1]; o.z = w[k + 2]; o.w = w[k + 3]; }
            else { o.x = __builtin_amdgcn_alignbit(w[k + 1], w[k], 16); o.y = __builtin_amdgcn_alignbit(w[k + 2], w[k + 1], 16); o.z = __builtin_amdgcn_alignbit(w[k + 3], w[k + 2], 16); o.w = __builtin_amdgcn_alignbit(w[k + 4], w[k + 3], 16); }
            *(LAS u32x4*)(KC + r * HY_CS + x8 * 16) = o; }
    }
}
template <int NTW> DI void hy_conv_mfma(const LAS unsigned char* Ub, const LAS unsigned char* KC, int wave, int lane, f32x4 (&acc)[NTW]) {
    constexpr int n = NTW * 128;
    const int i = lane & 15, q = lane >> 4, r = (8 - (i & 7)) & 7, t0w = wave * NTW * 16;
    const LAS unsigned char* ap = KC + r * HY_CS + 2 * (8 * q - t0w - 16 * (NTW - 1) - i + n - r);
    const LAS unsigned char* bp = Ub + i * HY_RS + 16 * q;
#pragma unroll
    for (int k = 0; k < NTW; ++k) acc[k] = (f32x4){0.f, 0.f, 0.f, 0.f};
    if constexpr (NTW == 16) {
        bf16x8 R[16];
#pragma unroll
        for (int k = 0; k < 16; ++k) R[k] = *(const LAS bf16x8*)(ap + 32 * (15 - k));
        for (int s8 = 0; s8 < n / 32; s8 += 8) {
#pragma unroll
            for (int ss = 0; ss < 8; ++ss) { const int s = s8 + ss;
                const bf16x8 bf = *(const LAS bf16x8*)(bp + 64 * s);
                bf16x8 n0, n1; const bool more = (s + 1 < n / 32);
                if (more) { n0 = *(const LAS bf16x8*)(ap + 64 * (s + 1) + 32 * 15); n1 = *(const LAS bf16x8*)(ap + 64 * (s + 1) + 32 * 14); }
#pragma unroll
                for (int k = 0; k < 16; ++k) acc[k] = mfma16(R[(k - 2 * ss) & 15], bf, acc[k]);
                if (more) { R[(0 - 2 * (ss + 1)) & 15] = n0; R[(1 - 2 * (ss + 1)) & 15] = n1; } }
        }
    } else {
#pragma unroll 2
        for (int s0c = 0; s0c < n / 32; ++s0c) {
            const bf16x8 bf = *(const LAS bf16x8*)(bp + 64 * s0c);
#pragma unroll
            for (int k = 0; k < NTW; ++k) { const bf16x8 af = *(const LAS bf16x8*)(ap + 64 * s0c + 32 * (NTW - 1 - k)); acc[k] = mfma16(af, bf, acc[k]); }
        }
    }
}
template <int NTW> DI void hyena_unit_fast(const Args& a, int e, int c, LAS unsigned char* lds) {
    constexpr int n = NTW * 128; constexpr int nsel = (n == CTXL) ? 1 : 0; constexpr int tokbase = nsel ? TL : 0;
    const int tid = otid(), wave = tid >> 6, lane = tid & 63, b = lane & 15, q = lane >> 4;
    const bf16_t* UC = (const bf16_t*)(a.ws + WS_BIG + B_UC); bf16_t* YH = (bf16_t*)(a.ws + WS_BIG + B_YH);
    const bf16_t* kr0 = nsel ? (const bf16_t*)(a.ws + WS_KRC) + ((size_t)(e * 2 + 0) * 512 + c) * 512 : (const bf16_t*)(a.ws + WS_KRL) + ((size_t)(e * 2 + 0) * 512 + c) * 4096;
    const bf16_t* kr1 = nsel ? (const bf16_t*)(a.ws + WS_KRC) + ((size_t)(e * 2 + 1) * 512 + c) * 512 : (const bf16_t*)(a.ws + WS_KRL) + ((size_t)(e * 2 + 1) * 512 + c) * 4096;
    LAS unsigned char* Ub = lds; LAS unsigned char* KC = lds + 16 * HY_RS;
    const bf16_t* vrow = UC + (size_t)c * T + tokbase; const bf16_t* x1row = UC + (size_t)(512 + c) * T + tokbase; const bf16_t* x2row = UC + (size_t)(1024 + c) * T + tokbase;
    bf16_t* yrow = YH + (size_t)c * T + tokbase;
    for (int idx = tid; idx < 16 * n / 8; idx += NTH) { const int bb = idx / (n / 8), ch = idx % (n / 8); *(LAS u32x4*)(Ub + bb * HY_RS + ch * 16) = *(const u32x4*)(vrow + bb * n + ch * 8); }
    hy_build_kc(kr0, n, KC, tid);
    __syncthreads();
    f32x4 acc[NTW]; u32x2 zp[NTW];
    hy_conv_mfma<NTW>(Ub, KC, wave, lane, acc);
#pragma unroll
    for (int k = 0; k < NTW; ++k) { const int t = wave * NTW * 16 + 16 * k + 4 * q; const u32x2 xv = *(const u32x2*)(x1row + b * n + t);
        zp[k].x = pk2(__uint_as_float(xv.x << 16) * acc[k][0], __uint_as_float(xv.x & 0xffff0000u) * acc[k][1]); zp[k].y = pk2(__uint_as_float(xv.y << 16) * acc[k][2], __uint_as_float(xv.y & 0xffff0000u) * acc[k][3]); }
    __syncthreads();
#pragma unroll
    for (int k = 0; k < NTW; ++k) { const int t = wave * NTW * 16 + 16 * k + 4 * q; *(LAS u32x2*)(Ub + b * HY_RS + t * 2) = zp[k]; }
    hy_build_kc(kr1, n, KC, tid);
    __syncthreads();
    hy_conv_mfma<NTW>(Ub, KC, wave, lane, acc);
#pragma unroll
    for (int k = 0; k < NTW; ++k) { const int t = wave * NTW * 16 + 16 * k + 4 * q; const u32x2 xv = *(const u32x2*)(x2row + b * n + t);
        zp[k].x = pk2(__uint_as_float(xv.x << 16) * acc[k][0], __uint_as_float(xv.x & 0xffff0000u) * acc[k][1]); zp[k].y = pk2(__uint_as_float(xv.y << 16) * acc[k][2], __uint_as_float(xv.y & 0xffff0000u) * acc[k][3]); }
    __syncthreads();
#pragma unroll
    for (int k = 0; k < NTW; ++k) { const int t = wave * NTW * 16 + 16 * k + 4 * q; *(LAS u32x2*)(Ub + b * HY_RS + t * 2) = zp[k]; }
    __syncthreads();
    for (int idx = tid; idx < 16 * n / 8; idx += NTH) { const int bb = idx / (n / 8), ch = idx % (n / 8); *(u32x4*)(yrow + bb * n + ch * 8) = *(const LAS u32x4*)(Ub + bb * HY_RS + ch * 16); }
    __syncthreads();
}
DI void attn_unit_naive(const Args& a, int l, int isctx, int b, int h, int qb, LAS unsigned char* lds) {
    const float* kp_I_LK1 = kin(I_LK1); const float* kp_I_LK2 = kin(I_LK2); const float* kp_I_LQ1 = kin(I_LQ1); const float* kp_I_LQ2 = kin(I_LQ2); const float* kp_I_SUBG = kin(I_SUBG);
    const bf16_t* QB = (const bf16_t*)(a.ws + WS_BIG + B_QB); const bf16_t* KB = (const bf16_t*)(a.ws + WS_BIG + B_KB); const bf16_t* VB = (const bf16_t*)(a.ws + WS_BIG + B_VB);
    bf16_t* MIXA = (bf16_t*)(a.ws + WS_BIG + B_MIXA_E);
    LAS bf16_t* Ks = (LAS bf16_t*)lds; LAS bf16_t* Vs = Ks + 64 * 128; LAS float* ex = (LAS float*)(lds + 32768); LAS float* ssq = ex + 64 * 128;
    const int tid = otid(), r = tid & 63, s = (tid >> 6) & 1, qt = tid >> 7, e = l >> 1;
    const int qrow = isctx ? TL + b * CTXL + qb * 64 + r : b * SEQ + qb * 64 + r;
    float q[64], o[32];
    { const bf16_t* qp = QB + (size_t)qrow * 512 + h * 128 + s * 64;
#pragma unroll
      for (int d8 = 0; d8 < 8; ++d8) { const u32x4 v = *(const u32x4*)(qp + d8 * 8);
          q[d8 * 8 + 0] = __uint_as_float(v.x << 16); q[d8 * 8 + 1] = __uint_as_float(v.x & 0xffff0000u); q[d8 * 8 + 2] = __uint_as_float(v.y << 16); q[d8 * 8 + 3] = __uint_as_float(v.y & 0xffff0000u);
          q[d8 * 8 + 4] = __uint_as_float(v.z << 16); q[d8 * 8 + 5] = __uint_as_float(v.z & 0xffff0000u); q[d8 * 8 + 6] = __uint_as_float(v.w << 16); q[d8 * 8 + 7] = __uint_as_float(v.w & 0xffff0000u); } }
#pragma unroll
    for (int i = 0; i < 32; ++i) o[i] = 0.f;
    float m = -INFINITY, lsum = 0.f;
    const int ntiles = isctx ? 4 : 36;
    for (int kt = 0; kt < ntiles; ++kt) {
        const int krow0 = (kt < 4) ? TL + b * CTXL + kt * 64 : b * SEQ + (kt - 4) * 64;
        __syncthreads();
        for (int i = tid; i < 1024; i += NTH) { const int key = i >> 4, ch = i & 15;
            *(LAS u32x4*)(Ks + key * 128 + ch * 8) = *(const u32x4*)(KB + (size_t)(krow0 + key) * 512 + h * 128 + ch * 8);
            *(LAS u32x4*)(Vs + key * 128 + ch * 8) = *(const u32x4*)(VB + (size_t)(krow0 + key) * 512 + h * 128 + ch * 8); }
        __syncthreads();
        for (int kg = 0; kg < 64; kg += 4) {
            float sc[4];
#pragma unroll
            for (int kk = 0; kk < 4; ++kk) { const LAS bf16_t* kp = Ks + (kg + kk) * 128 + s * 64; float acc = 0.f;
#pragma unroll
                for (int d8 = 0; d8 < 8; ++d8) { const u32x4 v = *(const LAS u32x4*)(kp + d8 * 8);
                    acc += q[d8 * 8 + 0] * __uint_as_float(v.x << 16) + q[d8 * 8 + 1] * __uint_as_float(v.x & 0xffff0000u) + q[d8 * 8 + 2] * __uint_as_float(v.y << 16) + q[d8 * 8 + 3] * __uint_as_float(v.y & 0xffff0000u)
                         + q[d8 * 8 + 4] * __uint_as_float(v.z << 16) + q[d8 * 8 + 5] * __uint_as_float(v.z & 0xffff0000u) + q[d8 * 8 + 6] * __uint_as_float(v.w << 16) + q[d8 * 8 + 7] * __uint_as_float(v.w & 0xffff0000u); }
                sc[kk] = acc; }
            const float mx = fmaxf(fmaxf(sc[0], sc[1]), fmaxf(sc[2], sc[3]));
            const float mn = fmaxf(m, mx); const float corr = exp2f(m - mn); m = mn; lsum *= corr;
#pragma unroll
            for (int i = 0; i < 32; ++i) o[i] *= corr;
#pragma unroll
            for (int kk = 0; kk < 4; ++kk) { const float p = exp2f(sc[kk] - mn); lsum += p; const LAS bf16_t* vp = Vs + (kg + kk) * 128 + qt * 32;
#pragma unroll
                for (int d8 = 0; d8 < 4; ++d8) { const u32x4 v = *(const LAS u32x4*)(vp + d8 * 8);
                    o[d8 * 8 + 0] += p * __uint_as_float(v.x << 16); o[d8 * 8 + 1] += p * __uint_as_float(v.x & 0xffff0000u); o[d8 * 8 + 2] += p * __uint_as_float(v.y << 16); o[d8 * 8 + 3] += p * __uint_as_float(v.y & 0xffff0000u);
                    o[d8 * 8 + 4] += p * __uint_as_float(v.z << 16); o[d8 * 8 + 5] += p * __uint_as_float(v.z & 0xffff0000u); o[d8 * 8 + 6] += p * __uint_as_float(v.w << 16); o[d8 * 8 + 7] += p * __uint_as_float(v.w & 0xffff0000u); } }
        }
    }
    const float inv = 1.f / lsum;
    float d1 = 0.f, d2 = 0.f;
    for (int i = 0; i < 64; ++i) { d1 += kp_I_LQ1[e * 64 + i] * kp_I_LK1[e * 64 + i]; d2 += kp_I_LQ2[e * 64 + i] * kp_I_LK2[e * 64 + i]; }
    const float lam_init = 0.8f - 0.6f * expf(-0.3f * (float)l);
    const float lam = expf(d1) - expf(d2) + lam_init;
    __syncthreads();
    if (s == 1) {
#pragma unroll
        for (int i = 0; i < 32; ++i) ex[r * 128 + qt * 32 + i] = o[i] * inv; }
    __syncthreads();
    if (s == 0) { float ss = 0.f;
#pragma unroll
        for (int i = 0; i < 32; ++i) { o[i] = o[i] * inv - lam * ex[r * 128 + qt * 32 + i]; ss += o[i] * o[i]; }
        ssq[r * 4 + qt] = ss; }
    __syncthreads();
    if (s == 0) { const float tot = (ssq[r * 4] + ssq[r * 4 + 1]) + (ssq[r * 4 + 2] + ssq[r * 4 + 3]); const float rs = rsqrtf(tot * (1.f / 128.f) + LN_EPS) * (1.f - lam_init);
        const float* g = kp_I_SUBG + e * 128 + qt * 32; bf16_t* dst = MIXA + (size_t)qrow * 1024 + 512 + h * 128 + qt * 32;
#pragma unroll
        for (int i = 0; i < 32; i += 4) { f32x4 v = {o[i] * rs * g[i], o[i + 1] * rs * g[i + 1], o[i + 2] * rs * g[i + 2], o[i + 3] * rs * g[i + 3]}; store_bf4(dst + i, v); } }
    __syncthreads();
}
typedef float f32x16 __attribute__((ext_vector_type(16)));
typedef short s16x4 __attribute__((ext_vector_type(4)));
constexpr int AT_KS = 272, AT_VS = 288, AT_KB = 64 * AT_KS, AT_VB = 64 * AT_VS;
constexpr int AT_EX = 2 * AT_KB + 2 * AT_VB;
DI f32x16 mfma32(bf16x8 a, bf16x8 b, f32x16 c) { return __builtin_amdgcn_mfma_f32_32x32x16_bf16(a, b, c, 0, 0, 0); }
DI s16x4 tr_read(const LAS unsigned char* p) { return __builtin_bit_cast(s16x4, __builtin_amdgcn_ds_read_tr16_b64_v4i16((LAS s16x4*)p)); }
DI void attn_unit_fast(const Args& a, int l, int isctx, int b, int hd, int qb, LAS unsigned char* lds) {
    const float* kp_I_LK1 = kin(I_LK1); const float* kp_I_LK2 = kin(I_LK2); const float* kp_I_LQ1 = kin(I_LQ1); const float* kp_I_LQ2 = kin(I_LQ2); const float* kp_I_SUBG = kin(I_SUBG);
    const bf16_t* QB = (const bf16_t*)(a.ws + WS_BIG + B_QB); const bf16_t* KB = (const bf16_t*)(a.ws + WS_BIG + B_KB); const bf16_t* VB = (const bf16_t*)(a.ws + WS_BIG + B_VB);
    bf16_t* MIXA = (bf16_t*)(a.ws + WS_BIG + B_MIXA_E);
    const int tid = otid(), wave = tid >> 6, lane = tid & 63, s = wave >> 2, r32 = lane & 31, hi = lane >> 5, e = l >> 1;
    const int qrow0 = isctx ? TL + b * CTXL + qb * 128 : b * SEQ + qb * 128;
    const int qrow = qrow0 + 32 * (wave & 3) + r32;
    bf16x8 qf[4];
#pragma unroll
    for (int d0 = 0; d0 < 4; ++d0) qf[d0] = *(const bf16x8*)(QB + (size_t)qrow * 512 + hd * 128 + s * 64 + 16 * d0 + 8 * hi);
    f32x16 O[4];
#pragma unroll
    for (int eb = 0; eb < 4; ++eb)
#pragma unroll
        for (int r = 0; r < 16; ++r) O[eb][r] = 0.f;
    float m = -INFINITY, lsum = 0.f;
    const int ntiles = isctx ? 4 : 36;
    u32x4 preK[2], preV[2];
    const int ck = tid >> 4, cc = tid & 15;
#define AT_ROW0(kt_) (((kt_) < 4) ? TL + b * CTXL + (kt_) * 64 : b * SEQ + ((kt_) - 4) * 64)
#define AT_LOADK(kt_) do { const int kr0_ = AT_ROW0(kt_); preK[0] = *(const u32x4*)(KB + (size_t)(kr0_ + ck) * 512 + hd * 128 + cc * 8); preK[1] = *(const u32x4*)(KB + (size_t)(kr0_ + ck + 32) * 512 + hd * 128 + cc * 8); } while (0)
#define AT_LOADV(kt_) do { const int kr0_ = AT_ROW0(kt_); preV[0] = *(const u32x4*)(VB + (size_t)(kr0_ + ck) * 512 + hd * 128 + cc * 8); preV[1] = *(const u32x4*)(VB + (size_t)(kr0_ + ck + 32) * 512 + hd * 128 + cc * 8); } while (0)
#define AT_STOREK(buf_) do { *(LAS u32x4*)(lds + (buf_) * AT_KB + ck * AT_KS + cc * 16) = preK[0]; *(LAS u32x4*)(lds + (buf_) * AT_KB + (ck + 32) * AT_KS + cc * 16) = preK[1]; } while (0)
#define AT_STOREV(buf_) do { *(LAS u32x4*)(lds + 2 * AT_KB + (buf_) * AT_VB + ck * AT_VS + cc * 16) = preV[0]; *(LAS u32x4*)(lds + 2 * AT_KB + (buf_) * AT_VB + (ck + 32) * AT_VS + cc * 16) = preV[1]; } while (0)
#define AT_QK(P0_, P1_, buf_) do { const LAS unsigned char* Kt_ = lds + (buf_) * AT_KB + koff; \
        _Pragma("unroll") for (int r = 0; r < 16; ++r) { P0_[r] = 0.f; P1_[r] = 0.f; } \
        bf16x8 kf_[8]; _Pragma("unroll") for (int d0 = 0; d0 < 4; ++d0) { kf_[2 * d0] = *(const LAS bf16x8*)(Kt_ + d0 * 32); kf_[2 * d0 + 1] = *(const LAS bf16x8*)(Kt_ + 32 * AT_KS + d0 * 32); } \
        __builtin_amdgcn_sched_barrier(0); \
        _Pragma("unroll") for (int d0 = 0; d0 < 4; ++d0) { P0_ = mfma32(kf_[2 * d0], qf[d0], P0_); P1_ = mfma32(kf_[2 * d0 + 1], qf[d0], P1_); } } while (0)
    const int i16 = lane & 15, qq = i16 >> 2, p4 = i16 & 3, blk16 = (lane >> 4) & 1;
    const int koff = r32 * AT_KS + s * 128 + hi * 16;
    const int voff = (4 * hi + qq) * AT_VS + (16 * blk16 + 4 * p4) * 2;
    AT_LOADK(0); AT_LOADV(0); AT_STOREK(0); AT_STOREV(0);
    AT_LOADK(1); AT_STOREK(1);
    __syncthreads();
    f32x16 P0, P1, N0, N1;
    AT_QK(P0, P1, 0);
    for (int kt = 0; kt < ntiles; ++kt) {
        const int buf = kt & 1;
        if (kt + 2 < ntiles) AT_LOADK(kt + 2);
        if (kt + 1 < ntiles) { AT_LOADV(kt + 1); AT_QK(N0, N1, buf ^ 1); }
        const LAS unsigned char* Vt = lds + 2 * AT_KB + buf * AT_VB + voff;
        float mx = fmaxf(P0[0], P1[0]);
#pragma unroll
        for (int r = 1; r < 16; ++r) mx = fmaxf(mx, fmaxf(P0[r], P1[r]));
        mx = xor32_max(mx);
        if (__any(mx > m + 6.f)) { const float mn = fmaxf(m, mx); const float corr = __builtin_amdgcn_exp2f(m - mn); m = mn; lsum *= corr;
#pragma unroll
            for (int eb = 0; eb < 4; ++eb) O[eb] = O[eb] * corr; }
        float ps = 0.f;
#pragma unroll
        for (int r = 0; r < 16; ++r) { P0[r] = __builtin_amdgcn_exp2f(P0[r] - m); P1[r] = __builtin_amdgcn_exp2f(P1[r] - m); ps += P0[r] + P1[r]; }
        lsum += ps;
        bf16x8 pa[4];
#pragma unroll
        for (int s2 = 0; s2 < 2; ++s2) { u32x4 w0, w1;
            w0.x = pk2(P0[8 * s2 + 0], P0[8 * s2 + 1]); w0.y = pk2(P0[8 * s2 + 2], P0[8 * s2 + 3]); w0.z = pk2(P0[8 * s2 + 4], P0[8 * s2 + 5]); w0.w = pk2(P0[8 * s2 + 6], P0[8 * s2 + 7]);
            w1.x = pk2(P1[8 * s2 + 0], P1[8 * s2 + 1]); w1.y = pk2(P1[8 * s2 + 2], P1[8 * s2 + 3]); w1.z = pk2(P1[8 * s2 + 4], P1[8 * s2 + 5]); w1.w = pk2(P1[8 * s2 + 6], P1[8 * s2 + 7]);
            pa[s2] = __builtin_bit_cast(bf16x8, w0); pa[2 + s2] = __builtin_bit_cast(bf16x8, w1); }
        { s16x4 vl[2][4], vh[2][4];
#pragma unroll
          for (int ks = 0; ks < 4; ++ks) { vl[0][ks] = tr_read(Vt + ks * 16 * AT_VS); vh[0][ks] = tr_read(Vt + ks * 16 * AT_VS + 8 * AT_VS); }
#pragma unroll
          for (int eb = 0; eb < 4; ++eb) {
              if (eb < 3) {
#pragma unroll
                  for (int ks = 0; ks < 4; ++ks) { vl[(eb + 1) & 1][ks] = tr_read(Vt + ks * 16 * AT_VS + (eb + 1) * 64); vh[(eb + 1) & 1][ks] = tr_read(Vt + ks * 16 * AT_VS + (eb + 1) * 64 + 8 * AT_VS); } }
              __builtin_amdgcn_sched_barrier(0);
#pragma unroll
              for (int ks = 0; ks < 4; ++ks) { const bf16x8 vf = __builtin_shufflevector(vl[eb & 1][ks], vh[eb & 1][ks], 0, 1, 2, 3, 4, 5, 6, 7); O[eb] = mfma32(vf, pa[ks], O[eb]); }
              __builtin_amdgcn_sched_barrier(0); } }
        if (kt + 2 < ntiles) AT_STOREK(buf);
        if (kt + 1 < ntiles) AT_STOREV(buf ^ 1);
        __syncthreads();
        P0 = N0; P1 = N1;
    }
#undef AT_ROW0
#undef AT_LOADK
#undef AT_LOADV
#undef AT_STOREK
#undef AT_STOREV
#undef AT_QK
    const float ltot = xor32_sum(lsum); const float inv = 1.f / ltot;
    float d1 = 0.f, d2 = 0.f;
    for (int i = 0; i < 64; ++i) { d1 += kp_I_LQ1[e * 64 + i] * kp_I_LK1[e * 64 + i]; d2 += kp_I_LQ2[e * 64 + i] * kp_I_LK2[e * 64 + i]; }
    const float lam_init = 0.8f - 0.6f * expf(-0.3f * (float)l);
    const float lam = expf(d1) - expf(d2) + lam_init;
    LAS float* ex = (LAS float*)(lds + AT_EX); const int lrow = 32 * (wave & 3) + r32;
    if (s == 1) {
#pragma unroll
        for (int eb = 0; eb < 4; ++eb)
#pragma unroll
            for (int r = 0; r < 16; ++r) ex[lrow * 129 + eb * 32 + (r & 3) + 8 * (r >> 2) + 4 * hi] = O[eb][r] * inv; }
    __syncthreads();
    if (s == 0) { float ss = 0.f;
#pragma unroll
        for (int eb = 0; eb < 4; ++eb)
#pragma unroll
            for (int r = 0; r < 16; ++r) { const float dv = O[eb][r] * inv - lam * ex[lrow * 129 + eb * 32 + (r & 3) + 8 * (r >> 2) + 4 * hi]; O[eb][r] = dv; ss += dv * dv; }
        ss = xor32_sum(ss);
        const float rs = rsqrtf(ss * (1.f / 128.f) + LN_EPS) * (1.f - lam_init); const float* g = kp_I_SUBG + e * 128;
        LAS bf16_t* st = (LAS bf16_t*)lds;
#pragma unroll
        for (int eb = 0; eb < 4; ++eb)
#pragma unroll
            for (int r4 = 0; r4 < 4; ++r4) { const int e0 = eb * 32 + 8 * r4 + 4 * hi; u32x2 w;
                w.x = pk2(O[eb][4 * r4] * rs * g[e0], O[eb][4 * r4 + 1] * rs * g[e0 + 1]); w.y = pk2(O[eb][4 * r4 + 2] * rs * g[e0 + 2], O[eb][4 * r4 + 3] * rs * g[e0 + 3]);
                *(LAS u32x2*)(st + lrow * 136 + e0) = w; } }
    __syncthreads();
    { const LAS bf16_t* st = (const LAS bf16_t*)lds;
      for (int i = tid; i < 128 * 16; i += NTH) { const int row = i >> 4, ch = i & 15; *(u32x4*)(MIXA + (size_t)(qrow0 + row) * 1024 + 512 + hd * 128 + ch * 8) = *(const LAS u32x4*)(st + row * 136 + ch * 8); } }
    __syncthreads();
}
DI void phase_yh_t(const Args& a, LAS unsigned char* lds, int vbx, int vG) {
    const bf16_t* YH = (const bf16_t*)(a.ws + WS_BIG + B_YH); bf16_t* MIXA = (bf16_t*)(a.ws + WS_BIG + B_MIXA_E);
    LAS bf16_t* buf = (LAS bf16_t*)lds;
    const int tid = otid();
    u32x4 pv[2];
#define YT_LOAD(tile_) do { const int tt_ = (tile_) >> 3, cb_ = (tile_) & 7; _Pragma("unroll") for (int k_ = 0; k_ < 2; ++k_) { const int i_ = tid + k_ * NTH, c_ = i_ >> 4, ch_ = i_ & 15; \
        pv[k_] = *(const u32x4*)(YH + (size_t)(cb_ * 64 + c_) * T + tt_ * 128 + ch_ * 8); } } while (0)
    int tile = vbx;
    if (tile < 288 * 8) YT_LOAD(tile);
    for (; tile < 288 * 8; tile += vG) {
        const int tt = tile >> 3, cb = tile & 7, tok0 = tt * 128;
#pragma unroll
        for (int k = 0; k < 2; ++k) { const int i = tid + k * NTH, c = i >> 4, ch = i & 15; *(LAS u32x4*)(buf + c * 136 + ch * 8) = pv[k]; }
        __syncthreads();
        if (tile + vG < 288 * 8) YT_LOAD(tile + vG);
        for (int i = tid; i < 128 * 8; i += NTH) { const int tk = i >> 3, c8 = i & 7; unsigned short v[8];
#pragma unroll
            for (int j = 0; j < 8; ++j) v[j] = buf[(c8 * 8 + j) * 136 + tk];
            u32x4 w; w.x = v[0] | ((unsigned)v[1] << 16); w.y = v[2] | ((unsigned)v[3] << 16); w.z = v[4] | ((unsigned)v[5] << 16); w.w = v[6] | ((unsigned)v[7] << 16);
            *(u32x4*)(MIXA + (size_t)(tok0 + tk) * 1024 + cb * 64 + c8 * 8) = w; }
        __syncthreads();
    }
#undef YT_LOAD
}

DI void phase_rgconv(const Args& a, int o) {
    const float* kp_I_RGCB = kin(I_RGCB); const float* kp_I_RGCW = kin(I_RGCW);
    const bf16_t* REC = (const bf16_t*)(a.ws + WS_BIG + B_REC); bf16_t* U = (bf16_t*)(a.ws + WS_BIG + B_U);
    const float* cw = kp_I_RGCW + (size_t)o * 4 * 1024; const float* cb = kp_I_RGCB + (size_t)o * 1024;
    for (int task = obid() * NTH + otid(); task < 1024 * 128; task += gridDim.x * NTH) {
        const int rb = task >> 7, c8 = (task & 127) * 8, r0 = rb * 36;
        float w[4][8], bias[8];
#pragma unroll
        for (int k = 0; k < 4; ++k) { const f32x4 wa = *(const f32x4*)(cw + k * 1024 + c8), wb = *(const f32x4*)(cw + k * 1024 + c8 + 4);
            w[k][0] = wa[0]; w[k][1] = wa[1]; w[k][2] = wa[2]; w[k][3] = wa[3]; w[k][4] = wb[0]; w[k][5] = wb[1]; w[k][6] = wb[2]; w[k][7] = wb[3]; }
        { const f32x4 ba = *(const f32x4*)(cb + c8), bb = *(const f32x4*)(cb + c8 + 4); bias[0] = ba[0]; bias[1] = ba[1]; bias[2] = ba[2]; bias[3] = ba[3]; bias[4] = bb[0]; bias[5] = bb[1]; bias[6] = bb[2]; bias[7] = bb[3]; }
#define RG_LD(rr_) (*(const u32x4*)(REC + (size_t)((rr_) < 0 ? 0 : ((rr_) > T - 1 ? T - 1 : (rr_))) * 1024 + c8))
#define RG_TAP(k_, v_, rr_) do { if ((rr_) >= s0 && (rr_) < s1) { const u32x4 t_ = (v_); \
            acc[0] += w[k_][0] * __uint_as_float(t_.x << 16); acc[1] += w[k_][1] * __uint_as_float(t_.x & 0xffff0000u); acc[2] += w[k_][2] * __uint_as_float(t_.y << 16); acc[3] += w[k_][3] * __uint_as_float(t_.y & 0xffff0000u); \
            acc[4] += w[k_][4] * __uint_as_float(t_.z << 16); acc[5] += w[k_][5] * __uint_as_float(t_.z & 0xffff0000u); acc[6] += w[k_][6] * __uint_as_float(t_.w << 16); acc[7] += w[k_][7] * __uint_as_float(t_.w & 0xffff0000u); } } while (0)
        u32x4 p0 = RG_LD(r0 - 2), p1 = RG_LD(r0 - 1), p2 = RG_LD(r0);
#pragma unroll 1
        for (int b = 0; b < 3; ++b) { u32x4 nv[12];
#pragma unroll
            for (int j = 0; j < 12; ++j) nv[j] = RG_LD(r0 + b * 12 + j + 1);
#pragma unroll
            for (int j = 0; j < 12; ++j) { const int row = r0 + b * 12 + j;
                int s0, s1; if (row < TL) { s0 = row & ~(SEQ - 1); s1 = s0 + SEQ; } else { s0 = TL + ((row - TL) & ~(CTXL - 1)); s1 = s0 + CTXL; }
                float acc[8];
#pragma unroll
                for (int jj = 0; jj < 8; ++jj) acc[jj] = bias[jj];
                RG_TAP(0, p0, row - 2); RG_TAP(1, p1, row - 1); RG_TAP(2, p2, row); RG_TAP(3, nv[j], row + 1);
                u32x4 ov; ov.x = pk2(acc[0], acc[1]); ov.y = pk2(acc[2], acc[3]); ov.z = pk2(acc[4], acc[5]); ov.w = pk2(acc[6], acc[7]);
                *(u32x4*)(U + (size_t)row * 1024 + c8) = ov;
                p0 = p1; p1 = p2; p2 = nv[j]; }
        }
#undef RG_LD
#undef RG_TAP
    }
}
DI int scan_chunk_of(int dir, int jj) { return dir == 0 ? jj : (jj < 8 ? 7 - jj : 79 - jj); }
DI int chunk_row0(int b, int chunk) { return chunk < 8 ? TL + b * CTXL + chunk * 32 : b * SEQ + (chunk - 8) * 32; }
DI void phase_scan1(const Args& a) {
    const bf16_t* LA = (const bf16_t*)(a.ws + WS_BIG + B_LA); const bf16_t* BB = (const bf16_t*)(a.ws + WS_BIG + B_BB);
    float* CT = (float*)((unsigned char*)a.out + O_CT);
    for (int idx = obid() * NTH + otid(); idx < 2 * 16 * 72 * 512; idx += gridDim.x * NTH) {
        const int ch = (idx & 511) * 2, g = idx >> 9, chunk = g % 72, b = (g / 72) & 15, dir = g / (72 * 16);
        const int row0 = chunk_row0(b, chunk); const bf16_t* la = LA + ((size_t)dir * T + row0) * 1024 + ch; const bf16_t* bb = BB + ((size_t)dir * T + row0) * 1024 + ch;
        float P0 = 1.f, Q0 = 0.f, P1 = 1.f, Q1 = 0.f;
        for (int i0 = 0; i0 < 32; i0 += 16) { unsigned lv[16], bv[16];
#pragma unroll
            for (int i = 0; i < 16; ++i) { const int ii = dir ? 31 - (i0 + i) : i0 + i; lv[i] = *(const unsigned*)(la + (size_t)ii * 1024); bv[i] = *(const unsigned*)(bb + (size_t)ii * 1024); }
#pragma unroll
            for (int i = 0; i < 16; ++i) { const float a0 = __expf(__uint_as_float(lv[i] << 16)), a1 = __expf(__uint_as_float(lv[i] & 0xffff0000u));
                P0 *= a0; Q0 = a0 * Q0 + __builtin_amdgcn_sqrtf(1.f - a0 * a0) * __uint_as_float(bv[i] << 16); P1 *= a1; Q1 = a1 * Q1 + __builtin_amdgcn_sqrtf(1.f - a1 * a1) * __uint_as_float(bv[i] & 0xffff0000u); } }
        const size_t o = (size_t)g * 1024 + ch; *(f32x4*)(CT + o * 2) = (f32x4){P0, Q0, P1, Q1};
    }
}
DI void phase_scan2(const Args& a) {
    const float* CT = (const float*)((unsigned char*)a.out + O_CT); float* CARRY = (float*)((unsigned char*)a.out + O_CARRY);
    for (int idx = obid() * NTH + otid(); idx < 2 * 16 * 1024; idx += gridDim.x * NTH) {
        const int ch = idx & 1023, b = (idx >> 10) & 15, dir = idx >> 14; float h = 0.f;
        float pq[72];
#pragma unroll 1
        for (int hh = 0; hh < 2; ++hh) {
#pragma unroll
            for (int j = 0; j < 36; ++j) { const int chunk = scan_chunk_of(dir, hh * 36 + j); const size_t o = (((size_t)dir * 16 + b) * 72 + chunk) * 1024 + ch; pq[2 * j] = CT[o * 2]; pq[2 * j + 1] = CT[o * 2 + 1]; }
#pragma unroll
            for (int j = 0; j < 36; ++j) { const int chunk = scan_chunk_of(dir, hh * 36 + j); const size_t o = (((size_t)dir * 16 + b) * 72 + chunk) * 1024 + ch; CARRY[o] = h; h = pq[2 * j] * h + pq[2 * j + 1]; } }
    }
}
DI void phase_scan3(const Args& a) {
    const bf16_t* LA = (const bf16_t*)(a.ws + WS_BIG + B_LA); const bf16_t* BB = (const bf16_t*)(a.ws + WS_BIG + B_BB); const bf16_t* GATE = (const bf16_t*)(a.ws + WS_BIG + B_GATE);
    bf16_t* MIXA = (bf16_t*)(a.ws + WS_BIG + B_MIXA_O); const float* CARRY = (const float*)((unsigned char*)a.out + O_CARRY);
    for (int idx = obid() * NTH + otid(); idx < 16 * 72 * 512; idx += gridDim.x * NTH) {
        const int ch = (idx & 511) * 2, g = idx >> 9, chunk = g % 72, b = g / 72; const int row0 = chunk_row0(b, chunk);
        unsigned hfp[32];
        float hf0[32];
        { const bf16_t* la = LA + ((size_t)row0) * 1024 + ch; const bf16_t* bb = BB + ((size_t)row0) * 1024 + ch;
          const float* cp = CARRY + (((size_t)0 * 16 + b) * 72 + chunk) * 1024 + ch; float h0 = cp[0], h1 = cp[1];
#pragma unroll
          for (int i0 = 0; i0 < 32; i0 += 16) { unsigned lv[16], bv[16];
#pragma unroll
              for (int i = 0; i < 16; ++i) { lv[i] = *(const unsigned*)(la + (size_t)(i0 + i) * 1024); bv[i] = *(const unsigned*)(bb + (size_t)(i0 + i) * 1024); }
#pragma unroll
              for (int i = 0; i < 16; ++i) { const float a0 = __expf(__uint_as_float(lv[i] << 16)), a1 = __expf(__uint_as_float(lv[i] & 0xffff0000u));
                  h0 = a0 * h0 + __builtin_amdgcn_sqrtf(1.f - a0 * a0) * __uint_as_float(bv[i] << 16); h1 = a1 * h1 + __builtin_amdgcn_sqrtf(1.f - a1 * a1) * __uint_as_float(bv[i] & 0xffff0000u);
                  hf0[i0 + i] = h0; hfp[i0 + i] = __float_as_uint(h1); } } }
        { const bf16_t* la = LA + ((size_t)T + row0) * 1024 + ch; const bf16_t* bb = BB + ((size_t)T + row0) * 1024 + ch;
          const float* cp = CARRY + (((size_t)1 * 16 + b) * 72 + chunk) * 1024 + ch; float h0 = cp[0], h1 = cp[1];
          const bf16_t* gp = GATE + (size_t)row0 * 1024 + ch; bf16_t* mo = MIXA + (size_t)row0 * 1024 + ch;
#pragma unroll
          for (int i0 = 16; i0 >= 0; i0 -= 16) { unsigned lv[16], bv[16], gv[16];
#pragma unroll
              for (int i = 0; i < 16; ++i) { lv[i] = *(const unsigned*)(la + (size_t)(i0 + i) * 1024); bv[i] = *(const unsigned*)(bb + (size_t)(i0 + i) * 1024); gv[i] = *(const unsigned*)(gp + (size_t)(i0 + i) * 1024); }
#pragma unroll
              for (int i = 15; i >= 0; --i) { const float a0 = __expf(__uint_as_float(lv[i] << 16)), a1 = __expf(__uint_as_float(lv[i] & 0xffff0000u));
                  h0 = a0 * h0 + __builtin_amdgcn_sqrtf(1.f - a0 * a0) * __uint_as_float(bv[i] << 16); h1 = a1 * h1 + __builtin_amdgcn_sqrtf(1.f - a1 * a1) * __uint_as_float(bv[i] & 0xffff0000u);
                  *(unsigned*)(mo + (size_t)(i0 + i) * 1024) = pk2(__uint_as_float(gv[i] << 16) * (hf0[i0 + i] + h0), __uint_as_float(gv[i] & 0xffff0000u) * (__uint_as_float(hfp[i0 + i]) + h1)); } } }
    }
}

DI int route_row(float logit, int lane, float bias, float* wout) {
    const float score = 1.f / (1.f + expf(-logit)); const float sel = score + bias;
    float m1 = sel; m1 = fmaxf(m1, xor_lane<1>(m1)); m1 = fmaxf(m1, xor_lane<2>(m1)); m1 = fmaxf(m1, xor_lane<4>(m1));
    const unsigned long long eq = __ballot(sel == m1); const int g = lane >> 3; const unsigned gm = (unsigned)(eq >> (g * 8)) & 0xffu; const int first = __ffs(gm) - 1;
    float m2 = ((lane & 7) == first) ? -INFINITY : sel; m2 = fmaxf(m2, xor_lane<1>(m2)); m2 = fmaxf(m2, xor_lane<2>(m2)); m2 = fmaxf(m2, xor_lane<4>(m2));
    const float gs = m1 + m2; int grank = 0;
#pragma unroll
    for (int gg = 0; gg < 8; ++gg) { const float o = lane_bcast(gs, gg * 8); grank += ((o > gs) || (o == gs && gg < g)) ? 1 : 0; }
    const float msel = grank < 4 ? sel : -INFINITY; int rank = 0;
    unsigned ub = __float_as_uint(msel); ub = (ub & 0x80000000u) ? ~ub : (ub | 0x80000000u);
    const unsigned long long key = ((unsigned long long)ub << 6) | (unsigned)(63 - lane);
    const unsigned klo = (unsigned)key, khi = (unsigned)(key >> 32);
#pragma unroll
    for (int e2 = 0; e2 < 64; ++e2) { const unsigned long long ok = ((unsigned long long)(unsigned)__builtin_amdgcn_readlane((int)khi, e2) << 32) | (unsigned)__builtin_amdgcn_readlane((int)klo, e2); rank += (ok > key) ? 1 : 0; }
    const bool chosen = rank < 8; const float wsum = wave_sum(chosen ? score : 0.f);
    *wout = score / wsum * 2.5f;
    return chosen ? rank : -1;
}
constexpr int RW_ROWB = 528;
DI void phase_router(const Args& a, int l, int Mrows, const bf16_t* MB, LAS unsigned char* lds) {
    const float* kp_I_ROUTB = kin(I_ROUTB);
    bf16_t* XS = (bf16_t*)(a.ws + WS_XS); const float* MOD = (const float*)(a.ws + WS_MOD) + (size_t)l * 17 * 6144;
    const bf16_t* RWT = (const bf16_t*)(a.ws + WS_ROPE + 131072);
    int* cnt = (int*)(a.ws + WS_CTL) + CW_CNT + l * 64 * 32; int2* LIST = (int2*)((unsigned char*)a.out + O_LIST); bf16_t* TM = (bf16_t*)((unsigned char*)a.out + O_ABUF);
    const float* ln1g = kin(I_LN1G) + l * 1024; const float* ln1b = kin(I_LN1B) + l * 1024; const float* xin_l = kin(I_X); const float* xin_c = kin(I_CTX);
    const int tid = otid(); const int wave = tid >> 6, lane = tid & 63, i = lane & 15, q = lane >> 4;
    const float rb = kp_I_ROUTB[l * 64 + lane];
    const int R = Mrows >> 8, RW8 = R >> 3, NG = R >> 4;
    LAS float* lg = (LAS float*)lds;
    LAS unsigned char* rwb = lds + 40960;
    LAS int* lcnt = (LAS int*)(lds + 38912); LAS int* wgbase = lcnt + 64;
    LAS unsigned char* sb = lds + 39424;
    LAS float* part8 = (LAS float*)(lds + 110592);
    for (int tile = obid(); tile < 256; tile += gridDim.x) {
        const int rbase = tile * R, r0 = rbase + wave * RW8;
        u32x4 st[8];
#define RW_LOAD(c_) do { _Pragma("unroll") for (int j_ = 0; j_ < 8; ++j_) st[j_] = *(const u32x4*)((const char*)RWT + (rwoff + (unsigned)(j_ * 32768 + (c_) * 512))); } while (0)
#define RW_STORE() do { _Pragma("unroll") for (int j_ = 0; j_ < 8; ++j_) *(LAS u32x4*)(rwb + rwl + j_ * 16 * RW_ROWB) = st[j_]; } while (0)
        { f32x4 lg_[4], lb_[4];
#pragma unroll
          for (int j = 0; j < 4; ++j) { const int col = 4 * lane + 256 * j; lg_[j] = *(const f32x4*)(ln1g + col); lb_[j] = *(const f32x4*)(ln1b + col); }
#define LN_LOAD(row_, XQ, MQ) do { const int rw_ = (row_); const bf16_t* xr_ = XS + (size_t)rw_ * 1024; const bf16_t* mr_ = MB + (size_t)rw_ * 1024; \
              const float* xi_ = rw_ < TL ? xin_l + (size_t)rw_ * 1024 : xin_c + (size_t)(rw_ - TL) * 1024;          \
              _Pragma("unroll") for (int j = 0; j < 4; ++j) { const int col = 4 * lane + 256 * j; \
                  if (l == 0) XQ[j] = *(const f32x4*)(xi_ + col); else { const u32x2 xv = *(const u32x2*)(xr_ + col); XQ[j] = (f32x4){__uint_as_float(xv.x << 16), __uint_as_float(xv.x & 0xffff0000u), __uint_as_float(xv.y << 16), __uint_as_float(xv.y & 0xffff0000u)}; } \
                  MQ[j] = *(const u32x2*)(mr_ + col); } } while (0)
          f32x4 xa[4], xb[4]; u32x2 ma[4], mb[4];
          LN_LOAD(r0, xa, ma);
#pragma unroll 1
          for (int rr = 0; rr < RW8; ++rr) { const int row = r0 + rr; bf16_t* xrow = XS + (size_t)row * 1024; f32x4 v[4]; float s = 0.f;
              if (rr + 1 < RW8) LN_LOAD(row + 1, xb, mb);
              const float* md = MOD + (size_t)(row < TL ? (row >> 11) : 16) * 6144;
#pragma unroll
              for (int j = 0; j < 4; ++j) { const int col = 4 * lane + 256 * j; const f32x4 gvj = *(const f32x4*)(md + 2048 + col);
                  const f32x4 mf = {__uint_as_float(ma[j].x << 16), __uint_as_float(ma[j].x & 0xffff0000u), __uint_as_float(ma[j].y << 16), __uint_as_float(ma[j].y & 0xffff0000u)};
                  v[j] = xa[j] * DN_ALPHA + gvj * mf; s += (v[j][0] + v[j][1]) + (v[j][2] + v[j][3]); }
              const float mean = wave_sum(s) * (1.f / 1024.f); float s2 = 0.f;
#pragma unroll
              for (int j = 0; j < 4; ++j) { v[j] = v[j] - mean; s2 += (v[j][0] * v[j][0] + v[j][1] * v[j][1]) + (v[j][2] * v[j][2] + v[j][3] * v[j][3]); }
              const float rstd = rsqrtf(wave_sum(s2) * (1.f / 1024.f) + LN_EPS);
#pragma unroll
              for (int j = 0; j < 4; ++j) { const int col = 4 * lane + 256 * j; const f32x4 y = v[j] * rstd * lg_[j] + lb_[j];
                  store_bf4(xrow + col, y); const f32x4 shf = *(const f32x4*)(md + 3072 + col), scf = *(const f32x4*)(md + 4096 + col);
                  store_bf4(TM + (size_t)row * 1024 + col, y * (scf + 1.f) + shf); }
#pragma unroll
              for (int j = 0; j < 4; ++j) { xa[j] = xb[j]; ma[j] = mb[j]; } } }
#undef LN_LOAD
        unsigned rwoff = ((tid >> 5) * 1024 + (tid & 31) * 8) * 2, rwl = (tid >> 5) * RW_ROWB + (tid & 31) * 16; asm volatile("" : "+v"(rwoff), "+v"(rwl));
        RW_LOAD(0);
        asm volatile("s_waitcnt vmcnt(0)" ::: "memory");
        RW_STORE();
        if (tid < 64) lcnt[tid] = 0;
        __syncthreads();
        f32x4 acc[2][4];
#pragma unroll
        for (int gi = 0; gi < 2; ++gi)
#pragma unroll
            for (int eb = 0; eb < 4; ++eb) acc[gi][eb] = (f32x4){0.f, 0.f, 0.f, 0.f};
        const int wvu = __builtin_amdgcn_readfirstlane(wave);
        const bool g8 = (NG == 9) && (wvu < 4);
        const bf16_t* ta0 = TM + (size_t)(rbase + wave * 16 + i) * 1024 + 8 * q; const bf16_t* ta8 = TM + (size_t)(rbase + 128 + i) * 1024 + 8 * q + wvu * 256;
        constexpr int PD = 2;
        u32x4 xq[PD], a8[4];
#pragma unroll
        for (int ss = 0; ss < PD; ++ss) xq[ss] = __builtin_nontemporal_load((const u32x4*)(ta0 + 32 * ss));
#pragma unroll
        for (int s = 0; s < 4; ++s) a8[s] = g8 ? __builtin_nontemporal_load((const u32x4*)(ta8 + 32 * s)) : xq[0];
#pragma unroll
        for (int c = 0; c < 4; ++c) {
            if (c + 1 < 4) RW_LOAD(c + 1);
#pragma unroll
            for (int s = 0; s < 8; ++s) { const int ss = c * 8 + s;
                bf16x8 bh[4], bl[4];
#pragma unroll
                for (int eb = 0; eb < 4; ++eb) { bh[eb] = *(const LAS bf16x8*)(rwb + (eb * 16 + i) * RW_ROWB + (32 * s + 8 * q) * 2); bl[eb] = *(const LAS bf16x8*)(rwb + (64 + eb * 16 + i) * RW_ROWB + (32 * s + 8 * q) * 2); }
                const bf16x8 a0_ = __builtin_bit_cast(bf16x8, xq[s % PD]), a1_ = __builtin_bit_cast(bf16x8, a8[s & 3]);
                if (ss + PD < 32) xq[s % PD] = __builtin_nontemporal_load((const u32x4*)(ta0 + 32 * (ss + PD)));
                if (s < 4 && g8 && wvu == c) a8[s] = __builtin_nontemporal_load((const u32x4*)(ta8 + 32 * (s + 4)));
#pragma unroll
                for (int eb = 0; eb < 4; ++eb) { acc[0][eb] = mfma16(a0_, bh[eb], acc[0][eb]); acc[0][eb] = mfma16(a0_, bl[eb], acc[0][eb]); }
                if (g8 && wvu == c) {
#pragma unroll
                    for (int eb = 0; eb < 4; ++eb) { acc[1][eb] = mfma16(a1_, bh[eb], acc[1][eb]); acc[1][eb] = mfma16(a1_, bl[eb], acc[1][eb]); } }
            }
            if (c + 1 < 4) { LDS_WAIT(); __builtin_amdgcn_s_barrier();
                asm volatile("s_waitcnt vmcnt(0)" ::: "memory"); RW_STORE(); LDS_WAIT(); __builtin_amdgcn_s_barrier(); }
        }
#undef RW_LOAD
#undef RW_STORE
#pragma unroll
        for (int eb = 0; eb < 4; ++eb)
#pragma unroll
            for (int r = 0; r < 4; ++r) lg[(wave * 16 + 4 * q + r) * 65 + eb * 16 + i] = acc[0][eb][r];
        if (g8) {
#pragma unroll
            for (int eb = 0; eb < 4; ++eb)
#pragma unroll
                for (int r = 0; r < 4; ++r) part8[(wvu * 16 + 4 * q + r) * 64 + eb * 16 + i] = acc[1][eb][r]; }
        __syncthreads();
        if (NG == 9 && wvu == 2) {
#pragma unroll 1
            for (int idx = lane; idx < 1024; idx += 64) lg[(128 + (idx >> 6)) * 65 + (idx & 63)] = (part8[idx] + part8[1024 + idx]) + (part8[2048 + idx] + part8[3072 + idx]); }
        const int rl = wave * 64 + lane; const bool rok = rl < R;
        int pe[8], pp[8]; float pw[8];
        if (rok) {
            const LAS float* lrow = lg + rl * 65; float sel[64];
#pragma unroll
            for (int e = 0; e < 64; ++e) sel[e] = sigmoidf_(lrow[e]) + lane_bcast(rb, e);
            float gs[8];
#pragma unroll
            for (int g = 0; g < 8; ++g) { float m1 = sel[g * 8], m2 = -INFINITY;
#pragma unroll
                for (int j = 1; j < 8; ++j) { m2 = fmaxf(m2, fminf(m1, sel[g * 8 + j])); m1 = fmaxf(m1, sel[g * 8 + j]); }
                gs[g] = m1 + m2; }
#pragma unroll
            for (int g = 0; g < 8; ++g) { int grank = 0;
#pragma unroll
                for (int g2 = 0; g2 < 8; ++g2) { if (g2 == g) continue; grank += ((gs[g2] > gs[g]) || (gs[g2] == gs[g] && g2 < g)) ? 1 : 0; }
#pragma unroll
                for (int j = 0; j < 8; ++j) sel[g * 8 + j] = grank < 4 ? sel[g * 8 + j] : -INFINITY; }
#pragma unroll 1
            for (int k = 0; k < 8; ++k) { float best = sel[0]; int bi = 0;
#pragma unroll
                for (int e = 1; e < 64; ++e) { const bool c = sel[e] > best; best = c ? sel[e] : best; bi = c ? e : bi; }
#pragma unroll
                for (int e = 0; e < 64; ++e) sel[e] = (bi == e) ? -INFINITY : sel[e];
                sb[rl * 8 + k] = (unsigned char)bi; }
            float wsum = 0.f;
#pragma unroll
            for (int k = 0; k < 8; ++k) { pe[k] = sb[rl * 8 + k]; pw[k] = sigmoidf_(lrow[pe[k]]); wsum += pw[k]; pp[k] = __hip_atomic_fetch_add(lcnt + pe[k], 1, __ATOMIC_RELAXED, __HIP_MEMORY_SCOPE_WORKGROUP); }
            const float wn = __builtin_amdgcn_rcpf(wsum) * 2.5f;
#pragma unroll
            for (int k = 0; k < 8; ++k) pw[k] *= wn;
        }
        __syncthreads();
        if (wave == 0) wgbase[lane] = atomicAdd(&cnt[lane * 32], lcnt[lane]);
        __syncthreads();
        if (rok) {
#pragma unroll
            for (int k = 0; k < 8; ++k) LIST[(size_t)pe[k] * T + wgbase[pe[k]] + pp[k]] = make_int2((rbase + rl) * 8 + k, __float_as_int(pw[k])); }
        __syncthreads();
    }
}
DI void build_toff(const Args& a, int l, int Mrows, volatile LAS int* toff) {
    const int* cnt = (const int*)(a.ws + WS_CTL) + CW_CNT + l * 64 * 32;
    __syncthreads();
    if (otid() == 0) { int acc = 0;
#pragma unroll 1
        for (int e = 0; e < 64; ++e) { toff[e] = acc; acc += (cnt[e * 32] + 255) >> 8; }
        toff[64] = acc; acc += Mrows >> 8; toff[65] = acc; }
    __syncthreads();
    volatile LAS unsigned char* rt2e = (volatile LAS unsigned char*)(toff + 128); volatile LAS unsigned short* rtnv = (volatile LAS unsigned short*)(toff + 128 + 352);
    for (int rt = otid(); rt < toff[65]; rt += NTH) { int e = 0;
#pragma unroll 1
        while (e < 64 && toff[e + 1] <= rt) ++e;
        rt2e[rt] = (unsigned char)e;
        int nv = 256; if (e < 64) { const int rem = cnt[e * 32] - (rt - toff[e]) * 256; nv = rem < 256 ? rem : 256; } rtnv[rt] = (unsigned short)nv; }
    __syncthreads();
}
DI void phase_ln2(const Args& a, int l, int Mrows) {
    const float* kp_I_LN2B = kin(I_LN2B); const float* kp_I_LN2G = kin(I_LN2G);
    bf16_t* XS = (bf16_t*)(a.ws + WS_XS); const bf16_t* Y = (const bf16_t*)(a.ws + WS_BIG); bf16_t* AB = (bf16_t*)((unsigned char*)a.out + O_ABUF);
    const bf16_t* SHB = (l == DEPTH - 1) ? (const bf16_t*)(a.ws + WS_WGU) : (const bf16_t*)AB;
    const float* MOD = (const float*)(a.ws + WS_MOD) + (size_t)l * 17 * 6144; const float* MODN = MOD + 17 * 6144;
    const float* g = kp_I_LN2G + l * 1024; const float* bta = kp_I_LN2B + l * 1024;
    const int tid = otid(); const int lane = tid & 63, gw = obid() * NWV + (tid >> 6), NGW = gridDim.x * NWV;
#define UPK8(u_, lo_, hi_) do { lo_ = (f32x4){__uint_as_float((u_).x << 16), __uint_as_float((u_).x & 0xffff0000u), __uint_as_float((u_).y << 16), __uint_as_float((u_).y & 0xffff0000u)}; \
        hi_ = (f32x4){__uint_as_float((u_).z << 16), __uint_as_float((u_).z & 0xffff0000u), __uint_as_float((u_).w << 16), __uint_as_float((u_).w & 0xffff0000u)}; } while (0)
    for (int row0 = gw * 2; row0 < Mrows; row0 += NGW * 2) {
        f32x4 v[2][4]; float s[2] = {0.f, 0.f};
#pragma unroll
        for (int h = 0; h < 2; ++h) { const int row = row0 + h; const bf16_t* xr = XS + (size_t)row * 1024; const int mrow = row < TL ? (row >> 11) : 16; const float* md = MOD + (size_t)mrow * 6144;
#pragma unroll
            for (int j = 0; j < 2; ++j) { const int col = 8 * lane + 512 * j; f32x4 ys0 = {0.f, 0.f, 0.f, 0.f}, ys1 = {0.f, 0.f, 0.f, 0.f}, t0, t1;
#pragma unroll
                for (int k = 0; k < 8; ++k) { const u32x4 yv = *(const u32x4*)(Y + ((size_t)row * 8 + k) * 1024 + col); UPK8(yv, t0, t1); ys0 += t0; ys1 += t1; }
                { const u32x4 sv = *(const u32x4*)(SHB + (size_t)row * 1024 + col); UPK8(sv, t0, t1); ys0 += t0; ys1 += t1; }
                { const u32x4 xv = *(const u32x4*)(xr + col); UPK8(xv, t0, t1);
                  v[h][2 * j] = t0 * DN_ALPHA + *(const f32x4*)(md + 5120 + col) * ys0; v[h][2 * j + 1] = t1 * DN_ALPHA + *(const f32x4*)(md + 5120 + col + 4) * ys1; }
                s[h] += ((v[h][2 * j][0] + v[h][2 * j][1]) + (v[h][2 * j][2] + v[h][2 * j][3])) + ((v[h][2 * j + 1][0] + v[h][2 * j + 1][1]) + (v[h][2 * j + 1][2] + v[h][2 * j + 1][3])); } }
        asm volatile("" ::: "memory");
#pragma unroll
        for (int h = 0; h < 2; ++h) { const int row = row0 + h; bf16_t* xr = XS + (size_t)row * 1024; const int mrow = row < TL ? (row >> 11) : 16;
            const float mean = wave_sum(s[h]) * (1.f / 1024.f); float s2 = 0.f;
#pragma unroll
            for (int j = 0; j < 4; ++j) { v[h][j] = v[h][j] - mean; s2 += (v[h][j][0] * v[h][j][0] + v[h][j][1] * v[h][j][1]) + (v[h][j][2] * v[h][j][2] + v[h][j][3] * v[h][j][3]); }
            const float rstd = rsqrtf(wave_sum(s2) * (1.f / 1024.f) + LN_EPS);
            if (l == DEPTH - 1) {
#pragma unroll
                for (int j = 0; j < 4; ++j) { const int col = 8 * lane + 512 * (j >> 1) + 4 * (j & 1); *(f32x4*)(a.out + (size_t)row * 1024 + col) = v[h][j] * rstd * *(const f32x4*)(g + col) + *(const f32x4*)(bta + col); }
            } else { const float* mdn = MODN + (size_t)mrow * 6144;
#pragma unroll
                for (int j = 0; j < 2; ++j) { const int col = 8 * lane + 512 * j;
                    const f32x4 y0 = v[h][2 * j] * rstd * *(const f32x4*)(g + col) + *(const f32x4*)(bta + col), y1 = v[h][2 * j + 1] * rstd * *(const f32x4*)(g + col + 4) + *(const f32x4*)(bta + col + 4);
                    store_bf8(xr + col, y0, y1);
                    const f32x4 sh0 = *(const f32x4*)(mdn + col), sh1 = *(const f32x4*)(mdn + col + 4), sc0 = *(const f32x4*)(mdn + 1024 + col), sc1 = *(const f32x4*)(mdn + 1024 + col + 4);
                    store_bf8(AB + (size_t)row * 1024 + col, y0 * (sc0 + 1.f) + sh0, y1 * (sc1 + 1.f) + sh1); } } }
    }
#undef UPK8
}

#ifndef FASTMASK
#define FASTMASK 0xff
#endif
constexpr bool F_ABIN = FASTMASK & 1, F_RGIN = FASTMASK & 2, F_OUT = FASTMASK & 4, F_GATES = FASTMASK & 8, F_GU = FASTMASK & 16, F_DN = FASTMASK & 32, F_HY = FASTMASK & 64, F_AT = FASTMASK & 128;
__global__ void __launch_bounds__(NTH, 2) mega(Args a0) {
    extern __shared__ __attribute__((aligned(16))) unsigned char lds_raw[];
    LAS unsigned char* lds = (LAS unsigned char*)lds_raw;
    const int tid = threadIdx.x;
    volatile LAS unsigned* MISC = (volatile LAS unsigned*)(lds + LDS_MISC);
    volatile LAS int* toff = (volatile LAS int*)(lds + LDS_TOFF);
    if (tid < 64) MISC[tid] = 0u;
    if (tid < 46) { LAS unsigned long long* tb = (LAS unsigned long long*)(lds + LDS_PTRS); tb[tid] = ((const __attribute__((address_space(4))) unsigned long long*)__builtin_amdgcn_kernarg_segment_ptr())[tid]; }
    __syncthreads();
    XcdBarrier bar = xcd_barrier_post((unsigned*)(a0.ws + WS_CTL) + CW_BAR, MISC);
    const int G = gridDim.x, bx = blockIdx.x; const bool EARLY_T = F_AT && F_HY && (G == 256);
#define GRID_BAR() xcd_barrier(bar)
#ifndef TMASK
#define TMASK 0u
#endif
#ifndef TMULT
#define TMULT 10ull
#endif
    unsigned long long tacc = 0ull;
#define PH_ENV() const int bx = obid(); unsigned long long wsi_ = (unsigned long long)uni_ptr(a0.ws), oui_ = (unsigned long long)uni_ptr(a0.out); asm volatile("" : "+s"(wsi_), "+s"(oui_)); unsigned char* ws = (unsigned char*)(GAS unsigned char*)wsi_; float* outp_ = (float*)(GAS float*)oui_; const Args& a = a0; unsigned char* ob = (unsigned char*)outp_; \
    const float* MOD = (const float*)(ws + WS_MOD); bf16_t* ABUF = (bf16_t*)(ob + O_ABUF); const int2* LIST = (const int2*)(ob + O_LIST); (void)MOD; (void)ABUF; (void)LIST
#define PH(id, ...) do { unsigned long long t0_ = 0ull; if ((TMASK >> (id)) & 1u) t0_ = __builtin_amdgcn_s_memrealtime(); { PH_ENV(); __VA_ARGS__; } GRID_BAR(); if ((TMASK >> (id)) & 1u) tacc += __builtin_amdgcn_s_memrealtime() - t0_; } while (0)
#define PHN(id, ...) do { unsigned long long t0_ = 0ull; if ((TMASK >> (id)) & 1u) t0_ = __builtin_amdgcn_s_memrealtime(); __VA_ARGS__; if ((TMASK >> (id)) & 1u) tacc += __builtin_amdgcn_s_memrealtime() - t0_; } while (0)
    PH(0, phase_mod(a, lds); phase_hdn(a); phase_rope(a); phase_weights(a, 0, lds));
    PH(1, phase_kr(a); phase_init(a));

    for (int l = 0; l < DEPTH; ++l) {
        const int Mrows = (l == DEPTH - 1) ? TL : T;
        if ((l & 1) == 0) {
            const int e = l >> 1;
            PH(3, { SchedDense S{ABUF, (const bf16_t*)(ws + WS_WIN), 1024, 1024, T / 256, 12, G, bx};
              EpiAbIn E{(bf16_t*)(ws + WS_BIG + B_PH), (bf16_t*)(ws + WS_BIG + B_QB), (bf16_t*)(ws + WS_BIG + B_KB), (bf16_t*)(ws + WS_BIG + B_VB), (const float*)(ws + WS_ROPE)};
              gemm_units<F_ABIN>(lds, S, E, 1024, 1024); });
            PH(4, phase_uc(a, e, lds));
            PH(5, PHN(19, { if constexpr (F_HY) { for (int c = bx; c < 1024; c += G) { if (c < 512) hyena_unit_fast<16>(a, e, c, lds); else hyena_unit_fast<2>(a, e, c - 512, lds); } }
                          else { for (int c = bx; c < 1024; c += G) hyena_unit_naive(a, e, c & 511, c >> 9, lds); } });
                  if (EARLY_T) hy_signal((unsigned*)(ws + WS_CTL) + CW_HYC + e * 32);
                  PHN(20, { if constexpr (F_AT) { for (int u = bx; u < 1024 + 128; u += G) { if (u < 1024) attn_unit_fast(a, l, 0, u >> 6, (u >> 4) & 3, u & 15, lds); else { const int v = u - 1024; attn_unit_fast(a, l, 1, v >> 3, (v >> 1) & 3, v & 1, lds); } } }
                          else { for (int u = bx; u < 2048 + 256; u += G) { if (u < 2048) attn_unit_naive(a, l, 0, u >> 7, (u >> 5) & 3, u & 31, lds); else { const int v = u - 2048; attn_unit_naive(a, l, 1, v >> 4, (v >> 2) & 3, v & 3, lds); } } } });
                  if (EARLY_T && bx >= 128) { hy_wait((unsigned*)(ws + WS_CTL) + CW_HYC + e * 32, 256u, bar.bar); phase_yh_t(a, lds, bx - 128, 128); });
            if (!EARLY_T) PH(6, phase_yh_t(a, lds, bx, G));
            PH(7, { SchedDense S{(const bf16_t*)(ws + WS_BIG + B_MIXA_E), (const bf16_t*)(ws + WS_WOUT), 1024, 1024, Mrows / 256, 4, G, bx}; EpiM E{(bf16_t*)(ws + WS_BIG + B_M_E)}; gemm_units<F_OUT>(lds, S, E, 1024, 1024); });
        } else {
            const int o = l >> 1;
            PH(8, { SchedDense S{ABUF, (const bf16_t*)(ws + WS_WIN), 1024, 1024, T / 256, 8, G, bx}; EpiRgIn E{(bf16_t*)(ws + WS_BIG + B_GATE), (bf16_t*)(ws + WS_BIG + B_REC)}; gemm_units<F_RGIN>(lds, S, E, 1024, 1024); });
            PH(9, phase_rgconv(a, o));
            PH(10, { SchedGates S{(const bf16_t*)(ws + WS_BIG + B_U), (const bf16_t*)(ws + WS_WG), T / 256, G, bx};
              EpiGates E{(const bf16_t*)(ws + WS_BIG + B_U), (bf16_t*)(ws + WS_BIG + B_LA), (bf16_t*)(ws + WS_BIG + B_BB), kin(I_RGBA) + o * 2048, kin(I_RGBX) + o * 2048, (const float*)(ws + WS_ROPE + 65536) + o * 2048};
              gemm_units<F_GATES>(lds, S, E, 128, 128); });
            PH(11, phase_scan1(a));
            PH(12, phase_scan2(a));
            PH(13, phase_scan3(a));
            PH(7, { SchedDense S{(const bf16_t*)(ws + WS_BIG + B_MIXA_O), (const bf16_t*)(ws + WS_WOUT), 1024, 1024, Mrows / 256, 4, G, bx}; EpiM E{(bf16_t*)(ws + WS_BIG + B_M_O)}; gemm_units<F_OUT>(lds, S, E, 1024, 1024); });
        }
        PH(15, phase_router(a, l, Mrows, (const bf16_t*)(ws + WS_BIG + ((l & 1) ? B_M_O : B_M_E)), lds));
        build_toff(a0, l, Mrows, toff);
        PH(16, { const int* cnt = (const int*)(ws + WS_CTL) + CW_CNT + l * 64 * 32; SchedMoeT<true> S{ABUF, (const bf16_t*)(ws + WS_WGU), cnt, LIST, toff, (volatile LAS unsigned char*)(toff + 128), toff[65], 2, G, bx, (size_t)512 * 1024}; EpiGU E{(bf16_t*)(ws + WS_HS)}; gemm_units<F_GU>(lds, S, E, 1024, 1024); });
        PH(17, { const int* cnt = (const int*)(ws + WS_CTL) + CW_CNT + l * 64 * 32; { SchedMoeT<false> S{(const bf16_t*)(ws + WS_HS), (const bf16_t*)(ws + WS_WD), cnt, LIST, toff, (volatile LAS unsigned char*)(toff + 128), toff[64], 4, G, bx, (size_t)1024 * 256};
          EpiDn E{(bf16_t*)(ws + WS_BIG), LIST}; gemm_units<F_DN>(lds, S, E, 256, 256); }
          { SchedDense S{(const bf16_t*)(ws + WS_HS) + (size_t)toff[64] * 256 * 256, (const bf16_t*)(ws + WS_WD) + (size_t)64 * 1024 * 256, 256, 256, Mrows / 256, 4, G, (G == 256) ? ((bx + 128) & 255) : bx}; EpiM E{(l == DEPTH - 1) ? (bf16_t*)(ws + WS_WGU) : ABUF}; gemm_units<F_DN>(lds, S, E, 256, 256); } });
        PH(18, phase_ln2(a, l, Mrows); if (l + 1 < DEPTH) phase_weights(a, l + 1, lds));
    }
    if (TMASK != 0u) { if (bx == 0 && tid == 0) { const unsigned long long t1 = __builtin_amdgcn_s_memrealtime(); while (__builtin_amdgcn_s_memrealtime() - t1 < TMULT * tacc) __builtin_amdgcn_s_sleep(8); } }
}

extern "C" void kernel_launch(void* const* d_in, const int* in_sizes, int n_in, void* d_out, int out_size, void* d_ws, size_t ws_size, hipStream_t stream) {
    static int grid = 0;
    if (grid == 0) {
        int dev = 0, cus = 0;
        if (hipGetDevice(&dev) != hipSuccess || hipDeviceGetAttribute(&cus, hipDeviceAttributeMultiprocessorCount, dev) != hipSuccess) { grid = -1; return; }
        if (hipFuncSetAttribute((const void*)mega, hipFuncAttributeMaxDynamicSharedMemorySize, LDS_BYTES) != hipSuccess) { grid = -1; return; }
        int per_cu = 0; (void)hipOccupancyMaxActiveBlocksPerMultiprocessor(&per_cu, (const void*)mega, NTH, LDS_BYTES); (void)hipGetLastError();
        grid = cus;
        if (per_cu < 1) grid = cus;
    }
    if (grid < 0) return;
    (void)hipMemsetAsync((char*)d_ws + WS_CTL, 0, CTL_BYTES, stream);
    Args a{};
    for (int i = 0; i < 46; ++i) a.in[i] = (const float*)d_in[i];
    a.out = (float*)d_out; a.ws = (unsigned char*)d_ws;
    hipLaunchKernelGGL(mega, dim3(grid), dim3(NTH), LDS_BYTES, stream, a);
}
```

```cpp
#include <hip/hip_runtime.h>
#include <stdint.h>
#include <math.h>

#define GAS __attribute__((address_space(1)))
#define LAS __attribute__((address_space(3)))
#define DI __device__ __forceinline__
typedef unsigned short bf16_t;
typedef short bf16x8 __attribute__((ext_vector_type(8)));
typedef float f32x4 __attribute__((ext_vector_type(4)));
typedef unsigned u32x4 __attribute__((ext_vector_type(4)));
typedef unsigned u32x2 __attribute__((ext_vector_type(2)));

constexpr int D = 1024, NB = 16, SEQ = 2048, CTXL = 256, DEPTH = 4;
constexpr int TL = NB * SEQ, TC = NB * CTXL, T = TL + TC;
constexpr float LN_EPS = 1e-5f;
constexpr float DN_ALPHA = 1.6817928305074290861f;
constexpr float C2 = 0.125f * 1.4426950408889634f;
constexpr int NTH = 512, NWV = 8;

constexpr size_t MiB = 1u << 20;
constexpr size_t WS_CTL = 0, CTL_BYTES = 1 * MiB;
constexpr size_t WS_MOD = 1 * MiB;
constexpr size_t WS_HDN = 3 * MiB;
constexpr size_t WS_ROPE = 5 * MiB;
constexpr size_t WS_KRL = 6 * MiB;
constexpr size_t WS_KRC = 22 * MiB;
constexpr size_t WS_WIN = 24 * MiB;
constexpr size_t WS_WOUT = 30 * MiB;
constexpr size_t WS_WG = 32 * MiB;
constexpr size_t WS_WGU = 36 * MiB;
constexpr size_t WS_WD = 101 * MiB;
constexpr size_t WS_XS = 134 * MiB;
constexpr size_t WS_HS = 278 * MiB;
constexpr size_t WS_BIG = 448 * MiB;
constexpr size_t B_PH = 0, B_QB = 108 * MiB, B_KB = 144 * MiB, B_VB = 180 * MiB, B_UC = 216 * MiB, B_YH = 324 * MiB, B_MIXA_E = 360 * MiB, B_M_E = 432 * MiB;
constexpr size_t B_GATE = 0, B_REC = 72 * MiB, B_U = 144 * MiB, B_LA = 216 * MiB, B_BB = 360 * MiB, B_MIXA_O = 504 * MiB, B_M_O = 0;
constexpr size_t O_ABUF = 0, O_LIST = 72 * MiB, O_CT = 92 * MiB, O_CARRY = 112 * MiB;
constexpr int CW_BAR = 4096, CW_CNT = 8192, CW_HYC = 16384;

constexpr int LDS_SCR = 143360;
constexpr int LDS_MISC = LDS_SCR;
constexpr int LDS_TOFF = LDS_SCR + 256;
constexpr int LDS_PTRS = LDS_SCR + 5120;
constexpr int LDS_BYTES = 151552;

DI float bf2f(bf16_t b) { return __uint_as_float(((unsigned)b) << 16); }
DI unsigned f2bf(float f) { unsigned u = __float_as_uint(f); return (u + 0x7fffu + ((u >> 16) & 1u)) >> 16; }
typedef float f32x2_t __attribute__((ext_vector_type(2))); typedef __bf16 bf16x2_t __attribute__((ext_vector_type(2)));
DI unsigned pk2(float lo, float hi) { const f32x2_t v = {lo, hi}; const bf16x2_t b = __builtin_convertvector(v, bf16x2_t); return __builtin_bit_cast(unsigned, b); }
DI void store_bf8(bf16_t* p, f32x4 v0, f32x4 v1) { u32x4 w; w.x = pk2(v0[0], v0[1]); w.y = pk2(v0[2], v0[3]); w.z = pk2(v1[0], v1[1]); w.w = pk2(v1[2], v1[3]); *(u32x4*)p = w; }
DI void store_bf4(bf16_t* p, f32x4 v) { u32x2 w; w.x = pk2(v[0], v[1]); w.y = pk2(v[2], v[3]); *(u32x2*)p = w; }
template <int X> DI float xor_lane(float v) {
    if constexpr (X == 32) { const auto rr = __builtin_amdgcn_permlane32_swap(__float_as_uint(v), __float_as_uint(v), false, false); return __uint_as_float(rr[0] == __float_as_uint(v) ? rr[1] : rr[0]); }
    else return __uint_as_float((unsigned)__builtin_amdgcn_ds_swizzle((int)__float_as_uint(v), 0x1f | (X << 10)));
}
DI float xor32_sum(float v) { const auto rr = __builtin_amdgcn_permlane32_swap(__float_as_uint(v), __float_as_uint(v), false, false); return __uint_as_float(rr[0]) + __uint_as_float(rr[1]); }
DI float xor32_max(float v) { const auto rr = __builtin_amdgcn_permlane32_swap(__float_as_uint(v), __float_as_uint(v), false, false); return fmaxf(__uint_as_float(rr[0]), __uint_as_float(rr[1])); }
DI float lane_bcast(float v, int l) { return __uint_as_float((unsigned)__builtin_amdgcn_readlane((int)__float_as_uint(v), l)); }
DI float wave_sum(float v) { v += xor_lane<1>(v); v += xor_lane<2>(v); v += xor_lane<4>(v); v += xor_lane<8>(v); v += xor_lane<16>(v); return xor32_sum(v); }
DI float sigmoidf_(float x) { return __builtin_amdgcn_rcpf(1.f + __expf(-x)); }
#define LDS_WAIT() asm volatile("s_waitcnt lgkmcnt(0)" ::: "memory")
DI int otid() { int t = threadIdx.x; asm volatile("" : "+v"(t)); return t; }
DI const char* uni_ptr(const void* p) { const unsigned long long v = (unsigned long long)p; const unsigned lo = __builtin_amdgcn_readfirstlane((unsigned)v), hi = __builtin_amdgcn_readfirstlane((unsigned)(v >> 32)); return (const char*)(GAS const char*)(((unsigned long long)hi << 32) | lo); }
DI int obid() { int b = blockIdx.x; asm volatile("" : "+s"(b)); return b; }

#define XB_TMO      128
#define XB_XCNT(j)  (256  + 64 * (j))
#define XB_XSUB(j)  (1280 + 64 * (j))
#define XB_XGEN(j)  (2304 + 64 * (j))
#define XB_TOP      3328
#define XB_TOPGEN   3392
#define XCD_BAR_WORDS 3456
#define XB_SPIN_CAP (1u << 22)
DI unsigned xb_ld(unsigned* p)              { return __hip_atomic_load(p, __ATOMIC_RELAXED, __HIP_MEMORY_SCOPE_AGENT); }
DI unsigned xb_add(unsigned* p, unsigned v) { return __hip_atomic_fetch_add(p, v, __ATOMIC_RELAXED, __HIP_MEMORY_SCOPE_AGENT); }
DI unsigned xb_xcc_id() { return (unsigned)__builtin_amdgcn_s_getreg((3 << 11) | 20) & 0xFu; }
#define XB_SPIN(cond, bar) do { unsigned _sp = 0; while (cond) { __builtin_amdgcn_s_sleep(1); \
    if ((++_sp & 255u) == 0u) { if (xb_ld(&(bar)[XB_TMO])) break; if (_sp > XB_SPIN_CAP) { atomicAdd(&(bar)[XB_TMO], 1u); break; } } } } while (0)
struct XcdBarrier { unsigned* bar; unsigned x; volatile LAS unsigned* st; };
DI XcdBarrier xcd_barrier_post(unsigned* bar, volatile LAS unsigned* st) {
    XcdBarrier b; b.bar = bar; b.x = xb_xcc_id(); b.st = st;
    if (threadIdx.x == 0) (void)xb_add(&bar[XB_XCNT(b.x)], 1u);
    return b;
}
DI void xcd_barrier_complete(unsigned* bar, unsigned x, unsigned& nloc, unsigned& nx) {
    const unsigned G = gridDim.x * gridDim.y * gridDim.z;
    unsigned sum, cnt, mine, sp = 0u;
    for (;;) {
        sum = 0u; cnt = 0u; mine = 0u;
#pragma unroll
        for (unsigned j = 0; j < 16; ++j) { const unsigned c = xb_ld(&bar[XB_XCNT(j)]); sum += c; cnt += (c > 0u) ? 1u : 0u; mine = (j == x) ? c : mine; }
        if (sum == G) break;
        __builtin_amdgcn_s_sleep(1);
        if ((++sp & 255u) == 0u) { if (xb_ld(&bar[XB_TMO])) break; if (sp > XB_SPIN_CAP) { atomicAdd(&bar[XB_TMO], 1u); break; } }
    }
    nloc = mine > 0u ? mine : 1u; nx = cnt > 0u ? cnt : 1u;
}
DI void xcd_barrier(const XcdBarrier& b) {
    asm volatile("s_waitcnt vmcnt(0)" ::: "memory");
    __syncthreads();
    unsigned long long bi_ = (unsigned long long)uni_ptr(b.bar); asm volatile("" : "+s"(bi_));
    if (threadIdx.x == 0) {
        unsigned* bar = (unsigned*)(GAS unsigned*)bi_;
        __builtin_amdgcn_s_waitcnt(0);
        unsigned nloc = b.st[0], nx = b.st[1];
        if (nloc == 0u) { xcd_barrier_complete(bar, xb_xcc_id(), nloc, nx); b.st[0] = nloc; b.st[1] = nx; }
        const unsigned bx_ = xb_xcc_id();
        const unsigned old = xb_add(&bar[XB_XSUB(bx_)], 1u);
        const unsigned gen = old / nloc;
        if (old + 1u == (gen + 1u) * nloc) {
            __builtin_amdgcn_fence(__ATOMIC_RELEASE, "agent");
            asm volatile("s_waitcnt vmcnt(0)" ::: "memory");
            const unsigned og = xb_add(&bar[XB_TOP], 1u);
            const unsigned tg = og / nx;
            if (og + 1u == (tg + 1u) * nx) xb_add(&bar[XB_TOPGEN], 1u);
            else XB_SPIN(xb_ld(&bar[XB_TOPGEN]) == tg, bar);
            __builtin_amdgcn_fence(__ATOMIC_ACQUIRE, "agent");
            xb_add(&bar[XB_XGEN(bx_)], 1u);
            asm volatile("s_waitcnt vmcnt(0)" ::: "memory");
        } else {
            XB_SPIN(xb_ld(&bar[XB_XGEN(bx_)]) == gen, bar);
            __builtin_amdgcn_fence(__ATOMIC_ACQUIRE, "agent");
            asm volatile("s_waitcnt vmcnt(0)" ::: "memory");
        }
    }
    __syncthreads();
}

DI void hy_signal(unsigned* cw) { asm volatile("s_waitcnt vmcnt(0)" ::: "memory"); __syncthreads();
    if (threadIdx.x == 0) { __builtin_amdgcn_fence(__ATOMIC_RELEASE, "agent"); asm volatile("s_waitcnt vmcnt(0)" ::: "memory"); (void)xb_add(cw, 1u); } }
DI void hy_wait(unsigned* cw, unsigned target, unsigned* bar) {
    if (threadIdx.x == 0) { XB_SPIN(xb_ld(cw) < target, bar); __builtin_amdgcn_fence(__ATOMIC_ACQUIRE, "agent"); asm volatile("s_waitcnt vmcnt(0)" ::: "memory"); }
    __syncthreads(); }

struct Args { const float* in[46]; float* out; unsigned char* ws; };
enum { I_X = 0, I_C, I_CTX, I_CCTX, I_WMOD, I_BMOD, I_LN1G, I_LN1B, I_LN2G, I_LN2B, I_ABWIN, I_ABWOUT, I_HYSW, I_HYSB, I_FW1, I_FB1, I_FW2, I_FB2,
       I_FW3, I_FB3, I_FW4, I_FREQ, I_DECAY, I_SKIP, I_LQ1, I_LK1, I_LQ2, I_LK2, I_SUBG, I_RGWIN, I_RGWOUT, I_RGCW, I_RGCB, I_RGWA, I_RGBA, I_RGWX, I_RGBX,
       I_RGLAM, I_ROUTW, I_ROUTB, I_EXG, I_EXU, I_EXD, I_SHG, I_SHU, I_SHD };
DI const float* kin(int i) { const volatile LAS unsigned* tb = (const volatile LAS unsigned*)(size_t)LDS_PTRS; const unsigned lo = tb[2 * i], hi = tb[2 * i + 1];
    return (const float*)(GAS const float*)(((unsigned long long)(unsigned)__builtin_amdgcn_readfirstlane((int)hi) << 32) | (unsigned)__builtin_amdgcn_readfirstlane((int)lo)); }

struct GU { const bf16_t* A; const bf16_t* B; int pm, pn, e, ti, nvalid; };

DI f32x4 mfma16(bf16x8 a, bf16x8 b, f32x4 c) { return __builtin_amdgcn_mfma_f32_16x16x32_bf16(a, b, c, 0, 0, 0); }

namespace pg8 {
constexpr int BK = 64, HALF = 128, HTB = HALF * BK * 2, STAGE_BYTES = 8 * HTB;
DI int lds_byte(int r, int c) { const int st = (r >> 4) * 2 + (c >> 5), rr = r & 15, cc = c & 31, ob = rr * 64 + cc * 2; return st * 1024 + (ob ^ (((ob >> 9) & 1) << 5)); }
DI int perm32(int rho) { const int n = rho >> 4, i = rho & 15; return 8 * (i >> 2) + 4 * n + (i & 3); }
DI void stage_rc(int b, int& R, int& C) { const int st = b / 1024, sb = b % 1024, swz = sb ^ (((sb >> 9) & 1) << 5); R = (st >> 1) * 16 + swz / 64; C = (st & 1) * 32 + (swz % 64) / 2; }
template <class Sched, class Epi>
DI void gemm_naive(const Sched& S, const Epi& E, int K, int ldb) {
    const int tid = otid(), wave = tid >> 6, lane = tid & 63, fr = lane & 15, fq = lane >> 4;
    GU u;
    for (int i = 0; S.next(i, u); ++i) {
        for (int task = wave; task < 64; task += NWV) {
            const int rg = task >> 2, c0 = (task & 3) * 32, r = rg * 16 + fr;
            const bf16_t* arow = u.A + S.arow_off(u, r) + 8 * fq;
            const int br0 = Epi::PERM ? pg8::perm32(fr) : fr, br1 = Epi::PERM ? pg8::perm32(16 + fr) : 16 + fr;
            const bf16_t* b00 = u.B + (size_t)(c0 + br0) * ldb + 8 * fq; const bf16_t* b01 = u.B + (size_t)(c0 + br1) * ldb + 8 * fq;
            const bf16_t* b10 = b00 + (size_t)128 * ldb; const bf16_t* b11 = b01 + (size_t)128 * ldb;
            f32x4 a0 = {0.f, 0.f, 0.f, 0.f}, a1 = a0, b0 = a0, b1 = a0;
            for (int k0 = 0; k0 < K; k0 += 32) {
                const bf16x8 af = *(const bf16x8*)(arow + k0);
                const bf16x8 w00 = *(const bf16x8*)(b00 + k0), w01 = *(const bf16x8*)(b01 + k0), w10 = *(const bf16x8*)(b10 + k0), w11 = *(const bf16x8*)(b11 + k0);
                a0 = mfma16(w00, af, a0); a1 = mfma16(w01, af, a1); b0 = mfma16(w10, af, b0); b1 = mfma16(w11, af, b1);
            }
            const int cle = c0 + (Epi::PERM ? 8 : 4) * fq; typename Epi::UPre UP; typename Epi::Pre P; E.upre(u, cle, UP); E.pre(u, r, cle, P); E(u, r, cle, a0, a1, b0, b1, UP, P);
        }
    }
}

}
#ifndef PG8_ALIGN
#define PG8_ALIGN false
#endif
template <class Sched, class Epi>
DI void gemm_fast(LAS unsigned char* lds, const Sched& S, const Epi& E, const int K, const int ldb) {
    using namespace pg8;
    const int tid = otid(), wid = __builtin_amdgcn_readfirstlane(tid >> 6), lane = tid & 63, wr = wid >> 2, wc = wid & 3, fr = lane & 15, fq = lane >> 4;
    const int nt = K / BK;
    int R0, C0, R1, C1; stage_rc(tid * 16, R0, C0); stage_rc(tid * 16 + 8192, R1, C1);
    const int Rb0 = Epi::PERM ? ((R0 & ~31) + perm32(R0 & 31)) : R0, Rb1 = Epi::PERM ? ((R1 & ~31) + perm32(R1 & 31)) : R1;
    unsigned voffB[2]; voffB[0] = (unsigned)(Rb0 * ldb + C0) * 2u; voffB[1] = (unsigned)(Rb1 * ldb + C1) * 2u;
    GU cur, nxt; int ui = 0;
    if (!S.next(0, cur)) return;
    const size_t lda_ = S.arow_off(cur, 1);
    unsigned voffA[2]; voffA[0] = (unsigned)(R0 * lda_ + C0) * 2u; voffA[1] = (unsigned)(R1 * lda_ + C1) * 2u;
    const size_t kstep = (size_t)(BK * 2), hstepB = (size_t)HALF * ldb * 2, hstepA = (size_t)HALF * lda_ * 2;
    const unsigned ldsw = (unsigned)wid * 1024u;
    const int aoff = lds_byte(wr * 64 + fr, fq * 8), boff = lds_byte(wc * 32 + fr, fq * 8);
#define PG8_SA(b, h) (((b) * 2 + (h)) * HTB)
#define PG8_SB(b, h) ((4 + (b) * 2 + (h)) * HTB)
#define PG8_GLDS(gp, ldsoff) __builtin_amdgcn_global_load_lds((const unsigned*)(gp), (LAS unsigned*)(lds + (ldsoff)), 16, 0, 0)
#define PG8_STAGE_B(bufoff, gbase) do { PG8_GLDS((const char*)(gbase) + voffB[0], (bufoff) + ldsw); PG8_GLDS((const char*)(gbase) + voffB[1], (bufoff) + ldsw + 8192); } while (0)
#define PG8_STAGE_A(bufoff, gbase, h, o0, o1) do { if constexpr (Sched::GATHER) { PG8_GLDS((const char*)(gbase) + (o0), (bufoff) + ldsw); PG8_GLDS((const char*)(gbase) + (o1), (bufoff) + ldsw + 8192); } \
        else { PG8_GLDS((const char*)(gbase) + (h) * hstepA + voffA[0], (bufoff) + ldsw); PG8_GLDS((const char*)(gbase) + (h) * hstepA + voffA[1], (bufoff) + ldsw + 8192); } } while (0)
#define PG8_LDA(dst, b, h) do { _Pragma("unroll") for (int m = 0; m < 4; ++m) _Pragma("unroll") for (int k = 0; k < 2; ++k) dst[m][k] = *(const LAS bf16x8*)(lds + PG8_SA(b, h) + aoff + m * 2048 + k * 1024); } while (0)
#define PG8_LDB(dst, b, h) do { _Pragma("unroll") for (int n = 0; n < 2; ++n) _Pragma("unroll") for (int k = 0; k < 2; ++k) dst[n][k] = *(const LAS bf16x8*)(lds + PG8_SB(b, h) + boff + n * 2048 + k * 1024); } while (0)
#define PG8_MMA(ai, bj, At, Bt) do { __builtin_amdgcn_s_setprio(1); _Pragma("unroll") for (int m = 0; m < 4; ++m) _Pragma("unroll") for (int n = 0; n < 2; ++n) _Pragma("unroll") for (int k = 0; k < 2; ++k) \
        acc[ai][bj][m][n] = __builtin_amdgcn_mfma_f32_16x16x32_bf16(Bt[n][k], At[m][k], acc[ai][bj][m][n], 0, 0, 0); __builtin_amdgcn_s_setprio(0); } while (0)
#define PG8_WAIT_V(n) asm volatile("s_waitcnt vmcnt(" #n ")" ::: "memory")
#define PG8_WAIT_L(n) asm volatile("s_waitcnt lgkmcnt(" #n ")" ::: "memory")
#define PG8_BAR __builtin_amdgcn_s_barrier()
#define PG8_SCHED __builtin_amdgcn_sched_barrier(0)
#define PG8_AOFFS(d00, d01, d10, d11, u) do { if constexpr (Sched::GATHER) { d00 = (unsigned)(S.arow_off(u, R0) + C0) * 2u; d01 = (unsigned)(S.arow_off(u, R1) + C1) * 2u; \
        d10 = (unsigned)(S.arow_off(u, R0 + 128) + C0) * 2u; d11 = (unsigned)(S.arow_off(u, R1 + 128) + C1) * 2u; } } while (0)
    f32x4 acc[2][2][4][2];
#pragma unroll
    for (int a_ = 0; a_ < 2; ++a_)
#pragma unroll
        for (int b_ = 0; b_ < 2; ++b_)
#pragma unroll
            for (int m = 0; m < 4; ++m)
#pragma unroll
                for (int n = 0; n < 2; ++n) acc[a_][b_][m][n] = (f32x4){0.f, 0.f, 0.f, 0.f};
    bf16x8 At[4][2], B0[2][2], B1[2][2];
    const char* cA = uni_ptr(cur.A); const char* cB = uni_ptr(cur.B);
    unsigned c00 = 0, c01 = 0, c10 = 0, c11 = 0, n00 = 0, n01 = 0, n10 = 0, n11 = 0;
    PG8_AOFFS(c00, c01, c10, c11, cur);
    PG8_STAGE_B(PG8_SB(0, 0), cB); PG8_STAGE_B(PG8_SB(0, 1), cB + hstepB); PG8_STAGE_A(PG8_SA(0, 0), cA, 0, c00, c01); PG8_STAGE_A(PG8_SA(0, 1), cA, 1, c10, c11);
    if (wr == 1) PG8_BAR;
    PG8_WAIT_V(2); PG8_BAR;
    PG8_STAGE_B(PG8_SB(1, 0), cB + kstep); PG8_STAGE_A(PG8_SA(1, 0), cA + kstep, 0, c00, c01); PG8_STAGE_B(PG8_SB(1, 1), cB + hstepB + kstep);
    PG8_WAIT_V(6); PG8_BAR;
    for (;;) {
        const bool has_next = S.next(ui + 1, nxt);
        const char* nA = has_next ? uni_ptr(nxt.A) : cA; const char* nB = has_next ? uni_ptr(nxt.B) : cB;
        if (has_next) { PG8_AOFFS(n00, n01, n10, n11, nxt); } else { n00 = c00; n01 = c01; n10 = c10; n11 = c11; }
        if constexpr (Epi::LDSMETA) { int tq = threadIdx.x; asm volatile("" : "+v"(tq));
            if (tq < 256) { const unsigned* gp = E.mptr(cur, tq); LAS unsigned* lp = (LAS unsigned*)(lds + 131072 + (ui & 1) * 2048 + __builtin_amdgcn_readfirstlane(tq >> 6) * 256);
                __builtin_amdgcn_global_load_lds(gp, lp, 4, 0, 0); __builtin_amdgcn_global_load_lds(gp + 1, lp + 256, 4, 0, 0); } }
        typename Epi::Pre PE[Epi::EARLY ? 4 : 1];
        if constexpr (Epi::EARLY) { int tq = threadIdx.x; asm volatile("" : "+v"(tq)); const int wq = tq >> 6, lq = tq & 63, rbq = (wq >> 2) * 64 + (lq & 15), clq = (wq & 3) * 32 + (Epi::PERM ? 8 : 4) * (lq >> 4);
#pragma unroll
            for (int g = 0; g < 4; ++g) E.pre(cur, rbq + g * 16, clq, PE[g]); }
        for (int t = 0; t < nt; t += 2) {
            const bool last = (t == nt - 2);
            const char* a1 = cA + (size_t)(t + 1) * kstep;
            const char* a2 = last ? nA : cA + (size_t)(t + 2) * kstep; const char* b2 = last ? nB : cB + (size_t)(t + 2) * kstep;
            const char* a3 = a2 + kstep; const char* b3 = b2 + kstep;
            asm volatile("" : "+s"(a1), "+s"(a2), "+s"(b2), "+s"(a3), "+s"(b3));
            const unsigned o00 = last ? n00 : c00, o01 = last ? n01 : c01, o10 = last ? n10 : c10, o11 = last ? n11 : c11;
            PG8_LDB(B0, 0, 0); PG8_LDB(B1, 0, 1); PG8_SCHED; PG8_LDA(At, 0, 0); PG8_STAGE_A(PG8_SA(1, 1), a1, 1, c10, c11);
            PG8_WAIT_V(8); PG8_WAIT_L(0); PG8_BAR; PG8_MMA(0, 0, At, B0); PG8_MMA(0, 1, At, B1); PG8_BAR; PG8_SCHED;
            PG8_LDA(At, 0, 1); PG8_STAGE_B(PG8_SB(0, 0), b2); PG8_STAGE_B(PG8_SB(0, 1), b2 + hstepB); PG8_STAGE_A(PG8_SA(0, 0), a2, 0, o00, o01);
            PG8_WAIT_V(8); PG8_WAIT_L(0); PG8_BAR; PG8_MMA(1, 0, At, B0); PG8_MMA(1, 1, At, B1);
            PG8_BAR; PG8_SCHED;
            PG8_LDB(B0, 1, 0); PG8_LDB(B1, 1, 1); PG8_SCHED; PG8_LDA(At, 1, 0); PG8_STAGE_A(PG8_SA(0, 1), a2, 1, o10, o11);
            PG8_WAIT_V(8); PG8_WAIT_L(0); PG8_BAR; PG8_MMA(0, 0, At, B0); PG8_MMA(0, 1, At, B1); PG8_BAR; PG8_SCHED;
            PG8_LDA(At, 1, 1); PG8_STAGE_B(PG8_SB(1, 0), b3); PG8_STAGE_B(PG8_SB(1, 1), b3 + hstepB); PG8_STAGE_A(PG8_SA(1, 0), a3, 0, o00, o01);
            PG8_WAIT_V(8); PG8_WAIT_L(0); PG8_BAR; PG8_MMA(1, 0, At, B0); PG8_MMA(1, 1, At, B1); PG8_BAR; PG8_SCHED;
        }
        if (PG8_ALIGN) { if (wr == 0) PG8_BAR; }
        { int tz = threadIdx.x; asm volatile("" : "+v"(tz));
          const int wz = tz >> 6, lz = tz & 63, wrz = wz >> 2, wcz = wz & 3, frz = lz & 15, fqz = lz >> 4;
          const int clz = wcz * 32 + (Epi::PERM ? 8 : 4) * fqz, rbz = wrz * 64 + frz;
          typename Epi::UPre UP; E.upre(cur, clz, UP);
          if constexpr (Epi::EARLY) { typename Epi::Pre P2[4];
#pragma unroll
              for (int g = 0; g < 4; ++g) E.pre(cur, HALF + rbz + g * 16, clz, P2[g]);
#pragma unroll
              for (int g = 0; g < 4; ++g) E(cur, rbz + g * 16, clz, acc[0][0][g][0], acc[0][0][g][1], acc[0][1][g][0], acc[0][1][g][1], UP, PE[g]);
#pragma unroll
              for (int g = 0; g < 4; ++g) E(cur, HALF + rbz + g * 16, clz, acc[1][0][g][0], acc[1][0][g][1], acc[1][1][g][0], acc[1][1][g][1], UP, P2[g]); }
          else {
#pragma unroll
          for (int gb = 0; gb < 8; gb += Epi::BATCH) { typename Epi::Pre PP[Epi::BATCH];
#pragma unroll
              for (int j = 0; j < Epi::BATCH; ++j) { if constexpr (Epi::LDSMETA) E.pre_lds(cur, lds + 131072 + (ui & 1) * 2048, ((gb + j) >> 2) * HALF + rbz + ((gb + j) & 3) * 16, PP[j]); else E.pre(cur, ((gb + j) >> 2) * HALF + rbz + ((gb + j) & 3) * 16, clz, PP[j]); }
#pragma unroll
              for (int j = 0; j < Epi::BATCH; ++j) { const int ai = (gb + j) >> 2, m = (gb + j) & 3;
                  E(cur, ai * HALF + rbz + m * 16, clz, acc[ai][0][m][0], acc[ai][0][m][1], acc[ai][1][m][0], acc[ai][1][m][1], UP, PP[j]); } } }
        }
        if (!has_next) break;
#pragma unroll
        for (int a_ = 0; a_ < 2; ++a_)
#pragma unroll
            for (int b_ = 0; b_ < 2; ++b_)
#pragma unroll
                for (int m = 0; m < 4; ++m)
#pragma unroll
                    for (int n = 0; n < 2; ++n) acc[a_][b_][m][n] = (f32x4){0.f, 0.f, 0.f, 0.f};
        cur = nxt; cA = nA; cB = nB; c00 = n00; c01 = n01; c10 = n10; c11 = n11; ++ui;
        if (PG8_ALIGN) { if (wr == 1) PG8_BAR; }
    }
    PG8_WAIT_V(0);
    if (!PG8_ALIGN) { if (wr == 0) PG8_BAR; }
    PG8_BAR;
#undef PG8_SA
#undef PG8_SB
#undef PG8_GLDS
#undef PG8_STAGE_A
#undef PG8_STAGE_B
#undef PG8_LDA
#undef PG8_LDB
#undef PG8_MMA
#undef PG8_WAIT_V
#undef PG8_WAIT_L
#undef PG8_BAR
#undef PG8_SCHED
#undef PG8_AOFFS
}
template <bool FAST, class Sched, class Epi>
DI void gemm_units(LAS unsigned char* lds, const Sched& S, const Epi& E, int K, int ldb) { if constexpr (FAST) gemm_fast(lds, S, E, K, ldb); else gemm_naive(S, E, K, ldb); }

struct SchedDense {
    static constexpr bool GATHER = false;
    const bf16_t* A; const bf16_t* B; int lda, ldb, nM, nN, G, c;
    DI bool next(int i, GU& u) const { const int L = i * G + c; const int nwg = nM * nN; if (L >= nwg) return false;
        int wgid = L; { const int q = nwg >> 3, r = nwg & 7, xcd = wgid & 7, off = wgid >> 3; wgid = (xcd < r ? xcd * (q + 1) : r * (q + 1) + (xcd - r) * q) + off; }
        const int nig = 8 * nN, gid = wgid / nig, fm = gid * 8, gsz = (nM - fm) < 8 ? (nM - fm) : 8; u.pm = fm + ((wgid % nig) % gsz); u.pn = (wgid % nig) / gsz;
        u.A = A + (size_t)u.pm * 256 * lda; u.B = B + (size_t)u.pn * 256 * ldb; u.e = 0; u.ti = 0; u.nvalid = 256; return true; }
    DI size_t arow_off(const GU&, int r) const { return (size_t)r * lda; }
};
struct SchedGates {
    static constexpr bool GATHER = false;
    const bf16_t* A; const bf16_t* B; int nM, G, c;
    DI bool next(int i, GU& u) const { const int L = i * G + c; const int nwg = nM * 16; if (L >= nwg) return false;
        int wgid = L; { const int q = nwg >> 3, r = nwg & 7, xcd = wgid & 7, off = wgid >> 3; wgid = (xcd < r ? xcd * (q + 1) : r * (q + 1) + (xcd - r) * q) + off; }
        u.pm = wgid >> 4; u.pn = wgid & 15;
        u.A = A + (size_t)u.pm * 256 * 1024 + (u.pn >> 1) * 128; u.B = B + (size_t)u.pn * 256 * 128; u.e = 0; u.ti = 0; u.nvalid = 256; return true; }
    DI size_t arow_off(const GU&, int r) const { return (size_t)r * 1024; }
};
template <bool GATH> struct SchedMoeT {
    static constexpr bool GATHER = GATH;
    const bf16_t* A; const bf16_t* B; const int* cnt; const int2* list; volatile LAS int* toff; volatile LAS unsigned char* rt2e; int NT, NJ, G, c; size_t bstride;
    DI bool next(int i, GU& u) const {
        const int xcd = c & 7, k = c >> 3, nk = G >> 3, base = NT >> 3, rem = NT & 7, start = xcd * base + (xcd < rem ? xcd : rem), len = base + (xcd < rem ? 1 : 0);
        const int full = len / nk, remt = len - full * nk;
        int rt;
        if (GATH) { const int uu = k + i * nk; if (uu >= len * NJ) return false; rt = start + uu / NJ; u.pn = uu % NJ; }
        else if (i < full * NJ) { const int ti_ = i / NJ; rt = start + k + ti_ * nk; u.pn = i - ti_ * NJ; }
        else { const int uu = k + (i - full * NJ) * nk; if (uu >= remt * NJ) return false; rt = start + full * nk + uu / NJ; u.pn = uu % NJ; }
        u.pm = rt;
        const int e = __builtin_amdgcn_readfirstlane((int)rt2e[rt]);
        u.e = e; u.ti = rt - __builtin_amdgcn_readfirstlane(toff[e]); u.nvalid = __builtin_amdgcn_readfirstlane((int)((volatile LAS unsigned short*)(toff + 128 + 352))[rt]);
        u.A = GATH ? A : A + (size_t)rt * 256 * 256; u.B = B + (size_t)e * bstride + (size_t)u.pn * 256 * (GATH ? 1024 : 256); return true; }
    DI size_t arow_off(const GU& u, int r) const {
        if (!GATH) return (size_t)r * 256;
        int tok; if (u.e < 64) tok = (r < u.nvalid) ? (list[(size_t)u.e * T + u.ti * 256 + r].x >> 3) : 0; else tok = u.ti * 256 + r;
        return (size_t)tok * 1024; }
};

struct PreNone {};
struct PreRope { f32x4 t0, t1; };
struct EpiAbIn { bf16_t *PH, *QB, *KB, *VB; const float* rope; typedef PreNone UPre; typedef PreRope Pre; static constexpr int BATCH = 8; static constexpr bool LDSMETA = false, EARLY = false, PERM = false;
    DI void upre(const GU&, int, UPre&) const {}
    DI void pre(const GU& u, int rl, int cl, Pre& P) const { P.t0 = (f32x4){1.f, 0.f, 1.f, 0.f}; P.t1 = P.t0;
        const int row = u.pm * 256 + rl;
        if (u.pn >= 6 && u.pn < 10 && row < TL) { const int d = cl & 63, axis = d >> 5, f0 = d & 15, pos = row & (SEQ - 1), p = axis ? (pos & 63) : (pos >> 6);
            P.t0 = *(const f32x4*)(rope + (p * 16 + f0) * 2); P.t1 = *(const f32x4*)(rope + (p * 16 + f0) * 2 + 4); } }
    DI void put(int row, int col, f32x4 v0, f32x4 v1, const Pre& P) const {
        if (col < 1536) { store_bf4(PH + (size_t)row * 1536 + col, v0); store_bf4(PH + (size_t)row * 1536 + col + 16, v1); }
        else if (col < 2560) { int cc = col - 1536; bf16_t* dst = cc < 512 ? QB : KB; const float sc = cc < 512 ? C2 : 1.f; cc &= 511;
            const f32x4 cs = {P.t0[0], P.t0[2], P.t1[0], P.t1[2]}, sn = {P.t0[1], P.t0[3], P.t1[1], P.t1[3]};
            const f32x4 xa = v0, xb = v1; v0 = (xa * cs - xb * sn) * sc; v1 = (xb * cs + xa * sn) * sc;
            store_bf4(dst + (size_t)row * 512 + cc, v0); store_bf4(dst + (size_t)row * 512 + cc + 16, v1); }
        else { const int cc = col - 2560; store_bf4(VB + (size_t)row * 512 + cc, v0); store_bf4(VB + (size_t)row * 512 + cc + 16, v1); }
    }
    DI void operator()(const GU& u, int rl, int cl, f32x4 a0, f32x4 a1, f32x4 b0, f32x4 b1, const UPre&, const Pre& P) const {
        const int row = u.pm * 256 + rl, col = u.pn * 256 + cl; put(row, col, a0, a1, P); put(row, col + 128, b0, b1, P); }
};
DI float gelu_tanh(float x) { const float y = 0.7978845608028654f * (x + 0.044715f * x * x * x); const float t = 1.f - 2.f * __builtin_amdgcn_rcpf(1.f + __expf(2.f * y)); return 0.5f * x * (1.f + t); }
struct EpiRgIn { bf16_t *GATE, *REC; typedef PreNone UPre; typedef PreNone Pre; static constexpr int BATCH = 8; static constexpr bool LDSMETA = false, EARLY = false, PERM = true;
    DI void upre(const GU&, int, UPre&) const {}
    DI void pre(const GU&, int, int, Pre&) const {}
    DI void put(int row, int col, f32x4 v0, f32x4 v1) const {
        if (col < 1024) { f32x4 g0, g1;
#pragma unroll
            for (int j = 0; j < 4; ++j) { g0[j] = gelu_tanh(v0[j]); g1[j] = gelu_tanh(v1[j]); }
            store_bf8(GATE + (size_t)row * 1024 + col, g0, g1); }
        else store_bf8(REC + (size_t)row * 1024 + col - 1024, v0, v1); }
    DI void operator()(const GU& u, int rl, int cl, f32x4 a0, f32x4 a1, f32x4 b0, f32x4 b1, const UPre&, const Pre&) const {
        const int row = u.pm * 256 + rl, col = u.pn * 256 + cl; put(row, col, a0, a1); put(row, col + 128, b0, b1); }
};
struct EpiM { bf16_t* O;
    typedef PreNone UPre; typedef PreNone Pre; static constexpr int BATCH = 8; static constexpr bool LDSMETA = false, EARLY = false, PERM = true;
    DI void upre(const GU&, int, UPre&) const {}
    DI void pre(const GU&, int, int, Pre&) const {}
    DI void operator()(const GU& u, int rl, int cl, f32x4 a0, f32x4 a1, f32x4 b0, f32x4 b1, const UPre&, const Pre&) const {
        bf16_t* p = O + (size_t)(u.pm * 256 + rl) * 1024 + u.pn * 256 + cl; store_bf8(p, a0, a1); store_bf8(p + 128, b0, b1); }
};
struct PreGU { f32x4 ba0, ba1, bx0, bx1, lm0, lm1; };
struct PreGP { u32x4 u; };
struct EpiGates { const bf16_t* U; bf16_t *LA, *BB; const float *ba, *bx, *lam;
    typedef PreGU UPre; typedef PreGP Pre; static constexpr int BATCH = 8; static constexpr bool LDSMETA = false, EARLY = false, PERM = true;
    DI void upre(const GU& u, int cl, UPre& P) const { const int k = u.pn >> 1, dir = u.pn & 1, ci = dir * 1024 + k * 128 + cl;
        P.ba0 = *(const f32x4*)(ba + ci); P.ba1 = *(const f32x4*)(ba + ci + 4); P.bx0 = *(const f32x4*)(bx + ci); P.bx1 = *(const f32x4*)(bx + ci + 4);
        P.lm0 = *(const f32x4*)(lam + ci); P.lm1 = *(const f32x4*)(lam + ci + 4); }
    DI void pre(const GU& u, int rl, int cl, Pre& P) const { const int row = u.pm * 256 + rl, ch = (u.pn >> 1) * 128 + cl; P.u = *(const u32x4*)(U + (size_t)row * 1024 + ch); }
    DI void calc(f32x4 ra, f32x4 ia, unsigned ux, unsigned uy, f32x4 bav, f32x4 bxv, f32x4 lmv, f32x4& la, f32x4& bb) const {
        const float uv[4] = {__uint_as_float(ux << 16), __uint_as_float(ux & 0xffff0000u), __uint_as_float(uy << 16), __uint_as_float(uy & 0xffff0000u)};
#pragma unroll
        for (int j = 0; j < 4; ++j) {
            const float ex = __expf(-fminf(fmaxf(ra[j] + bav[j], -30.f), 30.f)) + 1.f, ey = __expf(-fminf(fmaxf(ia[j] + bxv[j], -30.f), 30.f)) + 1.f, rc = __builtin_amdgcn_rcpf(ex * ey);
            la[j] = (ey * rc) * lmv[j]; bb[j] = (ex * rc) * uv[j]; } }
    DI void operator()(const GU& u, int rl, int cl, f32x4 a0, f32x4 a1, f32x4 b0, f32x4 b1, const UPre& UP, const Pre& P) const {
        const int row = u.pm * 256 + rl, k = u.pn >> 1, dir = u.pn & 1, ch = k * 128 + cl; f32x4 la0, bb0, la1, bb1;
        calc(a0, b0, P.u.x, P.u.y, UP.ba0, UP.bx0, UP.lm0, la0, bb0); calc(a1, b1, P.u.z, P.u.w, UP.ba1, UP.bx1, UP.lm1, la1, bb1);
        store_bf8(LA + ((size_t)dir * T + row) * 1024 + ch, la0, la1); store_bf8(BB + ((size_t)dir * T + row) * 1024 + ch, bb0, bb1); }
};
struct EpiGU { bf16_t* HS; typedef PreNone UPre; typedef PreNone Pre; static constexpr int BATCH = 8; static constexpr bool LDSMETA = false, EARLY = false, PERM = true;
    DI void upre(const GU&, int, UPre&) const {}
    DI void pre(const GU&, int, int, Pre&) const {}
    DI void operator()(const GU& u, int rl, int cl, f32x4 a0, f32x4 a1, f32x4 b0, f32x4 b1, const UPre&, const Pre&) const {
        f32x4 h0, h1;
#pragma unroll
        for (int j = 0; j < 4; ++j) { h0[j] = a0[j] * sigmoidf_(a0[j]) * b0[j]; h1[j] = a1[j] * sigmoidf_(a1[j]) * b1[j]; }
        store_bf8(HS + ((size_t)u.pm * 256 + rl) * 256 + u.pn * 128 + cl, h0, h1); }
};
struct PreD { int2 meta; };
struct EpiDn { bf16_t* Y; const int2* list;
    typedef PreNone UPre; typedef PreD Pre; static constexpr int BATCH = 8; static constexpr bool LDSMETA = true, EARLY = false, PERM = true;
    DI void upre(const GU&, int, UPre&) const {}
    DI void pre(const GU& u, int rl, int, Pre& P) const { P.meta = (rl < u.nvalid) ? list[(size_t)u.e * T + u.ti * 256 + rl] : make_int2(-1, 0); }
    DI const unsigned* mptr(const GU& u, int r) const { return (const unsigned*)(list + (size_t)u.e * T + u.ti * 256 + r); }
    DI void pre_lds(const GU& u, const LAS unsigned char* mb, int rl, Pre& P) const { const int px = *(const LAS int*)(mb + rl * 4), py = *(const LAS int*)(mb + 1024 + rl * 4); P.meta = (rl < u.nvalid) ? make_int2(px, py) : make_int2(-1, 0); }
    DI void operator()(const GU& u, int, int cl, f32x4 a0, f32x4 a1, f32x4 b0, f32x4 b1, const UPre&, const Pre& P) const {
        if (P.meta.x >= 0) { const float w = __int_as_float(P.meta.y); bf16_t* y = Y + (size_t)P.meta.x * 1024 + u.pn * 256 + cl;
            store_bf8(y, a0 * w, a1 * w); store_bf8(y + 128, b0 * w, b1 * w); } }
};

DI void phase_mod(const Args& a, LAS unsigned char* lds) {
    const float* kp_I_BMOD = kin(I_BMOD); const float* kp_I_C = kin(I_C); const float* kp_I_CCTX = kin(I_CCTX); const float* kp_I_WMOD = kin(I_WMOD);
    LAS float* sc = (LAS float*)lds;
    LAS float* red = sc + 17 * 1024;
    float* MOD = (float*)(a.ws + WS_MOD);
    const int tid = otid(), wave = tid >> 6, lane = tid & 63;
    for (int i = tid; i < 17 * 1024; i += NTH) { const float v = (i < 16384) ? kp_I_C[i] : kp_I_CCTX[i - 16384]; sc[i] = v / (1.f + expf(-v)); }
    __syncthreads();
    const int wv = __builtin_amdgcn_readfirstlane(wave), col = lane & 31, kh = lane >> 5;
    const unsigned voff = (unsigned)(kh * 64 * 6144 + col) * 4u;
    for (int unit = obid(); unit < 4 * 192; unit += gridDim.x) {
        const int l = unit / 192, n0 = (unit % 192) * 32;
        const float* Wb = kp_I_WMOD + (size_t)l * 1024 * 6144 + n0 + (size_t)(wv * 128) * 6144;
        float w[64];
#pragma unroll
        for (int u = 0; u < 64; ++u) w[u] = *(const float*)((const char*)(Wb + (size_t)u * 6144) + voff);
        float acc[17];
#pragma unroll
        for (int r = 0; r < 17; ++r) acc[r] = 0.f;
        const LAS float* scp = sc + wv * 128 + kh * 64;
#pragma unroll
        for (int u4 = 0; u4 < 16; ++u4) {
#pragma unroll
            for (int r = 0; r < 17; ++r) { const f32x4 s = *(const LAS f32x4*)(scp + r * 1024 + 4 * u4); acc[r] += (s[0] * w[4 * u4] + s[1] * w[4 * u4 + 1]) + (s[2] * w[4 * u4 + 2] + s[3] * w[4 * u4 + 3]); } }
#pragma unroll
        for (int r = 0; r < 17; ++r) red[((wv * 2 + kh) * 17 + r) * 32 + col] = acc[r];
        __syncthreads();
        for (int i = tid; i < 17 * 32; i += NTH) { const int r = i >> 5, cl = i & 31; float s = 0.f;
#pragma unroll
            for (int p = 0; p < 16; ++p) s += red[(p * 17 + r) * 32 + cl];
            MOD[((size_t)l * 17 + r) * 6144 + n0 + cl] = s + kp_I_BMOD[l * 6144 + n0 + cl]; }
        __syncthreads();
    }
}
DI void phase_hdn(const Args& a) {
    const float* kp_I_FB1 = kin(I_FB1); const float* kp_I_FB2 = kin(I_FB2); const float* kp_I_FB3 = kin(I_FB3); const float* kp_I_FREQ = kin(I_FREQ); const float* kp_I_FW1 = kin(I_FW1); const float* kp_I_FW2 = kin(I_FW2); const float* kp_I_FW3 = kin(I_FW3);
    float* HDN = (float*)(a.ws + WS_HDN);
    const int tid = otid(); const int lane = tid & 63, gw = obid() * NWV + (tid >> 6), NGW = gridDim.x * NWV;
    for (int task = gw; task < 2 * 2304; task += NGW) {
        const int e = task / 2304, p = task % 2304, nsel = p >= 2048, t = nsel ? p - 2048 : p, n = nsel ? 256 : 2048;
        const float tt = (float)t / (float)(n - 1);
        const float fm = 1e-4f + (float)(lane & 15) * ((15.f - 1e-4f) / 15.f);
        const float ang = (6.283185307179586f / (float)n) * (float)t * fm;
        const float cs = cosf(ang), sn = sinf(ang);
        const float* w1 = kp_I_FW1 + e * 33 * 64; const float* w2 = kp_I_FW2 + e * 64 * 64; const float* w3 = kp_I_FW3 + e * 64 * 64;
        const float fr = kp_I_FREQ[e * 64 + lane];
        float s = tt * w1[lane];
#pragma unroll
        for (int m = 0; m < 16; ++m) { s += lane_bcast(cs, m) * w1[(1 + m) * 64 + lane]; s -= lane_bcast(sn, m) * w1[(17 + m) * 64 + lane]; }
        float h = sinf(fr * (s + kp_I_FB1[e * 64 + lane]));
        s = 0.f;
#pragma unroll 8
        for (int i = 0; i < 64; ++i) s += lane_bcast(h, i) * w2[i * 64 + lane];
        h = sinf(fr * (s + kp_I_FB2[e * 64 + lane]));
        s = 0.f;
#pragma unroll 8
        for (int i = 0; i < 64; ++i) s += lane_bcast(h, i) * w3[i * 64 + lane];
        h = sinf(fr * (s + kp_I_FB3[e * 64 + lane]));
        HDN[(size_t)task * 64 + lane] = h;
    }
}
DI void phase_rope(const Args& a) {
    const float* kp_I_RGLAM = kin(I_RGLAM);
    float* R = (float*)(a.ws + WS_ROPE);
    const int gt = obid() * NTH + otid();
    if (gt < 64 * 16) { const int p = gt >> 4, f = gt & 15; const float inv = powf(10000.f, -(float)f / 16.f); const float ang = (float)p * inv; R[gt * 2] = cosf(ang); R[gt * 2 + 1] = sinf(ang); }
    if (gt < 2 * 2048) { float* LSG = (float*)(a.ws + WS_ROPE + 65536); LSG[gt] = -8.f * log1pf(expf(-kp_I_RGLAM[gt])); }
}
DI void transpose_item(const float* W, int ldw, bf16_t* WT, int ldt, int k0, int n0, int drow0, int dcol0, LAS float* scr, int lane) {
    const int c4 = (lane & 15) * 4, kr = lane >> 4;
    f32x4 tv[16];
#pragma unroll
    for (int i = 0; i < 16; ++i) tv[i] = *(const f32x4*)(W + (size_t)(k0 + 4 * i + kr) * ldw + n0 + c4);
#pragma unroll
    for (int i = 0; i < 16; ++i) { LAS float* d = scr + (4 * i + kr) * 65 + c4; d[0] = tv[i][0]; d[1] = tv[i][1]; d[2] = tv[i][2]; d[3] = tv[i][3]; }
    LDS_WAIT();
    const int c = lane & 7;
#pragma unroll
    for (int j = 0; j < 8; ++j) { const int n = (lane >> 3) + 8 * j; const LAS float* s = scr + (8 * c) * 65 + n;
        u32x4 o; o.x = pk2(s[0 * 65], s[1 * 65]); o.y = pk2(s[2 * 65], s[3 * 65]); o.z = pk2(s[4 * 65], s[5 * 65]); o.w = pk2(s[6 * 65], s[7 * 65]);
        *(u32x4*)(WT + (size_t)(drow0 + n) * ldt + dcol0 + 8 * c) = o; }
    LDS_WAIT();
}
DI void phase_weights(const Args& a, int l, LAS unsigned char* lds) {
    const int tid = otid(), wave = tid >> 6, lane = tid & 63, gw = obid() * NWV + wave, NGW = gridDim.x * NWV;
    LAS float* scr = (LAS float*)(lds + wave * 16896);
    bf16_t* WIN = (bf16_t*)(a.ws + WS_WIN); bf16_t* WOUT = (bf16_t*)(a.ws + WS_WOUT); bf16_t* WG = (bf16_t*)(a.ws + WS_WG);
    bf16_t* WGU = (bf16_t*)(a.ws + WS_WGU); bf16_t* WD = (bf16_t*)(a.ws + WS_WD);
    const int half = l >> 1;
    const float* p_exg = kin(I_EXG); const float* p_exu = kin(I_EXU); const float* p_exd = kin(I_EXD); const float* p_shg = kin(I_SHG); const float* p_shu = kin(I_SHU); const float* p_shd = kin(I_SHD);
    for (int it = gw; it < 65 * 192; it += NGW) {
        const int e = it / 192, m = (it % 192) >> 6, r = it & 63;
        if (m < 2) { const float* src = (e < 64) ? (m ? p_exu : p_exg) + ((size_t)l * 64 + e) * 1024 * 256 : (m ? p_shu : p_shg) + (size_t)l * 1024 * 256;
            const int kb = r >> 2, nb = r & 3, n0 = nb * 64; const int drow0 = (n0 >> 7) * 256 + (n0 & 127) + (m ? 128 : 0);
            transpose_item(src, 256, WGU + (size_t)e * 512 * 1024, 1024, kb * 64, n0, drow0, kb * 64, scr, lane); }
        else { const float* src = (e < 64) ? p_exd + ((size_t)l * 64 + e) * 256 * 1024 : p_shd + (size_t)l * 256 * 1024;
            const int kb = r >> 4, nb = r & 15; transpose_item(src, 1024, WD + (size_t)e * 1024 * 256, 256, kb * 64, nb * 64, nb * 64, kb * 64, scr, lane); }
    }
    { const float* rw = kin(I_ROUTW) + (size_t)l * 1024 * 64; bf16_t* RWT = (bf16_t*)(a.ws + WS_ROPE + 131072);
      for (int idx = obid() * NTH + tid; idx < 64 * 1024; idx += gridDim.x * NTH) { const int e = idx >> 10, k = idx & 1023; const float w = rw[k * 64 + e]; const unsigned hi = f2bf(w);
          RWT[idx] = (bf16_t)hi; RWT[65536 + idx] = (bf16_t)f2bf(w - __uint_as_float(hi << 16)); } }
    if ((l & 1) == 0) {
        const float* win = kin(I_ABWIN) + (size_t)half * 1024 * 3072; const float* wout = kin(I_ABWOUT) + (size_t)half * 1024 * 1024;
        for (int it = gw; it < 768 + 256; it += NGW) {
            if (it < 768) { const int kb = it / 48, nb = it % 48; transpose_item(win, 3072, WIN, 1024, kb * 64, nb * 64, nb * 64, kb * 64, scr, lane); }
            else { const int r = it - 768, kb = r >> 4, nb = r & 15; transpose_item(wout, 1024, WOUT, 1024, kb * 64, nb * 64, nb * 64, kb * 64, scr, lane); }
        }
    } else {
        const float* win = kin(I_RGWIN) + (size_t)half * 1024 * 2048; const float* wout = kin(I_RGWOUT) + (size_t)half * 1024 * 1024;
        for (int it = gw; it < 512 + 256; it += NGW) {
            if (it < 512) { const int kb = it >> 5, nb = it & 31; transpose_item(win, 2048, WIN, 1024, kb * 64, nb * 64, nb * 64, kb * 64, scr, lane); }
            else { const int r = it - 512, kb = r >> 4, nb = r & 15; transpose_item(wout, 1024, WOUT, 1024, kb * 64, nb * 64, nb * 64, kb * 64, scr, lane); }
        }
        const float* wa = kin(I_RGWA) + (size_t)half * 2 * 8 * 128 * 128; const float* wx = kin(I_RGWX) + (size_t)half * 2 * 8 * 128 * 128;
        for (int idx = obid() * NTH + tid; idx < 4096 * 128; idx += gridDim.x * NTH) {
            const int n = idx >> 7, kk = idx & 127, pn = n >> 8, hf = (n >> 7) & 1, c = n & 127, k = pn >> 1, dir = pn & 1;
            const float v = (hf ? wx : wa)[(((size_t)dir * 8 + k) * 128 + kk) * 128 + c];
            WG[idx] = (bf16_t)f2bf(v);
        }
    }
}
DI void split8(f32x4 v0, f32x4 v1, bf16x8& hi, bf16x8& lo) {
    u32x4 hp; hp.x = pk2(v0[0], v0[1]); hp.y = pk2(v0[2], v0[3]); hp.z = pk2(v1[0], v1[1]); hp.w = pk2(v1[2], v1[3]);
    u32x4 lp; lp.x = pk2(v0[0] - __uint_as_float(hp.x << 16), v0[1] - __uint_as_float(hp.x & 0xffff0000u)); lp.y = pk2(v0[2] - __uint_as_float(hp.y << 16), v0[3] - __uint_as_float(hp.y & 0xffff0000u));
    lp.z = pk2(v1[0] - __uint_as_float(hp.z << 16), v1[1] - __uint_as_float(hp.z & 0xffff0000u)); lp.w = pk2(v1[2] - __uint_as_float(hp.w << 16), v1[3] - __uint_as_float(hp.w & 0xffff0000u));
    hi = __builtin_bit_cast(bf16x8, hp); lo = __builtin_bit_cast(bf16x8, lp);
}
DI void phase_kr(const Args& a) {
    const float* kp_I_DECAY = kin(I_DECAY); const float* kp_I_FW4 = kin(I_FW4); const float* kp_I_SKIP = kin(I_SKIP);
    const float* HDN = (const float*)(a.ws + WS_HDN);
    bf16_t* KRL = (bf16_t*)(a.ws + WS_KRL); bf16_t* KRC = (bf16_t*)(a.ws + WS_KRC);
    const int tid = otid(); const int lane = tid & 63, i = lane & 15, q = lane >> 4, gw = obid() * NWV + __builtin_amdgcn_readfirstlane(tid >> 6), NGW = gridDim.x * NWV;
    const unsigned voffb = (unsigned)(8 * q * 2048 + i) * 4u;
    for (int item = gw; item < 2 * 72 * 8; item += NGW) {
        const int part = item & 7, rest = item >> 3, e = rest / 72, xc = rest % 72, nsel = xc >= 64, n = nsel ? 256 : 2048, x0 = (nsel ? xc - 64 : xc) * 64;
        const int dir = (x0 >= n) ? 1 : 0; const bool lag0 = (x0 == n);
        const float invn = nsel ? (1.f / 255.f) : (1.f / 2047.f);
        const float* w4 = kp_I_FW4 + (size_t)e * 64 * 2048; const float* dec = kp_I_DECAY + e * 2048;
        bf16x8 ah[4][2], al[4][2];
#pragma unroll
        for (int mt = 0; mt < 4; ++mt) { const int x = x0 + mt * 16 + i, d = n - x, t = d < 0 ? -d : d; const bool valid = t < n;
            const float* hr = HDN + ((size_t)e * 2304 + (nsel ? 2048 : 0) + (valid ? t : 0)) * 64 + 8 * q;
#pragma unroll
            for (int ks = 0; ks < 2; ++ks) split8(*(const f32x4*)(hr + ks * 32), *(const f32x4*)(hr + ks * 32 + 4), ah[mt][ks], al[mt][ks]); }
#pragma unroll 1
        for (int half = 0; half < 2; ++half) {
            float wv[4][16];
#pragma unroll
            for (int nt = 0; nt < 4; ++nt) { const int oc0 = part * 128 + half * 64 + nt * 16, f0 = (oc0 >> 9) * 1024 + dir * 512 + (oc0 & 511);
#pragma unroll
                for (int k = 0; k < 16; ++k) wv[nt][k] = *(const float*)((const char*)(w4 + f0 + ((k >> 3) * 32 + (k & 7)) * 2048) + voffb); }
#pragma unroll
            for (int nt = 0; nt < 4; ++nt) { const int oc0 = part * 128 + half * 64 + nt * 16, ord = oc0 >> 9, c0 = oc0 & 511, f0 = ord * 1024 + dir * 512 + c0;
                bf16x8 bh[2], bl[2];
#pragma unroll
                for (int ks = 0; ks < 2; ++ks) split8((f32x4){wv[nt][ks * 8], wv[nt][ks * 8 + 1], wv[nt][ks * 8 + 2], wv[nt][ks * 8 + 3]}, (f32x4){wv[nt][ks * 8 + 4], wv[nt][ks * 8 + 5], wv[nt][ks * 8 + 6], wv[nt][ks * 8 + 7]}, bh[ks], bl[ks]);
                f32x4 acc[4];
#pragma unroll
                for (int mt = 0; mt < 4; ++mt) { acc[mt] = (f32x4){0.f, 0.f, 0.f, 0.f};
#pragma unroll
                    for (int ks = 0; ks < 2; ++ks) { acc[mt] = mfma16(ah[mt][ks], bh[ks], acc[mt]); acc[mt] = mfma16(ah[mt][ks], bl[ks], acc[mt]); acc[mt] = mfma16(al[mt][ks], bh[ks], acc[mt]); } }
                const float dv = fabsf(dec[f0 + i]); float s0 = 0.f;
                if (lag0) {
                    f32x4 a0 = {0.f, 0.f, 0.f, 0.f};
#pragma unroll
                    for (int ks = 0; ks < 2; ++ks) { float w0[8];
#pragma unroll
                        for (int r = 0; r < 8; ++r) w0[r] = *(const float*)((const char*)(w4 + ord * 1024 + c0 + (ks * 32 + r) * 2048) + voffb);
                        bf16x8 b0h, b0l; split8((f32x4){w0[0], w0[1], w0[2], w0[3]}, (f32x4){w0[4], w0[5], w0[6], w0[7]}, b0h, b0l);
                        a0 = mfma16(ah[0][ks], b0h, a0); a0 = mfma16(ah[0][ks], b0l, a0); a0 = mfma16(al[0][ks], b0h, a0); }
                    s0 = a0[0] + kp_I_SKIP[(e * 2 + ord) * 512 + c0 + i]; }
                bf16_t* dst = (nsel ? KRC + ((size_t)(e * 2 + ord) * 512 + c0 + i) * 512 : KRL + ((size_t)(e * 2 + ord) * 512 + c0 + i) * 4096) + x0 + 4 * q;
#pragma unroll
                for (int mt = 0; mt < 4; ++mt) { float val[4];
#pragma unroll
                    for (int r = 0; r < 4; ++r) { const int x = x0 + mt * 16 + 4 * q + r, d = n - x, t = d < 0 ? -d : d;
                        val[r] = acc[mt][r] * __expf(-((float)t * invn) * dv);
                        if (lag0 && mt == 0 && r == 0 && q == 0) val[r] += s0;
                        if (t >= n) val[r] = 0.f; }
                    u32x2 pk; pk.x = pk2(val[0], val[1]); pk.y = pk2(val[2], val[3]); *(u32x2*)(dst + mt * 16) = pk; }
            }
        }
    }
}
DI void phase_init(const Args& a) {
    const float* kp_I_CTX = kin(I_CTX); const float* kp_I_X = kin(I_X);
    bf16_t* XS = (bf16_t*)(a.ws + WS_XS);        bf16_t* AB = (bf16_t*)((unsigned char*)a.out + O_ABUF); const float* MOD = (const float*)(a.ws + WS_MOD);
    const int tid = otid(); const int lane = tid & 63, gw = obid() * NWV + (tid >> 6), NGW = gridDim.x * NWV;
    for (int row = gw; row < T; row += NGW) {
        const float* src = row < TL ? kp_I_X + (size_t)row * 1024 : kp_I_CTX + (size_t)(row - TL) * 1024;
        const int mrow = row < TL ? (row >> 11) : 16; const float* md = MOD + (size_t)mrow * 6144;
#pragma unroll
        for (int j = 0; j < 2; ++j) { const int col = 8 * lane + 512 * j; const f32x4 v0 = *(const f32x4*)(src + col), v1 = *(const f32x4*)(src + col + 4);
            const f32x4 sh0 = *(const f32x4*)(md + col), sh1 = *(const f32x4*)(md + col + 4), sc0 = *(const f32x4*)(md + 1024 + col), sc1 = *(const f32x4*)(md + 1024 + col + 4);
            store_bf8(AB + (size_t)row * 1024 + col, v0 * (sc0 + 1.f) + sh0, v1 * (sc1 + 1.f) + sh1); }
    }
}

DI void phase_uc(const Args& a, int e, LAS unsigned char* lds) {
    const float* kp_I_HYSB = kin(I_HYSB); const float* kp_I_HYSW = kin(I_HYSW);
    const bf16_t* PH = (const bf16_t*)(a.ws + WS_BIG + B_PH); bf16_t* UC = (bf16_t*)(a.ws + WS_BIG + B_UC);
    LAS float* buf = (LAS float*)lds;
    const float* sw = kp_I_HYSW + (size_t)e * 3 * 1536; const float* sb = kp_I_HYSB + (size_t)e * 1536;
    const int tid = otid();
    u32x4 pv[3];
#define UC_LOAD(tile_) do { const int tt_ = (tile_) / 24, cb_ = (tile_) % 24, tok0_ = tt_ * 128; int s0_, s1_; \
        if (tok0_ < TL) { s0_ = tok0_ & ~(SEQ - 1); s1_ = s0_ + SEQ; } else { s0_ = TL + ((tok0_ - TL) & ~(CTXL - 1)); s1_ = s0_ + CTXL; } \
        _Pragma("unroll") for (int k_ = 0; k_ < 3; ++k_) { const int i_ = tid + k_ * NTH; pv[k_] = (u32x4){0u, 0u, 0u, 0u}; \
            if (i_ < 130 * 8) { const int rr_ = i_ >> 3, c8_ = i_ & 7, tok_ = tok0_ - 1 + rr_; if (tok_ >= s0_ && tok_ < s1_) pv[k_] = *(const u32x4*)(PH + (size_t)tok_ * 1536 + cb_ * 64 + c8_ * 8); } } } while (0)
    int tile = obid();
    if (tile < 288 * 24) UC_LOAD(tile);
    for (; tile < 288 * 24; tile += gridDim.x) {
        const int tt = tile / 24, cb = tile % 24, tok0 = tt * 128;
#pragma unroll
        for (int k = 0; k < 3; ++k) { const int i = tid + k * NTH; if (i < 130 * 8) { const int rr = i >> 3, c8 = i & 7; const u32x4 v = pv[k];
            LAS float* d = buf + rr * 97 + c8 * 8 + 2 * (rr >> 3);
            d[0] = __uint_as_float(v.x << 16); d[1] = __uint_as_float(v.x & 0xffff0000u); d[2] = __uint_as_float(v.y << 16); d[3] = __uint_as_float(v.y & 0xffff0000u);
            d[4] = __uint_as_float(v.z << 16); d[5] = __uint_as_float(v.z & 0xffff0000u); d[6] = __uint_as_float(v.w << 16); d[7] = __uint_as_float(v.w & 0xffff0000u); } }
        float wq[2][4];
#pragma unroll
        for (int it = 0; it < 2; ++it) { const int cg = cb * 64 + ((tid + it * NTH) >> 4); wq[it][0] = sw[cg]; wq[it][1] = sw[1536 + cg]; wq[it][2] = sw[3072 + cg]; wq[it][3] = sb[cg]; }
        __syncthreads();
        if (tile + (int)gridDim.x < 288 * 24) UC_LOAD(tile + (int)gridDim.x);
#pragma unroll
        for (int it = 0; it < 2; ++it) { const int i = tid + it * NTH; const int c = i >> 4, ch = i & 15, cg = cb * 64 + c;
            const float w0 = wq[it][0], w1 = wq[it][1], w2 = wq[it][2], bb = wq[it][3]; float o[8];
#pragma unroll
            for (int j = 0; j < 8; ++j) { const int t = ch * 8 + j; o[j] = w0 * buf[t * 97 + c + 2 * (ch + (j >> 3))] + w1 * buf[(t + 1) * 97 + c + 2 * (ch + ((j + 1) >> 3))] + w2 * buf[(t + 2) * 97 + c + 2 * (ch + ((j + 2) >> 3))] + bb; }
            u32x4 w; w.x = pk2(o[0], o[1]); w.y = pk2(o[2], o[3]); w.z = pk2(o[4], o[5]); w.w = pk2(o[6], o[7]);
            *(u32x4*)(UC + (size_t)cg * T + tok0 + ch * 8) = w; }
        __syncthreads();
    }
#undef UC_LOAD
}
template <class F> DI void hy_conv_naive(const LAS bf16_t* U, const LAS bf16_t* KR, int n, const F& out) {
    const int tid = otid(); const int nt4 = n >> 2;
    for (int task = tid; task < 16 * nt4; task += NTH) {
        const int b = task / nt4, t0 = (task % nt4) * 4;
        const LAS bf16_t* ub = U + b * n; float y0 = 0.f, y1 = 0.f, y2 = 0.f, y3 = 0.f;
        int base = n - t0;
        float w1 = base - 1 >= 0 ? bf2f(KR[base - 1]) : 0.f, w2 = base - 2 >= 0 ? bf2f(KR[base - 2]) : 0.f, w3 = base - 3 >= 0 ? bf2f(KR[base - 3]) : 0.f;
        for (int s = 0; s < n; ++s) { const float w0 = bf2f(KR[base + s]); const float uv = bf2f(ub[s]);
            y0 += w0 * uv; y1 += w1 * uv; y2 += w2 * uv; y3 += w3 * uv; w3 = w2; w2 = w1; w1 = w0; }
        out(b, t0, y0, y1, y2, y3);
    }
}
struct HyOutZ { LAS bf16_t* Z; const bf16_t* x1; int n; int tokbase; int tstride;
    DI void operator()(int b, int t0, float y0, float y1, float y2, float y3) const { const u32x2 xv = *(const u32x2*)(x1 + tokbase + b * tstride + t0);
        const float a0 = __uint_as_float(xv.x << 16), a1 = __uint_as_float(xv.x & 0xffff0000u), a2 = __uint_as_float(xv.y << 16), a3 = __uint_as_float(xv.y & 0xffff0000u);
        u32x2 w; w.x = pk2(a0 * y0, a1 * y1); w.y = pk2(a2 * y2, a3 * y3); *(LAS u32x2*)(Z + b * n + t0) = w; } };
struct HyOutY { bf16_t* yh; const bf16_t* x2; int tokbase; int tstride;
    DI void operator()(int b, int t0, float y0, float y1, float y2, float y3) const { const u32x2 xv = *(const u32x2*)(x2 + tokbase + b * tstride + t0);
        const float a0 = __uint_as_float(xv.x << 16), a1 = __uint_as_float(xv.x & 0xffff0000u), a2 = __uint_as_float(xv.y << 16), a3 = __uint_as_float(xv.y & 0xffff0000u);
        u32x2 w; w.x = pk2(a0 * y0, a1 * y1); w.y = pk2(a2 * y2, a3 * y3); *(u32x2*)(yh + tokbase + b * tstride + t0) = w; } };
DI void hyena_unit_naive(const Args& a, int e, int c, int nsel, LAS unsigned char* lds) {
    const int n = nsel ? CTXL : SEQ, tokbase = nsel ? TL : 0, tid = otid();
    const bf16_t* UC = (const bf16_t*)(a.ws + WS_BIG + B_UC); bf16_t* YH = (bf16_t*)(a.ws + WS_BIG + B_YH);
    const bf16_t* kr0 = nsel ? (const bf16_t*)(a.ws + WS_KRC) + ((size_t)(e * 2 + 0) * 512 + c) * 512 : (const bf16_t*)(a.ws + WS_KRL) + ((size_t)(e * 2 + 0) * 512 + c) * 4096;
    const bf16_t* kr1 = nsel ? (const bf16_t*)(a.ws + WS_KRC) + ((size_t)(e * 2 + 1) * 512 + c) * 512 : (const bf16_t*)(a.ws + WS_KRL) + ((size_t)(e * 2 + 1) * 512 + c) * 4096;
    LAS bf16_t* U = (LAS bf16_t*)lds; LAS bf16_t* Z = U + 16 * SEQ; LAS bf16_t* KR = Z + 16 * SEQ;
    const bf16_t* vrow = UC + (size_t)c * T + tokbase;
    for (int i = tid; i < 16 * n / 8; i += NTH) { const int el = i * 8; *(LAS u32x4*)(U + el) = *(const u32x4*)(vrow + el); }
    for (int i = tid; i < 2 * n / 8; i += NTH) *(LAS u32x4*)(KR + i * 8) = *(const u32x4*)(kr0 + i * 8);
    __syncthreads();
    { HyOutZ o{Z, UC + (size_t)(512 + c) * T, n, tokbase, n}; hy_conv_naive(U, KR, n, o); }
    __syncthreads();
    for (int i = tid; i < 2 * n / 8; i += NTH) *(LAS u32x4*)(KR + i * 8) = *(const u32x4*)(kr1 + i * 8);
    __syncthreads();
    { HyOutY o{YH + (size_t)c * T, UC + (size_t)(1024 + c) * T, tokbase, n}; hy_conv_naive(Z, KR, n, o); }
    __syncthreads();
}
constexpr int HY_RS = 4112, HY_CS = 8208;
DI void hy_build_kc(const bf16_t* kr, int n, LAS unsigned char* KC, int tid) {
    for (int x8 = tid; x8 < 2 * n / 8; x8 += NTH) {
        const u32x4 lo = *(const u32x4*)(kr + x8 * 8); u32x4 hi = {0u, 0u, 0u, 0u}; if (x8 + 1 < 2 * n / 8) hi = *(const u32x4*)(kr + x8 * 8 + 8);
        const unsigned w[9] = {lo.x, lo.y, lo.z, lo.w, hi.x, hi.y, hi.z, hi.w, 0u};
#pragma unroll
        for (int r = 0; r < 8; ++r) { u32x4 o; const int k = r >> 1;
            if ((r & 1) == 0) { o.x = w[k]; o.y = w[k + 1]; o.z = w[k + 2]; o.w = w[k + 3]; }
            else { o.x = __builtin_amdgcn_alignbit(w[k + 1], w[k], 16); o.y = __builtin_amdgcn_alignbit(w[k + 2], w[k + 1], 16); o.z = __builtin_amdgcn_alignbit(w[k + 3], w[k + 2], 16); o.w = __builtin_amdgcn_alignbit(w[k + 4], w[k + 3], 16); }
            *(LAS u32x4*)(KC + r * HY_CS + x8 * 16) = o; }
    }
}
template <int NTW> DI void hy_conv_mfma(const LAS unsigned char* Ub, const LAS unsigned char* KC, int wave, int lane, f32x4 (&acc)[NTW]) {
    constexpr int n = NTW * 128;
    const int i = lane & 15, q = lane >> 4, r = (8 - (i & 7)) & 7, t0w = wave * NTW * 16;
    const LAS unsigned char* ap = KC + r * HY_CS + 2 * (8 * q - t0w - 16 * (NTW - 1) - i + n - r);
    const LAS unsigned char* bp = Ub + i * HY_RS + 16 * q;
#pragma unroll
    for (int k = 0; k < NTW; ++k) acc[k] = (f32x4){0.f, 0.f, 0.f, 0.f};
    if constexpr (NTW == 16) {
        bf16x8 R[16];
#pragma unroll
        for (int k = 0; k < 16; ++k) R[k] = *(const LAS bf16x8*)(ap + 32 * (15 - k));
        for (int s8 = 0; s8 < n / 32; s8 += 8) {
#pragma unroll
            for (int ss = 0; ss < 8; ++ss) { const int s = s8 + ss;
                const bf16x8 bf = *(const LAS bf16x8*)(bp + 64 * s);
                bf16x8 n0, n1; const bool more = (s + 1 < n / 32);
                if (more) { n0 = *(const LAS bf16x8*)(ap + 64 * (s + 1) + 32 * 15); n1 = *(const LAS bf16x8*)(ap + 64 * (s + 1) + 32 * 14); }
#pragma unroll
                for (int k = 0; k < 16; ++k) acc[k] = mfma16(R[(k - 2 * ss) & 15], bf, acc[k]);
                if (more) { R[(0 - 2 * (ss + 1)) & 15] = n0; R[(1 - 2 * (ss + 1)) & 15] = n1; } }
        }
    } else {
#pragma unroll 2
        for (int s0c = 0; s0c < n / 32; ++s0c) {
            const bf16x8 bf = *(const LAS bf16x8*)(bp + 64 * s0c);
#pragma unroll
            for (int k = 0; k < NTW; ++k) { const bf16x8 af = *(const LAS bf16x8*)(ap + 64 * s0c + 32 * (NTW - 1 - k)); acc[k] = mfma16(af, bf, acc[k]); }
        }
    }
}
template <int NTW> DI void hyena_unit_fast(const Args& a, int e, int c, LAS unsigned char* lds) {
    constexpr int n = NTW * 128; constexpr int nsel = (n == CTXL) ? 1 : 0; constexpr int tokbase = nsel ? TL : 0;
    const int tid = otid(), wave = tid >> 6, lane = tid & 63, b = lane & 15, q = lane >> 4;
    const bf16_t* UC = (const bf16_t*)(a.ws + WS_BIG + B_UC); bf16_t* YH = (bf16_t*)(a.ws + WS_BIG + B_YH);
    const bf16_t* kr0 = nsel ? (const bf16_t*)(a.ws + WS_KRC) + ((size_t)(e * 2 + 0) * 512 + c) * 512 : (const bf16_t*)(a.ws + WS_KRL) + ((size_t)(e * 2 + 0) * 512 + c) * 4096;
    const bf16_t* kr1 = nsel ? (const bf16_t*)(a.ws + WS_KRC) + ((size_t)(e * 2 + 1) * 512 + c) * 512 : (const bf16_t*)(a.ws + WS_KRL) + ((size_t)(e * 2 + 1) * 512 + c) * 4096;
    LAS unsigned char* Ub = lds; LAS unsigned char* KC = lds + 16 * HY_RS;
    const bf16_t* vrow = UC + (size_t)c * T + tokbase; const bf16_t* x1row = UC + (size_t)(512 + c) * T + tokbase; const bf16_t* x2row = UC + (size_t)(1024 + c) * T + tokbase;
    bf16_t* yrow = YH + (size_t)c * T + tokbase;
    for (int idx = tid; idx < 16 * n / 8; idx += NTH) { const int bb = idx / (n / 8), ch = idx % (n / 8); *(LAS u32x4*)(Ub + bb * HY_RS + ch * 16) = *(const u32x4*)(vrow + bb * n + ch * 8); }
    hy_build_kc(kr0, n, KC, tid);
    __syncthreads();
    f32x4 acc[NTW]; u32x2 zp[NTW];
    hy_conv_mfma<NTW>(Ub, KC, wave, lane, acc);
#pragma unroll
    for (int k = 0; k < NTW; ++k) { const int t = wave * NTW * 16 + 16 * k + 4 * q; const u32x2 xv = *(const u32x2*)(x1row + b * n + t);
        zp[k].x = pk2(__uint_as_float(xv.x << 16) * acc[k][0], __uint_as_float(xv.x & 0xffff0000u) * acc[k][1]); zp[k].y = pk2(__uint_as_float(xv.y << 16) * acc[k][2], __uint_as_float(xv.y & 0xffff0000u) * acc[k][3]); }
    __syncthreads();
#pragma unroll
    for (int k = 0; k < NTW; ++k) { const int t = wave * NTW * 16 + 16 * k + 4 * q; *(LAS u32x2*)(Ub + b * HY_RS + t * 2) = zp[k]; }
    hy_build_kc(kr1, n, KC, tid);
    __syncthreads();
    hy_conv_mfma<NTW>(Ub, KC, wave, lane, acc);
#pragma unroll
    for (int k = 0; k < NTW; ++k) { const int t = wave * NTW * 16 + 16 * k + 4 * q; const u32x2 xv = *(const u32x2*)(x2row + b * n + t);
        zp[k].x = pk2(__uint_as_float(xv.x << 16) * acc[k][0], __uint_as_float(xv.x & 0xffff0000u) * acc[k][1]); zp[k].y = pk2(__uint_as_float(xv.y << 16) * acc[k][2], __uint_as_float(xv.y & 0xffff0000u) * acc[k][3]); }
    __syncthreads();
#pragma unroll
    for (int k = 0; k < NTW; ++k) { const int t = wave * NTW * 16 + 16 * k + 4 * q; *(LAS u32x2*)(Ub + b * HY_RS + t * 2) = zp[k]; }
    __syncthreads();
    for (int idx = tid; idx < 16 * n / 8; idx += NTH) { const int bb = idx / (n / 8), ch = idx % (n / 8); *(u32x4*)(yrow + bb * n + ch * 8) = *(const LAS u32x4*)(Ub + bb * HY_RS + ch * 16); }
    __syncthreads();
}
DI void attn_unit_naive(const Args& a, int l, int isctx, int b, int h, int qb, LAS unsigned char* lds) {
    const float* kp_I_LK1 = kin(I_LK1); const float* kp_I_LK2 = kin(I_LK2); const float* kp_I_LQ1 = kin(I_LQ1); const float* kp_I_LQ2 = kin(I_LQ2); const float* kp_I_SUBG = kin(I_SUBG);
    const bf16_t* QB = (const bf16_t*)(a.ws + WS_BIG + B_QB); const bf16_t* KB = (const bf16_t*)(a.ws + WS_BIG + B_KB); const bf16_t* VB = (const bf16_t*)(a.ws + WS_BIG + B_VB);
    bf16_t* MIXA = (bf16_t*)(a.ws + WS_BIG + B_MIXA_E);
    LAS bf16_t* Ks = (LAS bf16_t*)lds; LAS bf16_t* Vs = Ks + 64 * 128; LAS float* ex = (LAS float*)(lds + 32768); LAS float* ssq = ex + 64 * 128;
    const int tid = otid(), r = tid & 63, s = (tid >> 6) & 1, qt = tid >> 7, e = l >> 1;
    const int qrow = isctx ? TL + b * CTXL + qb * 64 + r : b * SEQ + qb * 64 + r;
    float q[64], o[32];
    { const bf16_t* qp = QB + (size_t)qrow * 512 + h * 128 + s * 64;
#pragma unroll
      for (int d8 = 0; d8 < 8; ++d8) { const u32x4 v = *(const u32x4*)(qp + d8 * 8);
          q[d8 * 8 + 0] = __uint_as_float(v.x << 16); q[d8 * 8 + 1] = __uint_as_float(v.x & 0xffff0000u); q[d8 * 8 + 2] = __uint_as_float(v.y << 16); q[d8 * 8 + 3] = __uint_as_float(v.y & 0xffff0000u);
          q[d8 * 8 + 4] = __uint_as_float(v.z << 16); q[d8 * 8 + 5] = __uint_as_float(v.z & 0xffff0000u); q[d8 * 8 + 6] = __uint_as_float(v.w << 16); q[d8 * 8 + 7] = __uint_as_float(v.w & 0xffff0000u); } }
#pragma unroll
    for (int i = 0; i < 32; ++i) o[i] = 0.f;
    float m = -INFINITY, lsum = 0.f;
    const int ntiles = isctx ? 4 : 36;
    for (int kt = 0; kt < ntiles; ++kt) {
        const int krow0 = (kt < 4) ? TL + b * CTXL + kt * 64 : b * SEQ + (kt - 4) * 64;
        __syncthreads();
        for (int i = tid; i < 1024; i += NTH) { const int key = i >> 4, ch = i & 15;
            *(LAS u32x4*)(Ks + key * 128 + ch * 8) = *(const u32x4*)(KB + (size_t)(krow0 + key) * 512 + h * 128 + ch * 8);
            *(LAS u32x4*)(Vs + key * 128 + ch * 8) = *(const u32x4*)(VB + (size_t)(krow0 + key) * 512 + h * 128 + ch * 8); }
        __syncthreads();
        for (int kg = 0; kg < 64; kg += 4) {
            float sc[4];
#pragma unroll
            for (int kk = 0; kk < 4; ++kk) { const LAS bf16_t* kp = Ks + (kg + kk) * 128 + s * 64; float acc = 0.f;
#pragma unroll
                for (int d8 = 0; d8 < 8; ++d8) { const u32x4 v = *(const LAS u32x4*)(kp + d8 * 8);
                    acc += q[d8 * 8 + 0] * __uint_as_float(v.x << 16) + q[d8 * 8 + 1] * __uint_as_float(v.x & 0xffff0000u) + q[d8 * 8 + 2] * __uint_as_float(v.y << 16) + q[d8 * 8 + 3] * __uint_as_float(v.y & 0xffff0000u)
                         + q[d8 * 8 + 4] * __uint_as_float(v.z << 16) + q[d8 * 8 + 5] * __uint_as_float(v.z & 0xffff0000u) + q[d8 * 8 + 6] * __uint_as_float(v.w << 16) + q[d8 * 8 + 7] * __uint_as_float(v.w & 0xffff0000u); }
                sc[kk] = acc; }
            const float mx = fmaxf(fmaxf(sc[0], sc[1]), fmaxf(sc[2], sc[3]));
            const float mn = fmaxf(m, mx); const float corr = exp2f(m - mn); m = mn; lsum *= corr;
#pragma unroll
            for (int i = 0; i < 32; ++i) o[i] *= corr;
#pragma unroll
            for (int kk = 0; kk < 4; ++kk) { const float p = exp2f(sc[kk] - mn); lsum += p; const LAS bf16_t* vp = Vs + (kg + kk) * 128 + qt * 32;
#pragma unroll
                for (int d8 = 0; d8 < 4; ++d8) { const u32x4 v = *(const LAS u32x4*)(vp + d8 * 8);
                    o[d8 * 8 + 0] += p * __uint_as_float(v.x << 16); o[d8 * 8 + 1] += p * __uint_as_float(v.x & 0xffff0000u); o[d8 * 8 + 2] += p * __uint_as_float(v.y << 16); o[d8 * 8 + 3] += p * __uint_as_float(v.y & 0xffff0000u);
                    o[d8 * 8 + 4] += p * __uint_as_float(v.z << 16); o[d8 * 8 + 5] += p * __uint_as_float(v.z & 0xffff0000u); o[d8 * 8 + 6] += p * __uint_as_float(v.w << 16); o[d8 * 8 + 7] += p * __uint_as_float(v.w & 0xffff0000u); } }
        }
    }
    const float inv = 1.f / lsum;
    float d1 = 0.f, d2 = 0.f;
    for (int i = 0; i < 64; ++i) { d1 += kp_I_LQ1[e * 64 + i] * kp_I_LK1[e * 64 + i]; d2 += kp_I_LQ2[e * 64 + i] * kp_I_LK2[e * 64 + i]; }
    const float lam_init = 0.8f - 0.6f * expf(-0.3f * (float)l);
    const float lam = expf(d1) - expf(d2) + lam_init;
    __syncthreads();
    if (s == 1) {
#pragma unroll
        for (int i = 0; i < 32; ++i) ex[r * 128 + qt * 32 + i] = o[i] * inv; }
    __syncthreads();
    if (s == 0) { float ss = 0.f;
#pragma unroll
        for (int i = 0; i < 32; ++i) { o[i] = o[i] * inv - lam * ex[r * 128 + qt * 32 + i]; ss += o[i] * o[i]; }
        ssq[r * 4 + qt] = ss; }
    __syncthreads();
    if (s == 0) { const float tot = (ssq[r * 4] + ssq[r * 4 + 1]) + (ssq[r * 4 + 2] + ssq[r * 4 + 3]); const float rs = rsqrtf(tot * (1.f / 128.f) + LN_EPS) * (1.f - lam_init);
        const float* g = kp_I_SUBG + e * 128 + qt * 32; bf16_t* dst = MIXA + (size_t)qrow * 1024 + 512 + h * 128 + qt * 32;
#pragma unroll
        for (int i = 0; i < 32; i += 4) { f32x4 v = {o[i] * rs * g[i], o[i + 1] * rs * g[i + 1], o[i + 2] * rs * g[i + 2], o[i + 3] * rs * g[i + 3]}; store_bf4(dst + i, v); } }
    __syncthreads();
}
typedef float f32x16 __attribute__((ext_vector_type(16)));
typedef short s16x4 __attribute__((ext_vector_type(4)));
constexpr int AT_KS = 272, AT_VS = 288, AT_KB = 64 * AT_KS, AT_VB = 64 * AT_VS;
constexpr int AT_EX = 2 * AT_KB + 2 * AT_VB;
DI f32x16 mfma32(bf16x8 a, bf16x8 b, f32x16 c) { return __builtin_amdgcn_mfma_f32_32x32x16_bf16(a, b, c, 0, 0, 0); }
DI s16x4 tr_read(const LAS unsigned char* p) { return __builtin_bit_cast(s16x4, __builtin_amdgcn_ds_read_tr16_b64_v4i16((LAS s16x4*)p)); }
DI void attn_unit_fast(const Args& a, int l, int isctx, int b, int hd, int qb, LAS unsigned char* lds) {
    const float* kp_I_LK1 = kin(I_LK1); const float* kp_I_LK2 = kin(I_LK2); const float* kp_I_LQ1 = kin(I_LQ1); const float* kp_I_LQ2 = kin(I_LQ2); const float* kp_I_SUBG = kin(I_SUBG);
    const bf16_t* QB = (const bf16_t*)(a.ws + WS_BIG + B_QB); const bf16_t* KB = (const bf16_t*)(a.ws + WS_BIG + B_KB); const bf16_t* VB = (const bf16_t*)(a.ws + WS_BIG + B_VB);
    bf16_t* MIXA = (bf16_t*)(a.ws + WS_BIG + B_MIXA_E);
    const int tid = otid(), wave = tid >> 6, lane = tid & 63, s = wave >> 2, r32 = lane & 31, hi = lane >> 5, e = l >> 1;
    const int qrow0 = isctx ? TL + b * CTXL + qb * 128 : b * SEQ + qb * 128;
    const int qrow = qrow0 + 32 * (wave & 3) + r32;
    bf16x8 qf[4];
#pragma unroll
    for (int d0 = 0; d0 < 4; ++d0) qf[d0] = *(const bf16x8*)(QB + (size_t)qrow * 512 + hd * 128 + s * 64 + 16 * d0 + 8 * hi);
    f32x16 O[4];
#pragma unroll
    for (int eb = 0; eb < 4; ++eb)
#pragma unroll
        for (int r = 0; r < 16; ++r) O[eb][r] = 0.f;
    float m = -INFINITY, lsum = 0.f;
    const int ntiles = isctx ? 4 : 36;
    u32x4 preK[2], preV[2];
    const int ck = tid >> 4, cc = tid & 15;
#define AT_ROW0(kt_) (((kt_) < 4) ? TL + b * CTXL + (kt_) * 64 : b * SEQ + ((kt_) - 4) * 64)
#define AT_LOADK(kt_) do { const int kr0_ = AT_ROW0(kt_); preK[0] = *(const u32x4*)(KB + (size_t)(kr0_ + ck) * 512 + hd * 128 + cc * 8); preK[1] = *(const u32x4*)(KB + (size_t)(kr0_ + ck + 32) * 512 + hd * 128 + cc * 8); } while (0)
#define AT_LOADV(kt_) do { const int kr0_ = AT_ROW0(kt_); preV[0] = *(const u32x4*)(VB + (size_t)(kr0_ + ck) * 512 + hd * 128 + cc * 8); preV[1] = *(const u32x4*)(VB + (size_t)(kr0_ + ck + 32) * 512 + hd * 128 + cc * 8); } while (0)
#define AT_STOREK(buf_) do { *(LAS u32x4*)(lds + (buf_) * AT_KB + ck * AT_KS + cc * 16) = preK[0]; *(LAS u32x4*)(lds + (buf_) * AT_KB + (ck + 32) * AT_KS + cc * 16) = preK[1]; } while (0)
#define AT_STOREV(buf_) do { *(LAS u32x4*)(lds + 2 * AT_KB + (buf_) * AT_VB + ck * AT_VS + cc * 16) = preV[0]; *(LAS u32x4*)(lds + 2 * AT_KB + (buf_) * AT_VB + (ck + 32) * AT_VS + cc * 16) = preV[1]; } while (0)
#define AT_QK(P0_, P1_, buf_) do { const LAS unsigned char* Kt_ = lds + (buf_) * AT_KB + koff; \
        _Pragma("unroll") for (int r = 0; r < 16; ++r) { P0_[r] = 0.f; P1_[r] = 0.f; } \
        bf16x8 kf_[8]; _Pragma("unroll") for (int d0 = 0; d0 < 4; ++d0) { kf_[2 * d0] = *(const LAS bf16x8*)(Kt_ + d0 * 32); kf_[2 * d0 + 1] = *(const LAS bf16x8*)(Kt_ + 32 * AT_KS + d0 * 32); } \
        __builtin_amdgcn_sched_barrier(0); \
        _Pragma("unroll") for (int d0 = 0; d0 < 4; ++d0) { P0_ = mfma32(kf_[2 * d0], qf[d0], P0_); P1_ = mfma32(kf_[2 * d0 + 1], qf[d0], P1_); } } while (0)
    const int i16 = lane & 15, qq = i16 >> 2, p4 = i16 & 3, blk16 = (lane >> 4) & 1;
    const int koff = r32 * AT_KS + s * 128 + hi * 16;
    const int voff = (4 * hi + qq) * AT_VS + (16 * blk16 + 4 * p4) * 2;
    AT_LOADK(0); AT_LOADV(0); AT_STOREK(0); AT_STOREV(0);
    AT_LOADK(1); AT_STOREK(1);
    __syncthreads();
    f32x16 P0, P1, N0, N1;
    AT_QK(P0, P1, 0);
    for (int kt = 0; kt < ntiles; ++kt) {
        const int buf = kt & 1;
        if (kt + 2 < ntiles) AT_LOADK(kt + 2);
        if (kt + 1 < ntiles) { AT_LOADV(kt + 1); AT_QK(N0, N1, buf ^ 1); }
        const LAS unsigned char* Vt = lds + 2 * AT_KB + buf * AT_VB + voff;
        float mx = fmaxf(P0[0], P1[0]);
#pragma unroll
        for (int r = 1; r < 16; ++r) mx = fmaxf(mx, fmaxf(P0[r], P1[r]));
        mx = xor32_max(mx);
        if (__any(mx > m + 6.f)) { const float mn = fmaxf(m, mx); const float corr = __builtin_amdgcn_exp2f(m - mn); m = mn; lsum *= corr;
#pragma unroll
            for (int eb = 0; eb < 4; ++eb) O[eb] = O[eb] * corr; }
        float ps = 0.f;
#pragma unroll
        for (int r = 0; r < 16; ++r) { P0[r] = __builtin_amdgcn_exp2f(P0[r] - m); P1[r] = __builtin_amdgcn_exp2f(P1[r] - m); ps += P0[r] + P1[r]; }
        lsum += ps;
        bf16x8 pa[4];
#pragma unroll
        for (int s2 = 0; s2 < 2; ++s2) { u32x4 w0, w1;
            w0.x = pk2(P0[8 * s2 + 0], P0[8 * s2 + 1]); w0.y = pk2(P0[8 * s2 + 2], P0[8 * s2 + 3]); w0.z = pk2(P0[8 * s2 + 4], P0[8 * s2 + 5]); w0.w = pk2(P0[8 * s2 + 6], P0[8 * s2 + 7]);
            w1.x = pk2(P1[8 * s2 + 0], P1[8 * s2 + 1]); w1.y = pk2(P1[8 * s2 + 2], P1[8 * s2 + 3]); w1.z = pk2(P1[8 * s2 + 4], P1[8 * s2 + 5]); w1.w = pk2(P1[8 * s2 + 6], P1[8 * s2 + 7]);
            pa[s2] = __builtin_bit_cast(bf16x8, w0); pa[2 + s2] = __builtin_bit_cast(bf16x8, w1); }
        { s16x4 vl[2][4], vh[2][4];
#pragma unroll
          for (int ks = 0; ks < 4; ++ks) { vl[0][ks] = tr_read(Vt + ks * 16 * AT_VS); vh[0][ks] = tr_read(Vt + ks * 16 * AT_VS + 8 * AT_VS); }
#pragma unroll
          for (int eb = 0; eb < 4; ++eb) {
              if (eb < 3) {
#pragma unroll
                  for (int ks = 0; ks < 4; ++ks) { vl[(eb + 1) & 1][ks] = tr_read(Vt + ks * 16 * AT_VS + (eb + 1) * 64); vh[(eb + 1) & 1][ks] = tr_read(Vt + ks * 16 * AT_VS + (eb + 1) * 64 + 8 * AT_VS); } }
              __builtin_amdgcn_sched_barrier(0);
#pragma unroll
              for (int ks = 0; ks < 4; ++ks) { const bf16x8 vf = __builtin_shufflevector(vl[eb & 1][ks], vh[eb & 1][ks], 0, 1, 2, 3, 4, 5, 6, 7); O[eb] = mfma32(vf, pa[ks], O[eb]); }
              __builtin_amdgcn_sched_barrier(0); } }
        if (kt + 2 < ntiles) AT_STOREK(buf);
        if (kt + 1 < ntiles) AT_STOREV(buf ^ 1);
        __syncthreads();
        P0 = N0; P1 = N1;
    }
#undef AT_ROW0
#undef AT_LOADK
#undef AT_LOADV
#undef AT_STOREK
#undef AT_STOREV
#undef AT_QK
    const float ltot = xor32_sum(lsum); const float inv = 1.f / ltot;
    float d1 = 0.f, d2 = 0.f;
    for (int i = 0; i < 64; ++i) { d1 += kp_I_LQ1[e * 64 + i] * kp_I_LK1[e * 64 + i]; d2 += kp_I_LQ2[e * 64 + i] * kp_I_LK2[e * 64 + i]; }
    const float lam_init = 0.8f - 0.6f * expf(-0.3f * (float)l);
    const float lam = expf(d1) - expf(d2) + lam_init;
    LAS float* ex = (LAS float*)(lds + AT_EX); const int lrow = 32 * (wave & 3) + r32;
    if (s == 1) {
#pragma unroll
        for (int eb = 0; eb < 4; ++eb)
#pragma unroll
            for (int r = 0; r < 16; ++r) ex[lrow * 129 + eb * 32 + (r & 3) + 8 * (r >> 2) + 4 * hi] = O[eb][r] * inv; }
    __syncthreads();
    if (s == 0) { float ss = 0.f;
#pragma unroll
        for (int eb = 0; eb < 4; ++eb)
#pragma unroll
            for (int r = 0; r < 16; ++r) { const float dv = O[eb][r] * inv - lam * ex[lrow * 129 + eb * 32 + (r & 3) + 8 * (r >> 2) + 4 * hi]; O[eb][r] = dv; ss += dv * dv; }
        ss = xor32_sum(ss);
        const float rs = rsqrtf(ss * (1.f / 128.f) + LN_EPS) * (1.f - lam_init); const float* g = kp_I_SUBG + e * 128;
        LAS bf16_t* st = (LAS bf16_t*)lds;
#pragma unroll
        for (int eb = 0; eb < 4; ++eb)
#pragma unroll
            for (int r4 = 0; r4 < 4; ++r4) { const int e0 = eb * 32 + 8 * r4 + 4 * hi; u32x2 w;
                w.x = pk2(O[eb][4 * r4] * rs * g[e0], O[eb][4 * r4 + 1] * rs * g[e0 + 1]); w.y = pk2(O[eb][4 * r4 + 2] * rs * g[e0 + 2], O[eb][4 * r4 + 3] * rs * g[e0 + 3]);
                *(LAS u32x2*)(st + lrow * 136 + e0) = w; } }
    __syncthreads();
    { const LAS bf16_t* st = (const LAS bf16_t*)lds;
      for (int i = tid; i < 128 * 16; i += NTH) { const int row = i >> 4, ch = i & 15; *(u32x4*)(MIXA + (size_t)(qrow0 + row) * 1024 + 512 + hd * 128 + ch * 8) = *(const LAS u32x4*)(st + row * 136 + ch * 8); } }
    __syncthreads();
}
DI void phase_yh_t(const Args& a, LAS unsigned char* lds, int vbx, int vG) {
    const bf16_t* YH = (const bf16_t*)(a.ws + WS_BIG + B_YH); bf16_t* MIXA = (bf16_t*)(a.ws + WS_BIG + B_MIXA_E);
    LAS bf16_t* buf = (LAS bf16_t*)lds;
    const int tid = otid();
    u32x4 pv[2];
#define YT_LOAD(tile_) do { const int tt_ = (tile_) >> 3, cb_ = (tile_) & 7; _Pragma("unroll") for (int k_ = 0; k_ < 2; ++k_) { const int i_ = tid + k_ * NTH, c_ = i_ >> 4, ch_ = i_ & 15; \
        pv[k_] = *(const u32x4*)(YH + (size_t)(cb_ * 64 + c_) * T + tt_ * 128 + ch_ * 8); } } while (0)
    int tile = vbx;
    if (tile < 288 * 8) YT_LOAD(tile);
    for (; tile < 288 * 8; tile += vG) {
        const int tt = tile >> 3, cb = tile & 7, tok0 = tt * 128;
#pragma unroll
        for (int k = 0; k < 2; ++k) { const int i = tid + k * NTH, c = i >> 4, ch = i & 15; *(LAS u32x4*)(buf + c * 136 + ch * 8) = pv[k]; }
        __syncthreads();
        if (tile + vG < 288 * 8) YT_LOAD(tile + vG);
        for (int i = tid; i < 128 * 8; i += NTH) { const int tk = i >> 3, c8 = i & 7; unsigned short v[8];
#pragma unroll
            for (int j = 0; j < 8; ++j) v[j] = buf[(c8 * 8 + j) * 136 + tk];
            u32x4 w; w.x = v[0] | ((unsigned)v[1] << 16); w.y = v[2] | ((unsigned)v[3] << 16); w.z = v[4] | ((unsigned)v[5] << 16); w.w = v[6] | ((unsigned)v[7] << 16);
            *(u32x4*)(MIXA + (size_t)(tok0 + tk) * 1024 + cb * 64 + c8 * 8) = w; }
        __syncthreads();
    }
#undef YT_LOAD
}

DI void phase_rgconv(const Args& a, int o) {
    const float* kp_I_RGCB = kin(I_RGCB); const float* kp_I_RGCW = kin(I_RGCW);
    const bf16_t* REC = (const bf16_t*)(a.ws + WS_BIG + B_REC); bf16_t* U = (bf16_t*)(a.ws + WS_BIG + B_U);
    const float* cw = kp_I_RGCW + (size_t)o * 4 * 1024; const float* cb = kp_I_RGCB + (size_t)o * 1024;
    for (int task = obid() * NTH + otid(); task < 1024 * 128; task += gridDim.x * NTH) {
        const int rb = task >> 7, c8 = (task & 127) * 8, r0 = rb * 36;
        float w[4][8], bias[8];
#pragma unroll
        for (int k = 0; k < 4; ++k) { const f32x4 wa = *(const f32x4*)(cw + k * 1024 + c8), wb = *(const f32x4*)(cw + k * 1024 + c8 + 4);
            w[k][0] = wa[0]; w[k][1] = wa[1]; w[k][2] = wa[2]; w[k][3] = wa[3]; w[k][4] = wb[0]; w[k][5] = wb[1]; w[k][6] = wb[2]; w[k][7] = wb[3]; }
        { const f32x4 ba = *(const f32x4*)(cb + c8), bb = *(const f32x4*)(cb + c8 + 4); bias[0] = ba[0]; bias[1] = ba[1]; bias[2] = ba[2]; bias[3] = ba[3]; bias[4] = bb[0]; bias[5] = bb[1]; bias[6] = bb[2]; bias[7] = bb[3]; }
#define RG_LD(rr_) (*(const u32x4*)(REC + (size_t)((rr_) < 0 ? 0 : ((rr_) > T - 1 ? T - 1 : (rr_))) * 1024 + c8))
#define RG_TAP(k_, v_, rr_) do { if ((rr_) >= s0 && (rr_) < s1) { const u32x4 t_ = (v_); \
            acc[0] += w[k_][0] * __uint_as_float(t_.x << 16); acc[1] += w[k_][1] * __uint_as_float(t_.x & 0xffff0000u); acc[2] += w[k_][2] * __uint_as_float(t_.y << 16); acc[3] += w[k_][3] * __uint_as_float(t_.y & 0xffff0000u); \
            acc[4] += w[k_][4] * __uint_as_float(t_.z << 16); acc[5] += w[k_][5] * __uint_as_float(t_.z & 0xffff0000u); acc[6] += w[k_][6] * __uint_as_float(t_.w << 16); acc[7] += w[k_][7] * __uint_as_float(t_.w & 0xffff0000u); } } while (0)
        u32x4 p0 = RG_LD(r0 - 2), p1 = RG_LD(r0 - 1), p2 = RG_LD(r0);
#pragma unroll 1
        for (int b = 0; b < 3; ++b) { u32x4 nv[12];
#pragma unroll
            for (int j = 0; j < 12; ++j) nv[j] = RG_LD(r0 + b * 12 + j + 1);
#pragma unroll
            for (int j = 0; j < 12; ++j) { const int row = r0 + b * 12 + j;
                int s0, s1; if (row < TL) { s0 = row & ~(SEQ - 1); s1 = s0 + SEQ; } else { s0 = TL + ((row - TL) & ~(CTXL - 1)); s1 = s0 + CTXL; }
                float acc[8];
#pragma unroll
                for (int jj = 0; jj < 8; ++jj) acc[jj] = bias[jj];
                RG_TAP(0, p0, row - 2); RG_TAP(1, p1, row - 1); RG_TAP(2, p2, row); RG_TAP(3, nv[j], row + 1);
                u32x4 ov; ov.x = pk2(acc[0], acc[1]); ov.y = pk2(acc[2], acc[3]); ov.z = pk2(acc[4], acc[5]); ov.w = pk2(acc[6], acc[7]);
                *(u32x4*)(U + (size_t)row * 1024 + c8) = ov;
                p0 = p1; p1 = p2; p2 = nv[j]; }
        }
#undef RG_LD
#undef RG_TAP
    }
}
DI int scan_chunk_of(int dir, int jj) { return dir == 0 ? jj : (jj < 8 ? 7 - jj : 79 - jj); }
DI int chunk_row0(int b, int chunk) { return chunk < 8 ? TL + b * CTXL + chunk * 32 : b * SEQ + (chunk - 8) * 32; }
DI void phase_scan1(const Args& a) {
    const bf16_t* LA = (const bf16_t*)(a.ws + WS_BIG + B_LA); const bf16_t* BB = (const bf16_t*)(a.ws + WS_BIG + B_BB);
    float* CT = (float*)((unsigned char*)a.out + O_CT);
    for (int idx = obid() * NTH + otid(); idx < 2 * 16 * 72 * 512; idx += gridDim.x * NTH) {
        const int ch = (idx & 511) * 2, g = idx >> 9, chunk = g % 72, b = (g / 72) & 15, dir = g / (72 * 16);
        const int row0 = chunk_row0(b, chunk); const bf16_t* la = LA + ((size_t)dir * T + row0) * 1024 + ch; const bf16_t* bb = BB + ((size_t)dir * T + row0) * 1024 + ch;
        float P0 = 1.f, Q0 = 0.f, P1 = 1.f, Q1 = 0.f;
        for (int i0 = 0; i0 < 32; i0 += 16) { unsigned lv[16], bv[16];
#pragma unroll
            for (int i = 0; i < 16; ++i) { const int ii = dir ? 31 - (i0 + i) : i0 + i; lv[i] = *(const unsigned*)(la + (size_t)ii * 1024); bv[i] = *(const unsigned*)(bb + (size_t)ii * 1024); }
#pragma unroll
            for (int i = 0; i < 16; ++i) { const float a0 = __expf(__uint_as_float(lv[i] << 16)), a1 = __expf(__uint_as_float(lv[i] & 0xffff0000u));
                P0 *= a0; Q0 = a0 * Q0 + __builtin_amdgcn_sqrtf(1.f - a0 * a0) * __uint_as_float(bv[i] << 16); P1 *= a1; Q1 = a1 * Q1 + __builtin_amdgcn_sqrtf(1.f - a1 * a1) * __uint_as_float(bv[i] & 0xffff0000u); } }
        const size_t o = (size_t)g * 1024 + ch; *(f32x4*)(CT + o * 2) = (f32x4){P0, Q0, P1, Q1};
    }
}
DI void phase_scan2(const Args& a) {
    const float* CT = (const float*)((unsigned char*)a.out + O_CT); float* CARRY = (float*)((unsigned char*)a.out + O_CARRY);
    for (int idx = obid() * NTH + otid(); idx < 2 * 16 * 1024; idx += gridDim.x * NTH) {
        const int ch = idx & 1023, b = (idx >> 10) & 15, dir = idx >> 14; float h = 0.f;
        float pq[72];
#pragma unroll 1
        for (int hh = 0; hh < 2; ++hh) {
#pragma unroll
            for (int j = 0; j < 36; ++j) { const int chunk = scan_chunk_of(dir, hh * 36 + j); const size_t o = (((size_t)dir * 16 + b) * 72 + chunk) * 1024 + ch; pq[2 * j] = CT[o * 2]; pq[2 * j + 1] = CT[o * 2 + 1]; }
#pragma unroll
            for (int j = 0; j < 36; ++j) { const int chunk = scan_chunk_of(dir, hh * 36 + j); const size_t o = (((size_t)dir * 16 + b) * 72 + chunk) * 1024 + ch; CARRY[o] = h; h = pq[2 * j] * h + pq[2 * j + 1]; } }
    }
}
DI void phase_scan3(const Args& a) {
    const bf16_t* LA = (const bf16_t*)(a.ws + WS_BIG + B_LA); const bf16_t* BB = (const bf16_t*)(a.ws + WS_BIG + B_BB); const bf16_t* GATE = (const bf16_t*)(a.ws + WS_BIG + B_GATE);
    bf16_t* MIXA = (bf16_t*)(a.ws + WS_BIG + B_MIXA_O); const float* CARRY = (const float*)((unsigned char*)a.out + O_CARRY);
    for (int idx = obid() * NTH + otid(); idx < 16 * 72 * 512; idx += gridDim.x * NTH) {
        const int ch = (idx & 511) * 2, g = idx >> 9, chunk = g % 72, b = g / 72; const int row0 = chunk_row0(b, chunk);
        unsigned hfp[32];
        float hf0[32];
        { const bf16_t* la = LA + ((size_t)row0) * 1024 + ch; const bf16_t* bb = BB + ((size_t)row0) * 1024 + ch;
          const float* cp = CARRY + (((size_t)0 * 16 + b) * 72 + chunk) * 1024 + ch; float h0 = cp[0], h1 = cp[1];
#pragma unroll
          for (int i0 = 0; i0 < 32; i0 += 16) { unsigned lv[16], bv[16];
#pragma unroll
              for (int i = 0; i < 16; ++i) { lv[i] = *(const unsigned*)(la + (size_t)(i0 + i) * 1024); bv[i] = *(const unsigned*)(bb + (size_t)(i0 + i) * 1024); }
#pragma unroll
              for (int i = 0; i < 16; ++i) { const float a0 = __expf(__uint_as_float(lv[i] << 16)), a1 = __expf(__uint_as_float(lv[i] & 0xffff0000u));
                  h0 = a0 * h0 + __builtin_amdgcn_sqrtf(1.f - a0 * a0) * __uint_as_float(bv[i] << 16); h1 = a1 * h1 + __builtin_amdgcn_sqrtf(1.f - a1 * a1) * __uint_as_float(bv[i] & 0xffff0000u);
                  hf0[i0 + i] = h0; hfp[i0 + i] = __float_as_uint(h1); } } }
        { const bf16_t* la = LA + ((size_t)T + row0) * 1024 + ch; const bf16_t* bb = BB + ((size_t)T + row0) * 1024 + ch;
          const float* cp = CARRY + (((size_t)1 * 16 + b) * 72 + chunk) * 1024 + ch; float h0 = cp[0], h1 = cp[1];
          const bf16_t* gp = GATE + (size_t)row0 * 1024 + ch; bf16_t* mo = MIXA + (size_t)row0 * 1024 + ch;
#pragma unroll
          for (int i0 = 16; i0 >= 0; i0 -= 16) { unsigned lv[16], bv[16], gv[16];
#pragma unroll
              for (int i = 0; i < 16; ++i) { lv[i] = *(const unsigned*)(la + (size_t)(i0 + i) * 1024); bv[i] = *(const unsigned*)(bb + (size_t)(i0 + i) * 1024); gv[i] = *(const unsigned*)(gp + (size_t)(i0 + i) * 1024); }
#pragma unroll
              for (int i = 15; i >= 0; --i) { const float a0 = __expf(__uint_as_float(lv[i] << 16)), a1 = __expf(__uint_as_float(lv[i] & 0xffff0000u));
                  h0 = a0 * h0 + __builtin_amdgcn_sqrtf(1.f - a0 * a0) * __uint_as_float(bv[i] << 16); h1 = a1 * h1 + __builtin_amdgcn_sqrtf(1.f - a1 * a1) * __uint_as_float(bv[i] & 0xffff0000u);
                  *(unsigned*)(mo + (size_t)(i0 + i) * 1024) = pk2(__uint_as_float(gv[i] << 16) * (hf0[i0 + i] + h0), __uint_as_float(gv[i] & 0xffff0000u) * (__uint_as_float(hfp[i0 + i]) + h1)); } } }
    }
}

DI int route_row(float logit, int lane, float bias, float* wout) {
    const float score = 1.f / (1.f + expf(-logit)); const float sel = score + bias;
    float m1 = sel; m1 = fmaxf(m1, xor_lane<1>(m1)); m1 = fmaxf(m1, xor_lane<2>(m1)); m1 = fmaxf(m1, xor_lane<4>(m1));
    const unsigned long long eq = __ballot(sel == m1); const int g = lane >> 3; const unsigned gm = (unsigned)(eq >> (g * 8)) & 0xffu; const int first = __ffs(gm) - 1;
    float m2 = ((lane & 7) == first) ? -INFINITY : sel; m2 = fmaxf(m2, xor_lane<1>(m2)); m2 = fmaxf(m2, xor_lane<2>(m2)); m2 = fmaxf(m2, xor_lane<4>(m2));
    const float gs = m1 + m2; int grank = 0;
#pragma unroll
    for (int gg = 0; gg < 8; ++gg) { const float o = lane_bcast(gs, gg * 8); grank += ((o > gs) || (o == gs && gg < g)) ? 1 : 0; }
    const float msel = grank < 4 ? sel : -INFINITY; int rank = 0;
    unsigned ub = __float_as_uint(msel); ub = (ub & 0x80000000u) ? ~ub : (ub | 0x80000000u);
    const unsigned long long key = ((unsigned long long)ub << 6) | (unsigned)(63 - lane);
    const unsigned klo = (unsigned)key, khi = (unsigned)(key >> 32);
#pragma unroll
    for (int e2 = 0; e2 < 64; ++e2) { const unsigned long long ok = ((unsigned long long)(unsigned)__builtin_amdgcn_readlane((int)khi, e2) << 32) | (unsigned)__builtin_amdgcn_readlane((int)klo, e2); rank += (ok > key) ? 1 : 0; }
    const bool chosen = rank < 8; const float wsum = wave_sum(chosen ? score : 0.f);
    *wout = score / wsum * 2.5f;
    return chosen ? rank : -1;
}
constexpr int RW_ROWB = 528;
DI void phase_router(const Args& a, int l, int Mrows, const bf16_t* MB, LAS unsigned char* lds) {
    const float* kp_I_ROUTB = kin(I_ROUTB);
    bf16_t* XS = (bf16_t*)(a.ws + WS_XS); const float* MOD = (const float*)(a.ws + WS_MOD) + (size_t)l * 17 * 6144;
    const bf16_t* RWT = (const bf16_t*)(a.ws + WS_ROPE + 131072);
    int* cnt = (int*)(a.ws + WS_CTL) + CW_CNT + l * 64 * 32; int2* LIST = (int2*)((unsigned char*)a.out + O_LIST); bf16_t* TM = (bf16_t*)((unsigned char*)a.out + O_ABUF);
    const float* ln1g = kin(I_LN1G) + l * 1024; const float* ln1b = kin(I_LN1B) + l * 1024; const float* xin_l = kin(I_X); const float* xin_c = kin(I_CTX);
    const int tid = otid(); const int wave = tid >> 6, lane = tid & 63, i = lane & 15, q = lane >> 4;
    const float rb = kp_I_ROUTB[l * 64 + lane];
    const int R = Mrows >> 8, RW8 = R >> 3, NG = R >> 4;
    LAS float* lg = (LAS float*)lds;
    LAS unsigned char* rwb = lds + 40960;
    LAS int* lcnt = (LAS int*)(lds + 38912); LAS int* wgbase = lcnt + 64;
    LAS unsigned char* sb = lds + 39424;
    LAS float* part8 = (LAS float*)(lds + 110592);
    for (int tile = obid(); tile < 256; tile += gridDim.x) {
        const int rbase = tile * R, r0 = rbase + wave * RW8;
        u32x4 st[8];
#define RW_LOAD(c_) do { _Pragma("unroll") for (int j_ = 0; j_ < 8; ++j_) st[j_] = *(const u32x4*)((const char*)RWT + (rwoff + (unsigned)(j_ * 32768 + (c_) * 512))); } while (0)
#define RW_STORE() do { _Pragma("unroll") for (int j_ = 0; j_ < 8; ++j_) *(LAS u32x4*)(rwb + rwl + j_ * 16 * RW_ROWB) = st[j_]; } while (0)
#define LNC(j_) (8 * lane + 512 * ((j_) >> 1) + 4 * ((j_) & 1))
        { f32x4 lg_[4], lb_[4];
#pragma unroll
          for (int j = 0; j < 4; ++j) { const int col = LNC(j); lg_[j] = *(const f32x4*)(ln1g + col); lb_[j] = *(const f32x4*)(ln1b + col); }
#define LN_LOAD(row_, XQ, MQ) do { const int rw_ = (row_); const bf16_t* xr_ = XS + (size_t)rw_ * 1024; const bf16_t* mr_ = MB + (size_t)rw_ * 1024; \
              const float* xi_ = rw_ < TL ? xin_l + (size_t)rw_ * 1024 : xin_c + (size_t)(rw_ - TL) * 1024;          \
              _Pragma("unroll") for (int p = 0; p < 2; ++p) { const int col = LNC(2 * p); \
                  if (l == 0) { XQ[2 * p] = *(const f32x4*)(xi_ + col); XQ[2 * p + 1] = *(const f32x4*)(xi_ + col + 4); } \
                  else { const u32x4 xv = *(const u32x4*)(xr_ + col); XQ[2 * p] = (f32x4){__uint_as_float(xv.x << 16), __uint_as_float(xv.x & 0xffff0000u), __uint_as_float(xv.y << 16), __uint_as_float(xv.y & 0xffff0000u)}; \
                         XQ[2 * p + 1] = (f32x4){__uint_as_float(xv.z << 16), __uint_as_float(xv.z & 0xffff0000u), __uint_as_float(xv.w << 16), __uint_as_float(xv.w & 0xffff0000u)}; } \
                  { const u32x4 mv = *(const u32x4*)(mr_ + col); MQ[2 * p] = (u32x2){mv.x, mv.y}; MQ[2 * p + 1] = (u32x2){mv.z, mv.w}; } } } while (0)
          f32x4 xa[4], xb[4], xc[4]; u32x2 ma[4], mb[4], mc[4];
          LN_LOAD(r0, xa, ma); LN_LOAD(r0 + 1, xb, mb);
#pragma unroll 1
          for (int rr = 0; rr < RW8; ++rr) { const int row = r0 + rr; bf16_t* xrow = XS + (size_t)row * 1024; f32x4 v[4]; float s = 0.f;
              const float* md = MOD + (size_t)(row < TL ? (row >> 11) : 16) * 6144;
              f32x4 mgv[4], msh[4], msc[4];
#pragma unroll
              for (int j = 0; j < 4; ++j) { const int col = LNC(j); mgv[j] = *(const f32x4*)(md + 2048 + col); msh[j] = *(const f32x4*)(md + 3072 + col); msc[j] = *(const f32x4*)(md + 4096 + col); }
              asm volatile("" ::: "memory");
              if (rr + 2 < RW8) LN_LOAD(row + 2, xc, mc);
#pragma unroll
              for (int j = 0; j < 4; ++j) { const int col = LNC(j); const f32x4 gvj = mgv[j];
                  const f32x4 mf = {__uint_as_float(ma[j].x << 16), __uint_as_float(ma[j].x & 0xffff0000u), __uint_as_float(ma[j].y << 16), __uint_as_float(ma[j].y & 0xffff0000u)};
                  v[j] = xa[j] * DN_ALPHA + gvj * mf; s += (v[j][0] + v[j][1]) + (v[j][2] + v[j][3]); }
              const float mean = wave_sum(s) * (1.f / 1024.f); float s2 = 0.f;
#pragma unroll
              for (int j = 0; j < 4; ++j) { v[j] = v[j] - mean; s2 += (v[j][0] * v[j][0] + v[j][1] * v[j][1]) + (v[j][2] * v[j][2] + v[j][3] * v[j][3]); }
              const float rstd = rsqrtf(wave_sum(s2) * (1.f / 1024.f) + LN_EPS);
#pragma unroll
              for (int p = 0; p < 2; ++p) { const int col = LNC(2 * p); const f32x4 y0 = v[2 * p] * rstd * lg_[2 * p] + lb_[2 * p], y1 = v[2 * p + 1] * rstd * lg_[2 * p + 1] + lb_[2 * p + 1];
                  store_bf8(xrow + col, y0, y1);
                  const f32x4 sh0 = msh[2 * p], sh1 = msh[2 * p + 1], sc0 = msc[2 * p], sc1 = msc[2 * p + 1];
                  store_bf8(TM + (size_t)row * 1024 + col, y0 * (sc0 + 1.f) + sh0, y1 * (sc1 + 1.f) + sh1); }
#pragma unroll
              for (int j = 0; j < 4; ++j) { xa[j] = xb[j]; ma[j] = mb[j]; xb[j] = xc[j]; mb[j] = mc[j]; } } }
#undef LN_LOAD
#undef LNC
        unsigned rwoff = ((tid >> 5) * 1024 + (tid & 31) * 8) * 2, rwl = (tid >> 5) * RW_ROWB + (tid & 31) * 16; asm volatile("" : "+v"(rwoff), "+v"(rwl));
        RW_LOAD(0);
        asm volatile("s_waitcnt vmcnt(0)" ::: "memory");
        RW_STORE();
        if (tid < 64) lcnt[tid] = 0;
        __syncthreads();
        f32x4 acc[2][4];
#pragma unroll
        for (int gi = 0; gi < 2; ++gi)
#pragma unroll
            for (int eb = 0; eb < 4; ++eb) acc[gi][eb] = (f32x4){0.f, 0.f, 0.f, 0.f};
        const int wvu = __builtin_amdgcn_readfirstlane(wave);
        const bool g8 = (NG == 9) && (wvu < 4);
        const bf16_t* ta0 = TM + (size_t)(rbase + wave * 16 + i) * 1024 + 8 * q; const bf16_t* ta8 = TM + (size_t)(rbase + 128 + i) * 1024 + 8 * q + wvu * 256;
        constexpr int PD = 2;
        u32x4 xq[PD], a8[4];
#pragma unroll
        for (int ss = 0; ss < PD; ++ss) xq[ss] = __builtin_nontemporal_load((const u32x4*)(ta0 + 32 * ss));
#pragma unroll
        for (int s = 0; s < 4; ++s) a8[s] = g8 ? __builtin_nontemporal_load((const u32x4*)(ta8 + 32 * s)) : xq[0];
#pragma unroll
        for (int c = 0; c < 4; ++c) {
            if (c + 1 < 4) RW_LOAD(c + 1);
#pragma unroll
            for (int s = 0; s < 8; ++s) { const int ss = c * 8 + s;
                bf16x8 bh[4], bl[4];
#pragma unroll
                for (int eb = 0; eb < 4; ++eb) { bh[eb] = *(const LAS bf16x8*)(rwb + (eb * 16 + i) * RW_ROWB + (32 * s + 8 * q) * 2); bl[eb] = *(const LAS bf16x8*)(rwb + (64 + eb * 16 + i) * RW_ROWB + (32 * s + 8 * q) * 2); }
                const bf16x8 a0_ = __builtin_bit_cast(bf16x8, xq[s % PD]), a1_ = __builtin_bit_cast(bf16x8, a8[s & 3]);
                if (ss + PD < 32) xq[s % PD] = __builtin_nontemporal_load((const u32x4*)(ta0 + 32 * (ss + PD)));
                if (s < 4 && g8 && wvu == c) a8[s] = __builtin_nontemporal_load((const u32x4*)(ta8 + 32 * (s + 4)));
#pragma unroll
                for (int eb = 0; eb < 4; ++eb) { acc[0][eb] = mfma16(a0_, bh[eb], acc[0][eb]); acc[0][eb] = mfma16(a0_, bl[eb], acc[0][eb]); }
                if (g8 && wvu == c) {
#pragma unroll
                    for (int eb = 0; eb < 4; ++eb) { acc[1][eb] = mfma16(a1_, bh[eb], acc[1][eb]); acc[1][eb] = mfma16(a1_, bl[eb], acc[1][eb]); } }
            }
            if (c + 1 < 4) { LDS_WAIT(); __builtin_amdgcn_s_barrier();
                asm volatile("s_waitcnt vmcnt(0)" ::: "memory"); RW_STORE(); LDS_WAIT(); __builtin_amdgcn_s_barrier(); }
        }
#undef RW_LOAD
#undef RW_STORE
#pragma unroll
        for (int eb = 0; eb < 4; ++eb)
#pragma unroll
            for (int r = 0; r < 4; ++r) lg[(wave * 16 + 4 * q + r) * 65 + eb * 16 + i] = acc[0][eb][r];
        if (g8) {
#pragma unroll
            for (int eb = 0; eb < 4; ++eb)
#pragma unroll
                for (int r = 0; r < 4; ++r) part8[(wvu * 16 + 4 * q + r) * 64 + eb * 16 + i] = acc[1][eb][r]; }
        __syncthreads();
        if (NG == 9 && wvu == 2) {
#pragma unroll 1
            for (int idx = lane; idx < 1024; idx += 64) lg[(128 + (idx >> 6)) * 65 + (idx & 63)] = (part8[idx] + part8[1024 + idx]) + (part8[2048 + idx] + part8[3072 + idx]); }
        const int rl = wave * 64 + lane; const bool rok = rl < R;
        int pe[8], pp[8]; float pw[8];
        if (rok) {
            const LAS float* lrow = lg + rl * 65; float sel[64];
#pragma unroll
            for (int e = 0; e < 64; ++e) sel[e] = sigmoidf_(lrow[e]) + lane_bcast(rb, e);
            float gs[8];
#pragma unroll
            for (int g = 0; g < 8; ++g) { float m1 = sel[g * 8], m2 = -INFINITY;
#pragma unroll
                for (int j = 1; j < 8; ++j) { m2 = fmaxf(m2, fminf(m1, sel[g * 8 + j])); m1 = fmaxf(m1, sel[g * 8 + j]); }
                gs[g] = m1 + m2; }
#pragma unroll
            for (int g = 0; g < 8; ++g) { int grank = 0;
#pragma unroll
                for (int g2 = 0; g2 < 8; ++g2) { if (g2 == g) continue; grank += ((gs[g2] > gs[g]) || (gs[g2] == gs[g] && g2 < g)) ? 1 : 0; }
#pragma unroll
                for (int j = 0; j < 8; ++j) sel[g * 8 + j] = grank < 4 ? sel[g * 8 + j] : -INFINITY; }
#pragma unroll 1
            for (int k = 0; k < 8; ++k) { float best = sel[0]; int bi = 0;
#pragma unroll
                for (int e = 1; e < 64; ++e) { const bool c = sel[e] > best; best = c ? sel[e] : best; bi = c ? e : bi; }
#pragma unroll
                for (int e = 0; e < 64; ++e) sel[e] = (bi == e) ? -INFINITY : sel[e];
                sb[rl * 8 + k] = (unsigned char)bi; }
            float wsum = 0.f;
#pragma unroll
            for (int k = 0; k < 8; ++k) { pe[k] = sb[rl * 8 + k]; pw[k] = sigmoidf_(lrow[pe[k]]); wsum += pw[k]; pp[k] = __hip_atomic_fetch_add(lcnt + pe[k], 1, __ATOMIC_RELAXED, __HIP_MEMORY_SCOPE_WORKGROUP); }
            const float wn = __builtin_amdgcn_rcpf(wsum) * 2.5f;
#pragma unroll
            for (int k = 0; k < 8; ++k) pw[k] *= wn;
        }
        __syncthreads();
        if (wave == 0) wgbase[lane] = atomicAdd(&cnt[lane * 32], lcnt[lane]);
        __syncthreads();
        if (rok) {
#pragma unroll
            for (int k = 0; k < 8; ++k) LIST[(size_t)pe[k] * T + wgbase[pe[k]] + pp[k]] = make_int2((rbase + rl) * 8 + k, __float_as_int(pw[k])); }
        __syncthreads();
    }
}
DI void build_toff(const Args& a, int l, int Mrows, volatile LAS int* toff) {
    const int* cnt = (const int*)(a.ws + WS_CTL) + CW_CNT + l * 64 * 32;
    __syncthreads();
    if (otid() == 0) { int acc = 0;
#pragma unroll 1
        for (int e = 0; e < 64; ++e) { toff[e] = acc; acc += (cnt[e * 32] + 255) >> 8; }
        toff[64] = acc; acc += Mrows >> 8; toff[65] = acc; }
    __syncthreads();
    volatile LAS unsigned char* rt2e = (volatile LAS unsigned char*)(toff + 128); volatile LAS unsigned short* rtnv = (volatile LAS unsigned short*)(toff + 128 + 352);
    for (int rt = otid(); rt < toff[65]; rt += NTH) { int e = 0;
#pragma unroll 1
        while (e < 64 && toff[e + 1] <= rt) ++e;
        rt2e[rt] = (unsigned char)e;
        int nv = 256; if (e < 64) { const int rem = cnt[e * 32] - (rt - toff[e]) * 256; nv = rem < 256 ? rem : 256; } rtnv[rt] = (unsigned short)nv; }
    __syncthreads();
}
DI void phase_ln2(const Args& a, int l, int Mrows) {
    const float* kp_I_LN2B = kin(I_LN2B); const float* kp_I_LN2G = kin(I_LN2G);
    bf16_t* XS = (bf16_t*)(a.ws + WS_XS); const bf16_t* Y = (const bf16_t*)(a.ws + WS_BIG); bf16_t* AB = (bf16_t*)((unsigned char*)a.out + O_ABUF);
    const bf16_t* SHB = (l == DEPTH - 1) ? (const bf16_t*)(a.ws + WS_WGU) : (const bf16_t*)AB;
    const float* MOD = (const float*)(a.ws + WS_MOD) + (size_t)l * 17 * 6144; const float* MODN = MOD + 17 * 6144;
    const float* g = kp_I_LN2G + l * 1024; const float* bta = kp_I_LN2B + l * 1024;
    const int tid = otid(); const int lane = tid & 63, gw = obid() * NWV + (tid >> 6), NGW = gridDim.x * NWV;
#define UPK8(u_, lo_, hi_) do { lo_ = (f32x4){__uint_as_float((u_).x << 16), __uint_as_float((u_).x & 0xffff0000u), __uint_as_float((u_).y << 16), __uint_as_float((u_).y & 0xffff0000u)}; \
        hi_ = (f32x4){__uint_as_float((u_).z << 16), __uint_as_float((u_).z & 0xffff0000u), __uint_as_float((u_).w << 16), __uint_as_float((u_).w & 0xffff0000u)}; } while (0)
    for (int row0 = gw * 2; row0 < Mrows; row0 += NGW * 2) {
        f32x4 v[2][4]; float s[2] = {0.f, 0.f};
#pragma unroll
        for (int h = 0; h < 2; ++h) { const int row = row0 + h; const bf16_t* xr = XS + (size_t)row * 1024; const int mrow = row < TL ? (row >> 11) : 16; const float* md = MOD + (size_t)mrow * 6144;
#pragma unroll
            for (int j = 0; j < 2; ++j) { const int col = 8 * lane + 512 * j; f32x4 ys0 = {0.f, 0.f, 0.f, 0.f}, ys1 = {0.f, 0.f, 0.f, 0.f}, t0, t1;
#pragma unroll
                for (int k = 0; k < 8; ++k) { const u32x4 yv = *(const u32x4*)(Y + ((size_t)row * 8 + k) * 1024 + col); UPK8(yv, t0, t1); ys0 += t0; ys1 += t1; }
                { const u32x4 sv = *(const u32x4*)(SHB + (size_t)row * 1024 + col); UPK8(sv, t0, t1); ys0 += t0; ys1 += t1; }
                { const u32x4 xv = *(const u32x4*)(xr + col); UPK8(xv, t0, t1);
                  v[h][2 * j] = t0 * DN_ALPHA + *(const f32x4*)(md + 5120 + col) * ys0; v[h][2 * j + 1] = t1 * DN_ALPHA + *(const f32x4*)(md + 5120 + col + 4) * ys1; }
                s[h] += ((v[h][2 * j][0] + v[h][2 * j][1]) + (v[h][2 * j][2] + v[h][2 * j][3])) + ((v[h][2 * j + 1][0] + v[h][2 * j + 1][1]) + (v[h][2 * j + 1][2] + v[h][2 * j + 1][3])); } }
        asm volatile("" ::: "memory");
#pragma unroll
        for (int h = 0; h < 2; ++h) { const int row = row0 + h; bf16_t* xr = XS + (size_t)row * 1024; const int mrow = row < TL ? (row >> 11) : 16;
            const float mean = wave_sum(s[h]) * (1.f / 1024.f); float s2 = 0.f;
#pragma unroll
            for (int j = 0; j < 4; ++j) { v[h][j] = v[h][j] - mean; s2 += (v[h][j][0] * v[h][j][0] + v[h][j][1] * v[h][j][1]) + (v[h][j][2] * v[h][j][2] + v[h][j][3] * v[h][j][3]); }
            const float rstd = rsqrtf(wave_sum(s2) * (1.f / 1024.f) + LN_EPS);
            if (l == DEPTH - 1) {
#pragma unroll
                for (int j = 0; j < 4; ++j) { const int col = 8 * lane + 512 * (j >> 1) + 4 * (j & 1); *(f32x4*)(a.out + (size_t)row * 1024 + col) = v[h][j] * rstd * *(const f32x4*)(g + col) + *(const f32x4*)(bta + col); }
            } else { const float* mdn = MODN + (size_t)mrow * 6144;
#pragma unroll
                for (int j = 0; j < 2; ++j) { const int col = 8 * lane + 512 * j;
                    const f32x4 y0 = v[h][2 * j] * rstd * *(const f32x4*)(g + col) + *(const f32x4*)(bta + col), y1 = v[h][2 * j + 1] * rstd * *(const f32x4*)(g + col + 4) + *(const f32x4*)(bta + col + 4);
                    store_bf8(xr + col, y0, y1);
                    const f32x4 sh0 = *(const f32x4*)(mdn + col), sh1 = *(const f32x4*)(mdn + col + 4), sc0 = *(const f32x4*)(mdn + 1024 + col), sc1 = *(const f32x4*)(mdn + 1024 + col + 4);
                    store_bf8(AB + (size_t)row * 1024 + col, y0 * (sc0 + 1.f) + sh0, y1 * (sc1 + 1.f) + sh1); } } }
    }
#undef UPK8
}

#ifndef FASTMASK
#define FASTMASK 0xff
#endif
constexpr bool F_ABIN = FASTMASK & 1, F_RGIN = FASTMASK & 2, F_OUT = FASTMASK & 4, F_GATES = FASTMASK & 8, F_GU = FASTMASK & 16, F_DN = FASTMASK & 32, F_HY = FASTMASK & 64, F_AT = FASTMASK & 128;
__global__ void __launch_bounds__(NTH, 2) mega(Args a0) {
    extern __shared__ __attribute__((aligned(16))) unsigned char lds_raw[];
    LAS unsigned char* lds = (LAS unsigned char*)lds_raw;
    const int tid = threadIdx.x;
    volatile LAS unsigned* MISC = (volatile LAS unsigned*)(lds + LDS_MISC);
    volatile LAS int* toff = (volatile LAS int*)(lds + LDS_TOFF);
    if (tid < 64) MISC[tid] = 0u;
    if (tid < 46) { LAS unsigned long long* tb = (LAS unsigned long long*)(lds + LDS_PTRS); tb[tid] = ((const __attribute__((address_space(4))) unsigned long long*)__builtin_amdgcn_kernarg_segment_ptr())[tid]; }
    __syncthreads();
    XcdBarrier bar = xcd_barrier_post((unsigned*)(a0.ws + WS_CTL) + CW_BAR, MISC);
    const int G = gridDim.x, bx = blockIdx.x; const bool EARLY_T = F_AT && F_HY && (G == 256);
#define GRID_BAR() xcd_barrier(bar)
#ifndef TMASK
#define TMASK 0u
#endif
#ifndef TMULT
#define TMULT 10ull
#endif
    unsigned long long tacc = 0ull;
#define PH_ENV() const int bx = obid(); unsigned long long wsi_ = (unsigned long long)uni_ptr(a0.ws), oui_ = (unsigned long long)uni_ptr(a0.out); asm volatile("" : "+s"(wsi_), "+s"(oui_)); unsigned char* ws = (unsigned char*)(GAS unsigned char*)wsi_; float* outp_ = (float*)(GAS float*)oui_; const Args& a = a0; unsigned char* ob = (unsigned char*)outp_; \
    const float* MOD = (const float*)(ws + WS_MOD); bf16_t* ABUF = (bf16_t*)(ob + O_ABUF); const int2* LIST = (const int2*)(ob + O_LIST); (void)MOD; (void)ABUF; (void)LIST
#define PH(id, ...) do { unsigned long long t0_ = 0ull; if ((TMASK >> (id)) & 1u) t0_ = __builtin_amdgcn_s_memrealtime(); { PH_ENV(); __VA_ARGS__; } GRID_BAR(); if ((TMASK >> (id)) & 1u) tacc += __builtin_amdgcn_s_memrealtime() - t0_; } while (0)
#define PHN(id, ...) do { unsigned long long t0_ = 0ull; if ((TMASK >> (id)) & 1u) t0_ = __builtin_amdgcn_s_memrealtime(); __VA_ARGS__; if ((TMASK >> (id)) & 1u) tacc += __builtin_amdgcn_s_memrealtime() - t0_; } while (0)
    PH(0, phase_mod(a, lds); phase_hdn(a); phase_rope(a); phase_weights(a, 0, lds));
    PH(1, phase_kr(a); phase_init(a));

    for (int l = 0; l < DEPTH; ++l) {
        const int Mrows = (l == DEPTH - 1) ? TL : T;
        if ((l & 1) == 0) {
            const int e = l >> 1;
            PH(3, { SchedDense S{ABUF, (const bf16_t*)(ws + WS_WIN), 1024, 1024, T / 256, 12, G, bx};
              EpiAbIn E{(bf16_t*)(ws + WS_BIG + B_PH), (bf16_t*)(ws + WS_BIG + B_QB), (bf16_t*)(ws + WS_BIG + B_KB), (bf16_t*)(ws + WS_BIG + B_VB), (const float*)(ws + WS_ROPE)};
              gemm_units<F_ABIN>(lds, S, E, 1024, 1024); });
            PH(4, phase_uc(a, e, lds));
            PH(5, PHN(19, { if constexpr (F_HY) { for (int c = bx; c < 1024; c += G) { if (c < 512) hyena_unit_fast<16>(a, e, c, lds); else hyena_unit_fast<2>(a, e, c - 512, lds); } }
                          else { for (int c = bx; c < 1024; c += G) hyena_unit_naive(a, e, c & 511, c >> 9, lds); } });
                  if (EARLY_T) hy_signal((unsigned*)(ws + WS_CTL) + CW_HYC + e * 32);
                  PHN(20, { if constexpr (F_AT) { for (int u = bx; u < 1024 + 128; u += G) { if (u < 1024) attn_unit_fast(a, l, 0, u >> 6, (u >> 4) & 3, u & 15, lds); else { const int v = u - 1024; attn_unit_fast(a, l, 1, v >> 3, (v >> 1) & 3, v & 1, lds); } } }
                          else { for (int u = bx; u < 2048 + 256; u += G) { if (u < 2048) attn_unit_naive(a, l, 0, u >> 7, (u >> 5) & 3, u & 31, lds); else { const int v = u - 2048; attn_unit_naive(a, l, 1, v >> 4, (v >> 2) & 3, v & 3, lds); } } } });
                  if (EARLY_T && bx >= 128) { hy_wait((unsigned*)(ws + WS_CTL) + CW_HYC + e * 32, 256u, bar.bar); phase_yh_t(a, lds, bx - 128, 128); });
            if (!EARLY_T) PH(6, phase_yh_t(a, lds, bx, G));
            PH(7, { SchedDense S{(const bf16_t*)(ws + WS_BIG + B_MIXA_E), (const bf16_t*)(ws + WS_WOUT), 1024, 1024, Mrows / 256, 4, G, bx}; EpiM E{(bf16_t*)(ws + WS_BIG + B_M_E)}; gemm_units<F_OUT>(lds, S, E, 1024, 1024); });
        } else {
            const int o = l >> 1;
            PH(8, { SchedDense S{ABUF, (const bf16_t*)(ws + WS_WIN), 1024, 1024, T / 256, 8, G, bx}; EpiRgIn E{(bf16_t*)(ws + WS_BIG + B_GATE), (bf16_t*)(ws + WS_BIG + B_REC)}; gemm_units<F_RGIN>(lds, S, E, 1024, 1024); });
            PH(9, phase_rgconv(a, o));
            PH(10, { SchedGates S{(const bf16_t*)(ws + WS_BIG + B_U), (const bf16_t*)(ws + WS_WG), T / 256, G, bx};
              EpiGates E{(const bf16_t*)(ws + WS_BIG + B_U), (bf16_t*)(ws + WS_BIG + B_LA), (bf16_t*)(ws + WS_BIG + B_BB), kin(I_RGBA) + o * 2048, kin(I_RGBX) + o * 2048, (const float*)(ws + WS_ROPE + 65536) + o * 2048};
              gemm_units<F_GATES>(lds, S, E, 128, 128); });
            PH(11, phase_scan1(a));
            PH(12, phase_scan2(a));
            PH(13, phase_scan3(a));
            PH(7, { SchedDense S{(const bf16_t*)(ws + WS_BIG + B_MIXA_O), (const bf16_t*)(ws + WS_WOUT), 1024, 1024, Mrows / 256, 4, G, bx}; EpiM E{(bf16_t*)(ws + WS_BIG + B_M_O)}; gemm_units<F_OUT>(lds, S, E, 1024, 1024); });
        }
        PH(15, phase_router(a, l, Mrows, (const bf16_t*)(ws + WS_BIG + ((l & 1) ? B_M_O : B_M_E)), lds));
        build_toff(a0, l, Mrows, toff);
        PH(16, { const int* cnt = (const int*)(ws + WS_CTL) + CW_CNT + l * 64 * 32; SchedMoeT<true> S{ABUF, (const bf16_t*)(ws + WS_WGU), cnt, LIST, toff, (volatile LAS unsigned char*)(toff + 128), toff[65], 2, G, bx, (size_t)512 * 1024}; EpiGU E{(bf16_t*)(ws + WS_HS)}; gemm_units<F_GU>(lds, S, E, 1024, 1024); });
        PH(17, { const int* cnt = (const int*)(ws + WS_CTL) + CW_CNT + l * 64 * 32; { SchedMoeT<false> S{(const bf16_t*)(ws + WS_HS), (const bf16_t*)(ws + WS_WD), cnt, LIST, toff, (volatile LAS unsigned char*)(toff + 128), toff[64], 4, G, bx, (size_t)1024 * 256};
          EpiDn E{(bf16_t*)(ws + WS_BIG), LIST}; gemm_units<F_DN>(lds, S, E, 256, 256); }
          { SchedDense S{(const bf16_t*)(ws + WS_HS) + (size_t)toff[64] * 256 * 256, (const bf16_t*)(ws + WS_WD) + (size_t)64 * 1024 * 256, 256, 256, Mrows / 256, 4, G, (G == 256) ? ((bx + 128) & 255) : bx}; EpiM E{(l == DEPTH - 1) ? (bf16_t*)(ws + WS_WGU) : ABUF}; gemm_units<F_DN>(lds, S, E, 256, 256); } });
        PH(18, phase_ln2(a, l, Mrows); if (l + 1 < DEPTH) phase_weights(a, l + 1, lds));
    }
    if (TMASK != 0u) { if (bx == 0 && tid == 0) { const unsigned long long t1 = __builtin_amdgcn_s_memrealtime(); while (__builtin_amdgcn_s_memrealtime() - t1 < TMULT * tacc) __builtin_amdgcn_s_sleep(8); } }
}

extern "C" void kernel_launch(void* const* d_in, const int* in_sizes, int n_in, void* d_out, int out_size, void* d_ws, size_t ws_size, hipStream_t stream) {
    static int grid = 0;
    if (grid == 0) {
        int dev = 0, cus = 0;
        if (hipGetDevice(&dev) != hipSuccess || hipDeviceGetAttribute(&cus, hipDeviceAttributeMultiprocessorCount, dev) != hipSuccess) { grid = -1; return; }
        if (hipFuncSetAttribute((const void*)mega, hipFuncAttributeMaxDynamicSharedMemorySize, LDS_BYTES) != hipSuccess) { grid = -1; return; }
        int per_cu = 0; (void)hipOccupancyMaxActiveBlocksPerMultiprocessor(&per_cu, (const void*)mega, NTH, LDS_BYTES); (void)hipGetLastError();
        grid = cus;
        if (per_cu < 1) grid = cus;
    }
    if (grid < 0) return;
    (void)hipMemsetAsync((char*)d_ws + WS_CTL, 0, CTL_BYTES, stream);
    Args a{};
    for (int i = 0; i < 46; ++i) a.in[i] = (const float*)d_in[i];
    a.out = (float*)d_out; a.ws = (unsigned char*)d_ws;
    hipLaunchKernelGGL(mega, dim3(grid), dim3(NTH), LDS_BYTES, stream, a);
}
```
